# Optimizing an MI355X kernel written in HIP

```python
import math
import jax, jax.numpy as jnp
from jax import lax
import numpy as np

D_MODEL = 1024
BATCH = 16
SEQ = 2048
DEPTH = 4

CTX_LEN = 256
GRID_W = 64
CONV_CH = 512
CONV_WIDTH = 31
MLA_HEADS = 8
QK_NOPE = 64
QK_ROPE = 32
V_HEAD = 64
Q_LORA = 768
KV_LORA = 256
QK_HEAD = QK_NOPE + QK_ROPE
REC_WIDTH = 512
REC_BLOCKS = 8
REC_BW = REC_WIDTH // REC_BLOCKS
REC_CONV = 4
LRU_C = 8.0
N_BRANCH = 3
D_FF = 3584
N_EXPERTS = 8
TOP_K = 2
N_DENSE = DEPTH - DEPTH // 2
N_MOE = DEPTH // 2
ROPE_BASE = 10000.0
NORM_EPS = 1e-6
Q_BLOCK = 128
COL_CONV = 2 * CONV_CH
COL_Q = Q_LORA
COL_KV = KV_LORA + QK_ROPE
COL_REC = 2 * REC_WIDTH
COL_GATE = N_BRANCH * D_MODEL
IN_COLS = COL_CONV + COL_Q + COL_KV + COL_REC + COL_GATE

kernel_name = "hybrid_conv_mla_rglru_moe_dit"


def rmsnorm(x, g):
    xf = x.astype(jnp.float32)
    y = xf * lax.rsqrt(jnp.mean(xf * xf, axis=-1, keepdims=True) + NORM_EPS)
    return (y * g.astype(jnp.float32)).astype(x.dtype)


def layernorm(x, g, b):
    xf = x.astype(jnp.float32)
    mu = jnp.mean(xf, axis=-1, keepdims=True)
    var = jnp.mean(jnp.square(xf - mu), axis=-1, keepdims=True)
    y = (xf - mu) * lax.rsqrt(var + NORM_EPS)
    return (y * g.astype(jnp.float32) + b.astype(jnp.float32)).astype(x.dtype)


def modulate(h, shift, scale):
    return h * (1 + scale) + shift


def depthwise_conv(x, w, b, pad):
    y = lax.conv_general_dilated(x, w[:, None, :].astype(x.dtype), window_strides=(1,), padding=(pad,),
                                 dimension_numbers=("NWC", "WIO", "NWC"), feature_group_count=x.shape[-1])
    return y + b


def axial_rope_tables(seq):
    rows = seq // GRID_W
    row = jnp.repeat(jnp.arange(rows, dtype=jnp.int32), GRID_W)
    col = jnp.tile(jnp.arange(GRID_W, dtype=jnp.int32), rows)
    half = QK_ROPE // 2
    freqs = ROPE_BASE ** (-jnp.arange(0, half, 2, dtype=jnp.float32) / half)
    ang = jnp.stack([row[:, None].astype(jnp.float32) * freqs,
                     col[:, None].astype(jnp.float32) * freqs], axis=1)
    return jnp.cos(ang), jnp.sin(ang)


def apply_axial_rope(t, cos, sin):
    ts = t.astype(jnp.float32).reshape(t.shape[:-1] + (2, 2, QK_ROPE // 4))
    t1, t2 = ts[..., 0, :], ts[..., 1, :]
    cs, sn = cos[None, :, None], sin[None, :, None]
    out = jnp.stack([t1 * cs - t2 * sn, t2 * cs + t1 * sn], axis=-2)
    return out.reshape(t.shape).astype(t.dtype)


def rope_heads(t, cos, sin):
    return jnp.concatenate([t[..., :QK_NOPE], apply_axial_rope(t[..., QK_NOPE:], cos, sin)], axis=-1)


def split_cols(z):
    o1 = COL_CONV
    o2 = o1 + COL_Q
    o3 = o2 + COL_KV
    o4 = o3 + COL_REC
    return z[..., :o1], z[..., o1:o2], z[..., o2:o3], z[..., o3:o4], z[..., o4:]


def conv_branch(z, p):
    u = z[..., :CONV_CH] * jax.nn.sigmoid(z[..., CONV_CH:])
    u = depthwise_conv(u, p["conv_w"], p["conv_b"], (CONV_WIDTH // 2, CONV_WIDTH // 2))
    u = layernorm(u, p["conv_ln_g"], p["conv_ln_b"])
    return jax.nn.silu(u) @ p["w_o_conv"]


def mla_q(zq, p):
    b, l = zq.shape[:2]
    q = (rmsnorm(zq, p["g_q_a"]) @ p["w_q_b"]).reshape(b, l, MLA_HEADS, QK_HEAD)
    return rmsnorm(q, p["g_qn"])


def mla_kv(zkv, p):
    b, l = zkv.shape[:2]
    ckv = rmsnorm(zkv[..., :KV_LORA], p["g_kv_a"])
    k_rope = zkv[..., KV_LORA:]
    kv = (ckv @ p["w_kv_b"]).reshape(b, l, MLA_HEADS, QK_NOPE + V_HEAD)
    k = jnp.concatenate([kv[..., :QK_NOPE],
                         jnp.broadcast_to(k_rope[:, :, None, :], (b, l, MLA_HEADS, QK_ROPE))], axis=-1)
    return rmsnorm(k, p["g_kn"]), kv[..., QK_NOPE:]


def attend(q, k, v):
    s = jnp.einsum("bqhd,bkhd->bhqk", q, k).astype(jnp.float32) * (1.0 / math.sqrt(QK_HEAD))
    pr = jax.nn.softmax(s, axis=-1).astype(v.dtype)
    return jnp.einsum("bhqk,bkhd->bqhd", pr, v)


def block_attention(q, k, v):
    b, s, h, dq = q.shape
    nb = s // Q_BLOCK
    qb = q.reshape(b, nb, Q_BLOCK, h, dq).transpose(1, 0, 2, 3, 4)
    out = lax.map(lambda qq: attend(qq, k, v), qb)
    return out.transpose(1, 0, 2, 3, 4).reshape(b, s, h, V_HEAD)


def lru_scan(a, bx, h0, reverse):
    def comb(e1, e2):
        a1, b1 = e1
        a2, b2 = e2
        return a1 * a2, a2 * b1 + b2
    a_cum, b_cum = lax.associative_scan(comb, (a, bx), reverse=reverse, axis=1)
    return b_cum + a_cum * h0[:, None, :]


def rglru_dir(xc, w_a, b_a, w_i, b_i, lam, h0, reverse):
    b, l, w = xc.shape
    xh = xc.reshape(b, l, REC_BLOCKS, REC_BW)
    r = jax.nn.sigmoid(jnp.einsum("blgi,gij->blgj", xh, w_a).reshape(b, l, w) + b_a).astype(jnp.float32)
    i = jax.nn.sigmoid(jnp.einsum("blgi,gij->blgj", xh, w_i).reshape(b, l, w) + b_i).astype(jnp.float32)
    log_a = -LRU_C * r * jax.nn.softplus(-lam.astype(jnp.float32))
    a = jnp.exp(log_a)
    bx = jnp.sqrt(-jnp.expm1(2.0 * log_a)) * (i * xc.astype(jnp.float32))
    return lru_scan(a, bx, h0, reverse)


def rec_branch(zl, zc, p, ctx_out):
    b = zl.shape[0]
    hl_dirs, hc_dirs = [], []
    for d, reverse in ((0, False), (1, True)):
        pad = (0, REC_CONV - 1) if reverse else (REC_CONV - 1, 0)
        xc_c = depthwise_conv(zc[..., :REC_WIDTH], p["rec_conv_w"][d], p["rec_conv_b"][d], pad)
        xc_l = depthwise_conv(zl[..., :REC_WIDTH], p["rec_conv_w"][d], p["rec_conv_b"][d], pad)
        args = (p["w_ra"][d], p["b_ra"][d], p["w_ri"][d], p["b_ri"][d], p["lru_lambda"][d])
        hc = rglru_dir(xc_c, *args, jnp.zeros((b, REC_WIDTH), jnp.float32), reverse)
        h_fin = hc[:, 0] if reverse else hc[:, -1]
        hl_dirs.append(rglru_dir(xc_l, *args, h_fin, reverse))
        hc_dirs.append(hc)
    yl = ((hl_dirs[0] + hl_dirs[1]).astype(zl.dtype) * jax.nn.gelu(zl[..., REC_WIDTH:])) @ p["w_o_rec"]
    yc = None
    if ctx_out:
        yc = ((hc_dirs[0] + hc_dirs[1]).astype(zc.dtype) * jax.nn.gelu(zc[..., REC_WIDTH:])) @ p["w_o_rec"]
    return yl, yc


def gated_merge(zg, ya, yb, yc, p):
    g = jax.nn.sigmoid(zg + p["b_gate"]).reshape(zg.shape[:-1] + (N_BRANCH, D_MODEL))
    m = g[..., 0, :] * ya + g[..., 1, :] * yb + g[..., 2, :] * yc
    return m @ p["w_out"]


def mixer(hl, hc, p, cos, sin, ctx_out):
    b, s, _ = hl.shape
    cl, ql, kvl, rl, gl = split_cols(hl @ p["w_in"])
    cc, qc, kvc, rc, gc = split_cols(hc @ p["w_in"])
    ya_l = conv_branch(cl, p)
    kc, vc = mla_kv(kvc, p)
    kl, vl = mla_kv(kvl, p)
    kl = rope_heads(kl, cos, sin)
    q_lat = rope_heads(mla_q(ql, p), cos, sin)
    k_all = jnp.concatenate([kc, kl], axis=1)
    v_all = jnp.concatenate([vc, vl], axis=1)
    yb_l = block_attention(q_lat, k_all, v_all).reshape(b, s, MLA_HEADS * V_HEAD) @ p["w_o_mla"]
    yc_l, yc_c = rec_branch(rl, rc, p, ctx_out)
    out_l = gated_merge(gl, ya_l, yb_l, yc_l, p)
    out_c = None
    if ctx_out:
        ya_c = conv_branch(cc, p)
        yb_c = attend(mla_q(qc, p), kc, vc).reshape(b, CTX_LEN, MLA_HEADS * V_HEAD) @ p["w_o_mla"]
        out_c = gated_merge(gc, ya_c, yb_c, yc_c, p)
    return out_l, out_c


def swiglu(h, wg, wu, wd):
    return (jax.nn.silu(h @ wg) * (h @ wu)) @ wd


def moe_swiglu(h, w_router, w_g, w_u, w_d):
    logits = (h @ w_router).astype(jnp.float32)
    top_v, top_i = lax.top_k(logits, TOP_K)
    top_w = jax.nn.softmax(top_v, axis=-1)
    comb = jnp.sum(jax.nn.one_hot(top_i, N_EXPERTS, dtype=jnp.float32) * top_w[..., None], axis=-2)
    out = jnp.zeros_like(h)
    for e in range(N_EXPERTS):
        out = out + comb[..., e:e + 1].astype(h.dtype) * swiglu(h, w_g[e], w_u[e], w_d[e])
    return out


def setup_inputs(seed: int = 0) -> dict:
    key = jax.random.key(seed)
    ks = iter(jax.random.split(key, 48))

    def nrm(shape, fan_in):
        return jax.random.normal(next(ks), shape, jnp.float32) * (fan_in ** -0.5)

    def gain(shape):
        return 1.0 + 0.02 * jax.random.normal(next(ks), shape, jnp.float32)

    def bias(shape):
        return 0.02 * jax.random.normal(next(ks), shape, jnp.float32)

    d = D_MODEL
    inp = {}
    inp["x"] = jax.random.normal(next(ks), (BATCH, SEQ, d), jnp.float32)
    inp["c"] = jax.random.normal(next(ks), (BATCH, d), jnp.float32)
    inp["ctx"] = jax.random.normal(next(ks), (BATCH, CTX_LEN, d), jnp.float32)
    inp["c_ctx"] = jax.random.normal(next(ks), (d,), jnp.float32)
    inp["w_ada"] = 0.5 * nrm((DEPTH, d, 6 * d), d)
    inp["b_ada"] = bias((DEPTH, 6 * d))
    inp["g_norm1"] = gain((DEPTH, d))
    inp["g_norm2"] = gain((DEPTH, d))
    inp["w_in"] = nrm((DEPTH, d, IN_COLS), d)
    inp["b_gate"] = bias((DEPTH, COL_GATE))
    inp["conv_w"] = nrm((DEPTH, CONV_WIDTH, CONV_CH), CONV_WIDTH)
    inp["conv_b"] = bias((DEPTH, CONV_CH))
    inp["conv_ln_g"] = gain((DEPTH, CONV_CH))
    inp["conv_ln_b"] = bias((DEPTH, CONV_CH))
    inp["w_o_conv"] = nrm((DEPTH, CONV_CH, d), CONV_CH)
    inp["g_q_a"] = gain((DEPTH, Q_LORA))
    inp["w_q_b"] = nrm((DEPTH, Q_LORA, MLA_HEADS * QK_HEAD), Q_LORA)
    inp["g_kv_a"] = gain((DEPTH, KV_LORA))
    inp["w_kv_b"] = nrm((DEPTH, KV_LORA, MLA_HEADS * (QK_NOPE + V_HEAD)), KV_LORA)
    inp["g_qn"] = gain((DEPTH, QK_HEAD))
    inp["g_kn"] = gain((DEPTH, QK_HEAD))
    inp["w_o_mla"] = nrm((DEPTH, MLA_HEADS * V_HEAD, d), MLA_HEADS * V_HEAD)
    inp["rec_conv_w"] = nrm((DEPTH, 2, REC_CONV, REC_WIDTH), REC_CONV)
    inp["rec_conv_b"] = bias((DEPTH, 2, REC_WIDTH))
    inp["w_ra"] = nrm((DEPTH, 2, REC_BLOCKS, REC_BW, REC_BW), REC_BW)
    inp["b_ra"] = bias((DEPTH, 2, REC_WIDTH))
    inp["w_ri"] = nrm((DEPTH, 2, REC_BLOCKS, REC_BW, REC_BW), REC_BW)
    inp["b_ri"] = bias((DEPTH, 2, REC_WIDTH))
    u = jax.random.uniform(next(ks), (DEPTH, 2, REC_WIDTH), jnp.float32, minval=0.9, maxval=0.999)
    inp["lru_lambda"] = jnp.log(u) - jnp.log1p(-u)
    inp["w_o_rec"] = nrm((DEPTH, REC_WIDTH, d), REC_WIDTH)
    inp["w_out"] = nrm((DEPTH, d, d), d)
    inp["w_ff_gate"] = nrm((N_DENSE, d, D_FF), d)
    inp["w_ff_up"] = nrm((N_DENSE, d, D_FF), d)
    inp["w_ff_down"] = nrm((N_DENSE, D_FF, d), D_FF)
    inp["w_router"] = nrm((N_MOE, d, N_EXPERTS), d)
    inp["w_e_gate"] = nrm((N_MOE, N_EXPERTS, d, D_FF), d)
    inp["w_e_up"] = nrm((N_MOE, N_EXPERTS, d, D_FF), d)
    inp["w_e_down"] = nrm((N_MOE, N_EXPERTS, D_FF, d), D_FF)
    return inp


def reference(x, c, ctx, c_ctx, w_ada, b_ada, g_norm1, g_norm2, w_in, b_gate, conv_w, conv_b, conv_ln_g,
              conv_ln_b, w_o_conv, g_q_a, w_q_b, g_kv_a, w_kv_b, g_qn, g_kn, w_o_mla, rec_conv_w, rec_conv_b,
              w_ra, b_ra, w_ri, b_ri, lru_lambda, w_o_rec, w_out, w_ff_gate, w_ff_up, w_ff_down, w_router,
              w_e_gate, w_e_up, w_e_down):
    seq = x.shape[1]
    cos, sin = axial_rope_tables(seq)
    silu_c = jax.nn.silu(c)
    silu_cc = jax.nn.silu(c_ctx)
    for i in range(DEPTH):
        last = i == DEPTH - 1
        m_l = (silu_c @ w_ada[i] + b_ada[i])[:, None, :]
        m_c = silu_cc @ w_ada[i] + b_ada[i]
        sh1, sc1, ga1, sh2, sc2, ga2 = jnp.split(m_l, 6, axis=-1)
        csh1, csc1, cga1, csh2, csc2, cga2 = jnp.split(m_c, 6, axis=-1)
        p = {"w_in": w_in[i], "b_gate": b_gate[i], "conv_w": conv_w[i], "conv_b": conv_b[i],
             "conv_ln_g": conv_ln_g[i], "conv_ln_b": conv_ln_b[i], "w_o_conv": w_o_conv[i],
             "g_q_a": g_q_a[i], "w_q_b": w_q_b[i], "g_kv_a": g_kv_a[i], "w_kv_b": w_kv_b[i],
             "g_qn": g_qn[i], "g_kn": g_kn[i], "w_o_mla": w_o_mla[i], "rec_conv_w": rec_conv_w[i],
             "rec_conv_b": rec_conv_b[i], "w_ra": w_ra[i], "b_ra": b_ra[i], "w_ri": w_ri[i],
             "b_ri": b_ri[i], "lru_lambda": lru_lambda[i], "w_o_rec": w_o_rec[i], "w_out": w_out[i]}
        hl = modulate(rmsnorm(x, g_norm1[i]), sh1, sc1)
        hc = modulate(rmsnorm(ctx, g_norm1[i]), csh1, csc1)
        yl, yc = mixer(hl, hc, p, cos, sin, ctx_out=not last)
        x = x + ga1 * yl
        if not last:
            ctx = ctx + cga1 * yc
        hl = modulate(rmsnorm(x, g_norm2[i]), sh2, sc2)
        if last:
            h = hl
        else:
            h = jnp.concatenate([modulate(rmsnorm(ctx, g_norm2[i]), csh2, csc2), hl], axis=1)
        j = i // 2
        if i % 2 == 0:
            f = swiglu(h, w_ff_gate[j], w_ff_up[j], w_ff_down[j])
        else:
            f = moe_swiglu(h, w_router[j], w_e_gate[j], w_e_up[j], w_e_down[j])
        if last:
            x = x + ga2 * f
        else:
            x = x + ga2 * f[:, CTX_LEN:]
            ctx = ctx + cga2 * f[:, :CTX_LEN]
    return x
```

```cpp
#include <hip/hip_runtime.h>
#include <cstdio>
#include <cstdint>

#ifndef MK_ONE_LAUNCH
#define MK_ONE_LAUNCH 1
#endif

#define LAS __attribute__((address_space(3)))
#define GAS __attribute__((address_space(1)))
typedef unsigned short bf16_t;
typedef short bf16x8 __attribute__((ext_vector_type(8)));
typedef short s16x4 __attribute__((ext_vector_type(4)));
typedef float f32x2 __attribute__((ext_vector_type(2)));
typedef float f32x4 __attribute__((ext_vector_type(4)));
typedef float f32x16 __attribute__((ext_vector_type(16)));
typedef unsigned u32x2 __attribute__((ext_vector_type(2)));
typedef unsigned u32x4 __attribute__((ext_vector_type(4)));
typedef int i32x4 __attribute__((ext_vector_type(4)));
typedef int i32x2 __attribute__((ext_vector_type(2)));

constexpr int DM = 1024, NB = 16, SEQ = 2048, CTXL = 256, LROW = CTXL + SEQ  , T = NB * LROW  , DEPTH = 4;
constexpr int IN_COLS = 6176, NWIN = 6144, DFF = 3584, NEXP = 8, NMOD = 17;
constexpr int MOE_ROWS_MAX = 75776;
constexpr float NORM_EPS = 1e-6f;
constexpr float QSCALE = 0.10206207261596577f * 1.4426950408889634f;
constexpr int NTHREADS = 512, NWAVES = 8;

constexpr size_t al256(size_t x) { return (x + 255) & ~(size_t)255; }
constexpr size_t WS_CTL = 0, CTL_BYTES = 1u << 20;
constexpr size_t WS_MOD = WS_CTL + CTL_BYTES;
constexpr size_t WS_XRES = WS_MOD + al256((size_t)DEPTH * NMOD * 6144 * 4);
constexpr size_t WS_ROUTE_A = WS_XRES + (size_t)T * DM * 2;
constexpr size_t WS_ROUTE_W = WS_ROUTE_A + (size_t)T * 16;
constexpr size_t WS_ROUTE_P = WS_ROUTE_W + (size_t)T * 8;
constexpr size_t WS_TAB = WS_ROUTE_P + (size_t)T * 8;
constexpr size_t WS_STATS = WS_TAB + 4096;
constexpr size_t WS_INV = WS_STATS + (size_t)T * 32;
constexpr size_t WS_WIN = WS_INV + (size_t)8 * T * 4;
constexpr size_t WS_WQB = WS_WIN + (size_t)DEPTH * NWIN * DM * 2;
constexpr size_t WS_WKVB = WS_WQB + (size_t)DEPTH * 1024 * 768 * 2;
constexpr size_t WS_WCAT = WS_WKVB + (size_t)DEPTH * 1024 * 256 * 2;
constexpr size_t WS_WOUT = WS_WCAT + (size_t)DEPTH * 1024 * 1536 * 2;
constexpr size_t WS_WREC = WS_WOUT + (size_t)DEPTH * 1024 * 1024 * 2;
constexpr size_t WS_WKR = WS_WREC + (size_t)DEPTH * 2 * 2 * 8 * 4096 * 2;
constexpr size_t WS_WFFGU = WS_WKR + (size_t)DEPTH * 64 * 512 * 2;
constexpr size_t WS_WFFD = WS_WFFGU + (size_t)2 * 7168 * 1024 * 2;
constexpr size_t WS_WEGU = WS_WFFD + (size_t)2 * 1024 * 3584 * 2;
constexpr size_t WS_WED = WS_WEGU + (size_t)NEXP * 7168 * 1024 * 2;
constexpr size_t WS_ARENA = WS_WED + (size_t)NEXP * 1024 * 3584 * 2;
constexpr size_t A_H = WS_ARENA;
constexpr size_t A_G = A_H + (size_t)T * 1024 * 2;
constexpr size_t A_ZR = A_G + (size_t)T * 3072 * 2;
constexpr size_t A_ZQ = A_ZR + (size_t)T * 1024 * 2;
constexpr size_t A_Q = A_ZQ + (size_t)T * 768 * 2;
constexpr size_t A_ZKV = A_Q + (size_t)T * 768 * 2;
constexpr size_t A_KR = A_ZKV + (size_t)T * 256 * 2;
constexpr size_t A_KVR = A_KR + (size_t)T * 32 * 2;
constexpr size_t A_U = A_KVR + (size_t)T * 1024 * 2;
constexpr size_t A_CAT = A_U + (size_t)T * 512 * 2;
constexpr size_t A_SUM = A_CAT + (size_t)T * 1536 * 2;
constexpr size_t A_CAR = A_SUM + (size_t)NB * 8 * 2 * 72 * 2 * 64 * 4;
constexpr size_t A_MIX_END = A_CAR + (size_t)NB * 8 * 2 * 72 * 64 * 4;
constexpr size_t A_HID = A_G;
constexpr size_t A_HP = A_G;
constexpr size_t A_HIDM = A_HP + (size_t)MOE_ROWS_MAX * 1024 * 2;
constexpr size_t A_MOE_END = A_HIDM + (size_t)MOE_ROWS_MAX * 3584 * 2;
constexpr size_t WS_END = A_MIX_END > A_MOE_END ? A_MIX_END : A_MOE_END;
static_assert(WS_END < 1203000000ull, "workspace map must fit under sum(inputs)");
constexpr int CW_BAR = 4096, CW_CNT = 16384;

constexpr int RING_BYTES = 131072, LDS_BYTES = 147456, LDSCTL_OFF = LDS_BYTES - 1024;

__device__ __forceinline__ unsigned cvt_pk_bf16(float lo, float hi) { unsigned r; asm volatile("v_cvt_pk_bf16_f32 %0, %1, %2" : "=v"(r) : "v"(lo), "v"(hi)); return r; }
__device__ __forceinline__ float bf2f(unsigned short b) { return __uint_as_float(((unsigned)b) << 16); }
__device__ __forceinline__ float bflo(unsigned w) { return __uint_as_float(w << 16); }
__device__ __forceinline__ float bfhi(unsigned w) { return __uint_as_float(w & 0xffff0000u); }
__device__ __forceinline__ float fast_exp2(float x) { return __builtin_amdgcn_exp2f(x); }
__device__ __forceinline__ float fast_rcp(float x) { return __builtin_amdgcn_rcpf(x); }
__device__ __forceinline__ float sigmoidf_(float x) { return fast_rcp(1.0f + fast_exp2(-1.4426950408889634f * x)); }
__device__ __forceinline__ float siluf_(float x) { return x * sigmoidf_(x); }
__device__ __forceinline__ float gelu_tanh_(float x) { const float u = 0.7978845608028654f * (x + 0.044715f * x * x * x); return x * fast_rcp(1.0f + fast_exp2(-2.885390081777927f * u)); }
__device__ __forceinline__ float wave_sum(float v) {
    int x = __float_as_int(v);
    v += __int_as_float(__builtin_amdgcn_update_dpp(0, x, 0xB1, 0xF, 0xF, false)); x = __float_as_int(v);
    v += __int_as_float(__builtin_amdgcn_update_dpp(0, x, 0x4E, 0xF, 0xF, false)); x = __float_as_int(v);
    v += __int_as_float(__builtin_amdgcn_update_dpp(0, x, 0x141, 0xF, 0xF, false)); x = __float_as_int(v);
    v += __int_as_float(__builtin_amdgcn_update_dpp(0, x, 0x140, 0xF, 0xF, false)); x = __float_as_int(v);
    return (__int_as_float(__builtin_amdgcn_readlane(x, 0)) + __int_as_float(__builtin_amdgcn_readlane(x, 16))) + (__int_as_float(__builtin_amdgcn_readlane(x, 32)) + __int_as_float(__builtin_amdgcn_readlane(x, 48)));
}
#define LDS_WAIT() asm volatile("s_waitcnt lgkmcnt(0)" ::: "memory")
#define VM_WAIT() asm volatile("s_waitcnt vmcnt(0)" ::: "memory")

#define XB_TMO      128
#define XB_XCNT(j)  (256  + 64 * (j))
#define XB_XSUB(j)  (1280 + 64 * (j))
#define XB_XGEN(j)  (2304 + 64 * (j))
#define XB_TOP      3328
#define XB_TOPGEN   3392
#define XCD_BAR_WORDS 3456
#define XB_SPIN_CAP (1u << 20)
__device__ __forceinline__ unsigned xb_ld(unsigned* p)              { return __hip_atomic_load(p, __ATOMIC_RELAXED, __HIP_MEMORY_SCOPE_AGENT); }
__device__ __forceinline__ unsigned xb_add(unsigned* p, unsigned v) { return __hip_atomic_fetch_add(p, v, __ATOMIC_RELAXED, __HIP_MEMORY_SCOPE_AGENT); }
__device__ __forceinline__ unsigned xb_xcc_id() { return (unsigned)__builtin_amdgcn_s_getreg((3 << 11) | 20) & 0xFu; }
#define XB_SPIN(cond, bar) do { unsigned _sp = 0; while (cond) { __builtin_amdgcn_s_sleep(1); \
    if ((++_sp & 255u) == 0u) { if (xb_ld(&(bar)[XB_TMO])) break; if (_sp > XB_SPIN_CAP) { atomicAdd(&(bar)[XB_TMO], 1u); break; } } } } while (0)
struct XcdBarrier { unsigned* bar; unsigned x; volatile LAS unsigned* st; };
__device__ __forceinline__ XcdBarrier xcd_barrier_post(unsigned* bar, volatile LAS unsigned* st) {
    XcdBarrier b; b.bar = bar; b.x = xb_xcc_id(); b.st = st;
    if (threadIdx.x == 0) (void)xb_add(&bar[XB_XCNT(b.x)], 1u);
    return b;
}
__device__ __forceinline__ void xcd_barrier_complete(unsigned* bar, unsigned x, unsigned& nloc, unsigned& nx) {
    const unsigned G = gridDim.x * gridDim.y * gridDim.z;
    unsigned sum, cnt, mine, sp = 0u;
    for (;;) {
        sum = 0u; cnt = 0u; mine = 0u;
#pragma unroll
        for (unsigned j = 0; j < 16; ++j) { const unsigned c = xb_ld(&bar[XB_XCNT(j)]); sum += c; cnt += (c > 0u) ? 1u : 0u; mine = (j == x) ? c : mine; }
        if (sum == G) break;
        __builtin_amdgcn_s_sleep(1);
        if ((++sp & 255u) == 0u) { if (xb_ld(&bar[XB_TMO])) break; if (sp > XB_SPIN_CAP) { atomicAdd(&bar[XB_TMO], 1u); break; } }
    }
    nloc = mine > 0u ? mine : 1u; nx = cnt > 0u ? cnt : 1u;
}
__device__ __forceinline__ void xcd_barrier(const XcdBarrier& b) {
    asm volatile("s_waitcnt vmcnt(0)" ::: "memory");
    __syncthreads();
    if (threadIdx.x == 0) {
        unsigned* bar = b.bar;
        __builtin_amdgcn_s_waitcnt(0);
        unsigned nloc = b.st[0], nx = b.st[1];
        if (nloc == 0u) { xcd_barrier_complete(bar, b.x, nloc, nx); b.st[0] = nloc; b.st[1] = nx; }
        const unsigned old = xb_add(&bar[XB_XSUB(b.x)], 1u);
        const unsigned gen = old / nloc;
        if (old + 1u == (gen + 1u) * nloc) {
            __builtin_amdgcn_fence(__ATOMIC_RELEASE, "agent");
            asm volatile("s_waitcnt vmcnt(0)" ::: "memory");
            const unsigned og = xb_add(&bar[XB_TOP], 1u);
            const unsigned tg = og / nx;
            if (og + 1u == (tg + 1u) * nx) xb_add(&bar[XB_TOPGEN], 1u);
            else XB_SPIN(xb_ld(&bar[XB_TOPGEN]) == tg, bar);
            __builtin_amdgcn_fence(__ATOMIC_ACQUIRE, "agent");
            xb_add(&bar[XB_XGEN(b.x)], 1u);
            asm volatile("s_waitcnt vmcnt(0)" ::: "memory");
        } else {
            XB_SPIN(xb_ld(&bar[XB_XGEN(b.x)]) == gen, bar);
            __builtin_amdgcn_fence(__ATOMIC_ACQUIRE, "agent");
            asm volatile("s_waitcnt vmcnt(0)" ::: "memory");
        }
    }
    __syncthreads();
}

namespace pg8 {
constexpr int BM = 256, BK = 64, HALF = 128, HTB = HALF * BK * 2, STAGE_BYTES = 8 * HTB, NXCD = 8, WGM = 8;
__host__ __device__ __forceinline__ int lds_byte(int r, int c) { const int st = (r >> 4) * 2 + (c >> 5), rr = r & 15, cc = c & 31, ob = rr * 64 + cc * 2; return st * 1024 + (ob ^ (((ob >> 9) & 1) << 5)); }
__host__ __device__ __forceinline__ void stage_rc(int b, int& R, int& C) { const int st = b / 1024, sb = b % 1024, swz = sb ^ (((sb >> 9) & 1) << 5); R = (st >> 1) * 16 + swz / 64; C = (st & 1) * 32 + (swz % 64) / 2; }
__host__ __device__ __forceinline__ int perm32(int rho) { const int n = rho >> 4, i = rho & 15; return 8 * (i >> 2) + 4 * n + (i & 3); }

struct Unit { int pm, pn, tag, gidx; size_t a_off, b_off; };
struct Gemm { const bf16_t* A; const bf16_t* Bt; int lda, ldb, K; int tiledA; const int* gather = nullptr; };

struct Order {
    int nM, nN, nwg, G, c;
    int mode;
    int nseg;
    int lda_rows;
    int ldb_rows;
    int seg_k;
    int n_per_group;
    int tstart[9];
    bool gathered;
    __device__ __forceinline__ void init(int nM_, int nN_, int G_, int c_, int mode_, int nseg_, int lda_, int ldb_, int segk_) {
        nM = nM_; nN = nN_; nwg = nM * nN; G = G_; c = c_; mode = mode_; nseg = nseg_; lda_rows = lda_; ldb_rows = ldb_; seg_k = segk_; n_per_group = 0; gathered = false;
    }
    __device__ __forceinline__ bool next(int i, Unit& u) const {
        const int ti = i / nseg, seg = i - ti * nseg;
        const long L = (long)ti * G + c;
        if (mode == 3) {
            if (L >= nwg + 80) return false;
            if (L >= nwg) { const int idx = (int)L - nwg, cb = idx / 5, j = idx - cb * 5; u.pm = cb * 9; u.pn = 7 + j; u.tag = 0; u.gidx = 0;
                u.a_off = (size_t)u.pm * BM * lda_rows; u.b_off = (size_t)u.pn * BM * ldb_rows; return true; }
        }
        if (L >= nwg) return false;
        int wgid = (int)L; { const int q = nwg / NXCD, r = nwg % NXCD, xcd = wgid % NXCD, off = wgid / NXCD; wgid = (xcd < r ? xcd * (q + 1) : r * (q + 1) + (xcd - r) * q) + off; }
        const int nig = WGM * nN, gid = wgid / nig, fm = gid * WGM, gsz = (nM - fm) < WGM ? (nM - fm) : WGM;
        int pm = fm + ((wgid % nig) % gsz); const int pn = (wgid % nig) / gsz;
        int grp = 0, gts = 0;
        if (mode == 1 || mode == 3) pm = (pm >> 3) * 9 + 1 + (pm & 7);
        if (mode == 2) {
#pragma unroll
            for (int e = 1; e < 8; ++e) { const bool ge = pm >= tstart[e]; grp += ge ? 1 : 0; gts = ge ? tstart[e] : gts; }
        }
        u.pm = pm; u.pn = pn; u.tag = (mode == 2) ? grp : seg; u.gidx = (mode == 2) ? grp * T + (pm - gts) * BM : 0;
        u.a_off = (gathered ? (size_t)0 : (size_t)pm * BM * lda_rows) + (size_t)seg * seg_k;
        u.b_off = ((size_t)grp * n_per_group + (size_t)pn * BM) * ldb_rows + (size_t)seg * seg_k * BM;
        return true;
    }
};

typedef f32x4 Acc[2][2][4][2];

template <class Epi, bool ALIGN_EPI, bool GATHER = false>
__device__ __forceinline__ void gemm_phase(LAS unsigned char* lds, const Gemm g, const Order& S, const Epi& E, const int tid) {
    const int wid = __builtin_amdgcn_readfirstlane(tid >> 6), lane = tid & 63, wr = wid >> 2, wc = wid & 3, fr = lane & 15, fq = lane >> 4;
    const int nt = g.K / BK;
    unsigned voffA[2], voffB[2];
#pragma unroll
    for (int i = 0; i < 2; ++i) { int R, C; stage_rc(tid * 16 + i * 8192, R, C); const int Rb = Epi::PERM ? ((R & ~31) + perm32(R & 31)) : R;
        voffA[i] = g.tiledA ? (unsigned)(tid * 16 + i * 8192) : (unsigned)(R * g.lda + C) * 2u; voffB[i] = (unsigned)(tid * 16 + i * 8192); (void)Rb; }
    int gR[2], gC[2]; unsigned cvo0[2] = {0u, 0u}, cvo1[2] = {0u, 0u}, nvo0[2] = {0u, 0u}, nvo1[2] = {0u, 0u};
#pragma unroll
    for (int i = 0; i < 2; ++i) stage_rc(tid * 16 + i * 8192, gR[i], gC[i]);
#define PG8_GLOAD(u_, o0, o1) do { _Pragma("unroll") for (int _i = 0; _i < 2; ++_i) { \
        o0[_i] = (unsigned)(g.gather[(u_).gidx + gR[_i]] * g.lda + gC[_i]) * 2u; o1[_i] = (unsigned)(g.gather[(u_).gidx + HALF + gR[_i]] * g.lda + gC[_i]) * 2u; } } while (0)
    const size_t kstep = (size_t)(BK * 2), kstepA = g.tiledA ? (size_t)32768 : kstep;
    const size_t hstepA = g.tiledA ? (size_t)16384 : (size_t)HALF * g.lda * 2, hstepB = 16384, kstepB = 32768;
    static_assert(Epi::PERM, "the tiled weight copies carry the PERM row order");
    const unsigned ldsw = (unsigned)wid * 1024u;
    const int aoff = lds_byte(wr * 64 + fr, fq * 8), boff = lds_byte(wc * 32 + fr, fq * 8);
#define PG8_SA(b, h) (((b) * 2 + (h)) * HTB)
#define PG8_SB(b, h) ((4 + (b) * 2 + (h)) * HTB)
#define PG8_STAGE(bufoff, gbase, voff) do { _Pragma("unroll") for (int _i = 0; _i < 2; ++_i) \
        __builtin_amdgcn_global_load_lds((const unsigned*)((const char*)(gbase) + (voff)[_i]), (LAS unsigned*)(lds + (bufoff) + ldsw + _i * 8192), 16, 0, 0); } while (0)
#define PG8_STA(bufoff, gbase, h, v0, v1) do { if constexpr (GATHER) { if (h) PG8_STAGE(bufoff, gbase, v1); else PG8_STAGE(bufoff, gbase, v0); } else PG8_STAGE(bufoff, (gbase) + (h) * hstepA, voffA); } while (0)
#define PG8_LDA(dst, b, h) do { _Pragma("unroll") for (int m = 0; m < 4; ++m) _Pragma("unroll") for (int k = 0; k < 2; ++k) dst[m][k] = *(const LAS bf16x8*)(lds + PG8_SA(b, h) + aoff + m * 2048 + k * 1024); } while (0)
#define PG8_LDB(dst, b, h) do { _Pragma("unroll") for (int n = 0; n < 2; ++n) _Pragma("unroll") for (int k = 0; k < 2; ++k) dst[n][k] = *(const LAS bf16x8*)(lds + PG8_SB(b, h) + boff + n * 2048 + k * 1024); } while (0)
#define PG8_MMA(ai, bj, At, Bt) do { __builtin_amdgcn_s_setprio(1); _Pragma("unroll") for (int m = 0; m < 4; ++m) _Pragma("unroll") for (int n = 0; n < 2; ++n) _Pragma("unroll") for (int k = 0; k < 2; ++k) \
        acc[ai][bj][m][n] = __builtin_amdgcn_mfma_f32_16x16x32_bf16(Bt[n][k], At[m][k], acc[ai][bj][m][n], 0, 0, 0); __builtin_amdgcn_s_setprio(0); } while (0)
#define PG8_WAIT_V(n) asm volatile("s_waitcnt vmcnt(" #n ")" ::: "memory")
#define PG8_WAIT_L(n) asm volatile("s_waitcnt lgkmcnt(" #n ")" ::: "memory")
#define PG8_BAR __builtin_amdgcn_s_barrier()
#define PG8_SCHED __builtin_amdgcn_sched_barrier(0)
    Unit cur, nxt; int ui = 0;
    if (!S.next(0, cur)) return;
    Acc acc;
#pragma unroll
    for (int a = 0; a < 2; ++a)
#pragma unroll
        for (int b = 0; b < 2; ++b)
#pragma unroll
            for (int m = 0; m < 4; ++m)
#pragma unroll
                for (int n = 0; n < 2; ++n) acc[a][b][m][n] = (f32x4){0.f, 0.f, 0.f, 0.f};
    bf16x8 At[4][2], B0[2][2], B1[2][2];
    const char* cA = (const char*)g.A + cur.a_off * 2; const char* cB = (const char*)g.Bt + cur.b_off * 2;
    if constexpr (GATHER) PG8_GLOAD(cur, cvo0, cvo1);
    PG8_STAGE(PG8_SB(0, 0), cB, voffB); PG8_STAGE(PG8_SB(0, 1), cB + hstepB, voffB); PG8_STA(PG8_SA(0, 0), cA, 0, cvo0, cvo1); PG8_STA(PG8_SA(0, 1), cA, 1, cvo0, cvo1);
    if (wr == 1) PG8_BAR;
    PG8_WAIT_V(2); PG8_BAR;
    PG8_STAGE(PG8_SB(1, 0), cB + kstepB, voffB); PG8_STA(PG8_SA(1, 0), cA + kstepA, 0, cvo0, cvo1); PG8_STAGE(PG8_SB(1, 1), cB + hstepB + kstepB, voffB);
    PG8_WAIT_V(6); PG8_BAR;
    for (;;) {
        const bool has_next = S.next(ui + 1, nxt);
        const char* nA = has_next ? (const char*)g.A + nxt.a_off * 2 : cA; const char* nB = has_next ? (const char*)g.Bt + nxt.b_off * 2 : cB;
        if constexpr (GATHER) { if (has_next) {
#pragma unroll
            for (int k = 0; k < 4; ++k) __builtin_amdgcn_global_load_lds((const unsigned*)(g.gather + nxt.gidx + (k >> 1) * HALF + gR[k & 1]), (LAS unsigned*)(lds + RING_BYTES + (wid * 4 + k) * 256), 4, 0, 0); } }
        for (int t = 0; t < nt; t += 2) {
            const bool last = (t == nt - 2);
            const char* a1 = cA + (size_t)(t + 1) * kstepA;
            const char* a2 = last ? nA : cA + (size_t)(t + 2) * kstepA; const char* b2 = last ? nB : cB + (size_t)(t + 2) * kstepB;
            const char* a3 = a2 + kstepA; const char* b3 = b2 + kstepB;
            unsigned s0[2] = {0u, 0u}, s1[2] = {0u, 0u};
            if constexpr (GATHER) {
                if (last && has_next) {
#pragma unroll
                    for (int i = 0; i < 2; ++i) { const int t0 = *(const LAS int*)(lds + RING_BYTES + (wid * 4 + i) * 256 + lane * 4), t1 = *(const LAS int*)(lds + RING_BYTES + (wid * 4 + 2 + i) * 256 + lane * 4);
                        nvo0[i] = (unsigned)(t0 * g.lda + gC[i]) * 2u; nvo1[i] = (unsigned)(t1 * g.lda + gC[i]) * 2u; } }
                else if (last) { nvo0[0] = cvo0[0]; nvo0[1] = cvo0[1]; nvo1[0] = cvo1[0]; nvo1[1] = cvo1[1]; }
                s0[0] = last ? nvo0[0] : cvo0[0]; s0[1] = last ? nvo0[1] : cvo0[1]; s1[0] = last ? nvo1[0] : cvo1[0]; s1[1] = last ? nvo1[1] : cvo1[1]; }
            PG8_LDB(B0, 0, 0); PG8_LDB(B1, 0, 1); PG8_SCHED; PG8_LDA(At, 0, 0); PG8_STA(PG8_SA(1, 1), a1, 1, cvo0, cvo1);
            PG8_WAIT_V(8); PG8_WAIT_L(0); PG8_BAR; PG8_MMA(0, 0, At, B0); PG8_MMA(0, 1, At, B1); PG8_BAR; PG8_SCHED;
            PG8_LDA(At, 0, 1); PG8_STAGE(PG8_SB(0, 0), b2, voffB); PG8_STAGE(PG8_SB(0, 1), b2 + hstepB, voffB); PG8_STA(PG8_SA(0, 0), a2, 0, s0, s1);
            PG8_WAIT_V(8); PG8_WAIT_L(0); PG8_BAR; PG8_MMA(1, 0, At, B0); PG8_MMA(1, 1, At, B1); PG8_BAR; PG8_SCHED;
            PG8_LDB(B0, 1, 0); PG8_LDB(B1, 1, 1); PG8_SCHED; PG8_LDA(At, 1, 0); PG8_STA(PG8_SA(0, 1), a2, 1, s0, s1);
            PG8_WAIT_V(8); PG8_WAIT_L(0); PG8_BAR; PG8_MMA(0, 0, At, B0); PG8_MMA(0, 1, At, B1); PG8_BAR; PG8_SCHED;
            PG8_LDA(At, 1, 1); PG8_STAGE(PG8_SB(1, 0), b3, voffB); PG8_STAGE(PG8_SB(1, 1), b3 + hstepB, voffB); PG8_STA(PG8_SA(1, 0), a3, 0, s0, s1);
            PG8_WAIT_V(8); PG8_WAIT_L(0); PG8_BAR; PG8_MMA(1, 0, At, B0); PG8_MMA(1, 1, At, B1); PG8_BAR; PG8_SCHED;
        }
        if constexpr (ALIGN_EPI) { if (wr == 0) PG8_BAR; }
        E(acc, cur, wr, wc, fr, fq);
        if (!has_next) break;
        if constexpr (!Epi::KEEP_ACC) {
#pragma unroll
            for (int a = 0; a < 2; ++a)
#pragma unroll
                for (int b = 0; b < 2; ++b)
#pragma unroll
                    for (int m = 0; m < 4; ++m)
#pragma unroll
                        for (int n = 0; n < 2; ++n) acc[a][b][m][n] = (f32x4){0.f, 0.f, 0.f, 0.f};
        }
        cur = nxt; cA = nA; cB = nB; ++ui;
        if constexpr (GATHER) { cvo0[0] = nvo0[0]; cvo0[1] = nvo0[1]; cvo1[0] = nvo1[0]; cvo1[1] = nvo1[1]; }
        if constexpr (ALIGN_EPI) { if (wr == 1) PG8_BAR; }
    }
    PG8_WAIT_V(0);
    if constexpr (!ALIGN_EPI) { if (wr == 0) PG8_BAR; }
    PG8_BAR;
#undef PG8_SA
#undef PG8_SB
#undef PG8_STAGE
#undef PG8_LDA
#undef PG8_STA
#undef PG8_GLOAD
#undef PG8_LDB
#undef PG8_MMA
#undef PG8_WAIT_V
#undef PG8_WAIT_L
#undef PG8_BAR
#undef PG8_SCHED
}

__device__ __forceinline__ u32x4 pack8(const f32x4 v0, const f32x4 v1) { u32x4 w; w.x = cvt_pk_bf16(v0[0], v0[1]); w.y = cvt_pk_bf16(v0[2], v0[3]); w.z = cvt_pk_bf16(v1[0], v1[1]); w.w = cvt_pk_bf16(v1[2], v1[3]); return w; }
__device__ __forceinline__ void unpack8(const u32x4 w, f32x4& v0, f32x4& v1) { v0 = (f32x4){bflo(w.x), bfhi(w.x), bflo(w.y), bfhi(w.y)}; v1 = (f32x4){bflo(w.z), bfhi(w.z), bflo(w.w), bfhi(w.w)}; }

__device__ __forceinline__ size_t tiled_a_off(int pm, int Ktot, int ai, int wr, int m, int fr, int fq, int c) {
    const int kt = c >> 6, st = ((4 * wr + m) << 1) + ((c >> 5) & 1), ob = (64 * fr + 16 * fq) ^ ((fr >> 3) << 5);
    return (size_t)pm * BM * Ktot + (size_t)kt * 16384 + ai * 8192 + st * 512 + (ob >> 1);
}
struct EpiPlain {
    static constexpr bool PERM = true, KEEP_ACC = false;
    bf16_t* O; int ldc;
    __device__ __forceinline__ void operator()(Acc& acc, const Unit& u, int wr, int wc, int fr, int fq) const {
        const int row0 = u.pm * BM + wr * 64 + fr, col0 = u.pn * BM + wc * 32 + 8 * fq;
#pragma unroll
        for (int ai = 0; ai < 2; ++ai)
#pragma unroll
            for (int m = 0; m < 4; ++m) { bf16_t* rowp = O + (size_t)(row0 + ai * HALF + m * 16) * ldc + col0;
#pragma unroll
                for (int bj = 0; bj < 2; ++bj) *(u32x4*)(rowp + bj * HALF) = pack8(acc[ai][bj][m][0], acc[ai][bj][m][1]); }
    }
};
struct EpiQ {
    static constexpr bool PERM = true, KEEP_ACC = false;
    bf16_t* Q; const float* gqn; const unsigned long long* stats; LAS float* red;
    __device__ __forceinline__ void operator()(Acc& acc, const Unit& u, int wr, int wc, int fr, int fq) const {
        asm volatile("" : "+v"(fr), "+v"(fq));
        const int b = u.pm / 9, tq = u.pm - b * 9, row0 = u.pm * BM + wr * 64 + fr;
        LAS f32x4* info = (LAS f32x4*)(red + 1536);
        const int rl = wc * 64 + fq * 16 + fr;
        unsigned long long s0 = 0;
        if (wr == 0) s0 = stats[(size_t)(u.pm * BM + rl) * 4];
        float g[8];
#pragma unroll
        for (int j = 0; j < 8; ++j) g[j] = gqn[32 * (wc < 3 ? wc : 0) + 8 * fq + j];
        if (wc < 3) {
#pragma unroll
            for (int ai = 0; ai < 2; ++ai)
#pragma unroll
                for (int bj = 0; bj < 2; ++bj)
#pragma unroll
                    for (int m = 0; m < 4; ++m) { const f32x4 p = acc[ai][bj][m][0] * acc[ai][bj][m][0] + acc[ai][bj][m][1] * acc[ai][bj][m][1];
                        float sq = (p[0] + p[1]) + (p[2] + p[3]); sq += __shfl_xor(sq, 16); sq += __shfl_xor(sq, 32);
                        if (fq == 0) red[((wr * 4 + ai * 2 + bj) * 3 + wc) * 64 + m * 16 + fr] = sq; }
        }
        asm volatile("s_waitcnt lgkmcnt(0)" ::: "memory"); __builtin_amdgcn_s_barrier(); asm volatile("" ::: "memory");
        if (wr == 0) {
            const float r = 1.0f / sqrtf((float)s0 * (1.0f / (1048576.0f * 768.0f)) + NORM_EPS);
            const int ri = ((((rl >> 6) & 1) * 4 + (rl >> 7) * 2) * 3) * 64 + (rl & 63);
            const float ss0 = red[ri] + red[ri + 64] + red[ri + 128], ss1 = red[ri + 192] + red[ri + 256] + red[ri + 320];
            info[rl] = (f32x4){r * QSCALE / sqrtf(ss0 * r * r * (1.0f / 96.0f) + NORM_EPS), r * QSCALE / sqrtf(ss1 * r * r * (1.0f / 96.0f) + NORM_EPS), 0.f, 0.f};
        }
        asm volatile("s_waitcnt lgkmcnt(0)" ::: "memory"); __builtin_amdgcn_s_barrier(); asm volatile("" ::: "memory");
        if (wc < 3) {
            const float sgn = (fq & 1) ? 1.0f : -1.0f;
#pragma unroll
            for (int ai = 0; ai < 2; ++ai)
#pragma unroll
                for (int m = 0; m < 4; ++m) { const f32x4 inf = info[ai * HALF + wr * 64 + m * 16 + fr]; const int tk = tq * 4 + 2 * ai + wr;
                    bf16_t* qp = Q + (size_t)(row0 + ai * HALF + m * 16) * 768 + 96 * (2 * u.pn) + 32 * wc + 8 * fq;
#pragma unroll
                    for (int bj = 0; bj < 2; ++bj) { const float sc = inf[bj];
                        f32x4 v0, v1;
#pragma unroll
                        for (int i = 0; i < 4; ++i) { v0[i] = acc[ai][bj][m][0][i] * sc * g[i]; v1[i] = acc[ai][bj][m][1][i] * sc * g[4 + i]; }
                        if (wc == 2 && tq > 0) { const LAS f32x4* tp = (const LAS f32x4*)(red + 2560) + ((fq >> 1) == 0 ? (tk - 4) : (16 * m + fr)) * 4;
                            const f32x4 c0 = tp[0], c1 = tp[1], c2 = tp[2], c3 = tp[3];
                            f32x4 p0, p1;
#pragma unroll
                            for (int i = 0; i < 4; ++i) { p0[i] = __shfl_xor(v0[i], 16); p1[i] = __shfl_xor(v1[i], 16); }
                            v0[0] = v0[0] * c0[0] + sgn * p0[0] * c0[1]; v0[1] = v0[1] * c0[2] + sgn * p0[1] * c0[3]; v0[2] = v0[2] * c1[0] + sgn * p0[2] * c1[1]; v0[3] = v0[3] * c1[2] + sgn * p0[3] * c1[3];
                            v1[0] = v1[0] * c2[0] + sgn * p1[0] * c2[1]; v1[1] = v1[1] * c2[2] + sgn * p1[1] * c2[3]; v1[2] = v1[2] * c3[0] + sgn * p1[2] * c3[1]; v1[3] = v1[3] * c3[2] + sgn * p1[3] * c3[3]; }
                        *(u32x4*)(qp + 96 * bj) = pack8(v0, v1); } }
        }
        asm volatile("" :: "v"(g[0]), "v"(g[1]), "v"(g[2]), "v"(g[3]), "v"(g[4]), "v"(g[5]), "v"(g[6]), "v"(g[7]));
    }
};
struct EpiKV {
    static constexpr bool PERM = true, KEEP_ACC = false;
    bf16_t* Kt; bf16_t* Vt; const bf16_t* KR; const float* gkn; const unsigned long long* stats; LAS float* red;
    __device__ __forceinline__ void operator()(Acc& acc, const Unit& u, int wr, int wc, int fr, int fq) const {
        asm volatile("" : "+v"(fr), "+v"(fq));
        const int b = u.pm / 9, tq = u.pm - b * 9, row0 = u.pm * BM + wr * 64 + fr;
        const bool kw = wc < 2;
        LAS f32x4* info = (LAS f32x4*)(red + 1536);
        const int rl = wc * 64 + fq * 16 + fr;
        unsigned long long s1 = 0, s2 = 0;
        if (wr == 0) { s1 = stats[(size_t)(u.pm * BM + rl) * 4 + 1]; s2 = stats[(size_t)(u.pm * BM + rl) * 4 + 2]; }
        u32x4 krw[2][4];
#pragma unroll
        for (int ai = 0; ai < 2; ++ai)
#pragma unroll
            for (int m = 0; m < 4; ++m) { krw[ai][m] = (u32x4){0u, 0u, 0u, 0u}; if (!kw) krw[ai][m] = *(const u32x4*)(KR + (size_t)(row0 + ai * HALF + m * 16) * 32 + 8 * fq); }
        float gk[8], gp[8];
#pragma unroll
        for (int j = 0; j < 8; ++j) { gk[j] = gkn[(kw ? 32 * wc : 64) + 8 * fq + j]; gp[j] = gkn[64 + 8 * (fq ^ 1) + j]; }
        if (kw) {
#pragma unroll
            for (int ai = 0; ai < 2; ++ai)
#pragma unroll
                for (int bj = 0; bj < 2; ++bj)
#pragma unroll
                    for (int m = 0; m < 4; ++m) { const f32x4 p = acc[ai][bj][m][0] * acc[ai][bj][m][0] + acc[ai][bj][m][1] * acc[ai][bj][m][1];
                        float sq = (p[0] + p[1]) + (p[2] + p[3]); sq += __shfl_xor(sq, 16); sq += __shfl_xor(sq, 32);
                        if (fq == 0) red[((wr * 4 + ai * 2 + bj) * 2 + wc) * 64 + m * 16 + fr] = sq; }
        }
        asm volatile("s_waitcnt lgkmcnt(0)" ::: "memory"); __builtin_amdgcn_s_barrier(); asm volatile("" ::: "memory");
        if (wr == 0) {
            const float r = 1.0f / sqrtf((float)s1 * (1.0f / (1048576.0f * 256.0f)) + NORM_EPS), krss = (float)s2 * (1.0f / 1048576.0f);
            const int ri = ((((rl >> 6) & 1) * 4 + (rl >> 7) * 2) * 2) * 64 + (rl & 63);
            const float ss0 = red[ri] + red[ri + 64], ss1 = red[ri + 128] + red[ri + 192];
            info[rl] = (f32x4){r, 1.0f / sqrtf((ss0 * r * r + krss) * (1.0f / 96.0f) + NORM_EPS), 1.0f / sqrtf((ss1 * r * r + krss) * (1.0f / 96.0f) + NORM_EPS), 0.f};
        }
        asm volatile("s_waitcnt lgkmcnt(0)" ::: "memory"); __builtin_amdgcn_s_barrier(); asm volatile("" ::: "memory");
        if (kw) {
#pragma unroll
            for (int ai = 0; ai < 2; ++ai)
#pragma unroll
                for (int m = 0; m < 4; ++m) { const f32x4 inf = info[ai * HALF + wr * 64 + m * 16 + fr];
#pragma unroll
                    for (int bj = 0; bj < 2; ++bj) { const float sc = inf[0] * inf[1 + bj];
                        f32x4 v0, v1;
#pragma unroll
                        for (int i = 0; i < 4; ++i) { v0[i] = acc[ai][bj][m][0][i] * sc * gk[i]; v1[i] = acc[ai][bj][m][1][i] * sc * gk[4 + i]; }
                        *(u32x4*)(Kt + ((size_t)((b * 8 + 2 * u.pn + bj) * 36 + tq * 4 + 2 * ai + wr) * 12 + 4 * wc + fq) * 512 + (16 * m + fr) * 8) = pack8(v0, v1); } }
        } else {
            const int dh = wc - 2;
            const float sgn = (fq & 1) ? 1.0f : -1.0f;
#pragma unroll
            for (int ai = 0; ai < 2; ++ai)
#pragma unroll
                for (int m = 0; m < 4; ++m) { const int tk = tq * 4 + 2 * ai + wr; const float r = info[ai * HALF + wr * 64 + m * 16 + fr][0];
#pragma unroll
                    for (int bj = 0; bj < 2; ++bj)
                        *(u32x4*)(Vt + ((size_t)(((((b * 8 + 2 * u.pn + bj) * 36 + tk) * 2 + dh) * 4 + m) * 16 + fr)) * 32 + fq * 8) = pack8(acc[ai][bj][m][0] * r, acc[ai][bj][m][1] * r); }
            __builtin_amdgcn_sched_barrier(0);
#pragma unroll
            for (int ai = 0; ai < 2; ++ai)
#pragma unroll
                for (int m = 0; m < 4; ++m) { const int tk = tq * 4 + 2 * ai + wr; const f32x4 inf = info[ai * HALF + wr * 64 + m * 16 + fr]; const float n = dh ? inf[2] : inf[1];
                    const u32x4 wo = krw[ai][m]; u32x4 wp;
                    wp.x = (unsigned)__shfl_xor((int)wo.x, 16); wp.y = (unsigned)__shfl_xor((int)wo.y, 16); wp.z = (unsigned)__shfl_xor((int)wo.z, 16); wp.w = (unsigned)__shfl_xor((int)wo.w, 16);
                    f32x4 x0, x1, p0, p1; unpack8(wo, x0, x1); unpack8(wp, p0, p1);
                    f32x4 o0, o1;
                    if (tq > 0) { const LAS f32x4* tp = (const LAS f32x4*)(red + 2560) + ((fq >> 1) == 0 ? (tk - 4) : (16 * m + fr)) * 4;
                        const f32x4 c0 = tp[0], c1 = tp[1], c2 = tp[2], c3 = tp[3];
#define EKV_ROT(o, i, xo, xp, j, cc, sv) o[i] = (xo) * n * gk[j] * (cc) + sgn * ((xp) * n * gp[j]) * (sv);
                        EKV_ROT(o0, 0, x0[0], p0[0], 0, c0[0], c0[1]) EKV_ROT(o0, 1, x0[1], p0[1], 1, c0[2], c0[3]) EKV_ROT(o0, 2, x0[2], p0[2], 2, c1[0], c1[1]) EKV_ROT(o0, 3, x0[3], p0[3], 3, c1[2], c1[3])
                        EKV_ROT(o1, 0, x1[0], p1[0], 4, c2[0], c2[1]) EKV_ROT(o1, 1, x1[1], p1[1], 5, c2[2], c2[3]) EKV_ROT(o1, 2, x1[2], p1[2], 6, c3[0], c3[1]) EKV_ROT(o1, 3, x1[3], p1[3], 7, c3[2], c3[3])
#undef EKV_ROT
                    } else {
#pragma unroll
                        for (int i = 0; i < 4; ++i) { o0[i] = x0[i] * n * gk[i]; o1[i] = x1[i] * n * gk[4 + i]; }
                    }
                    *(u32x4*)(Kt + ((size_t)((b * 8 + 2 * u.pn + dh) * 36 + tk) * 12 + 8 + fq) * 512 + (16 * m + fr) * 8) = pack8(o0, o1);
                    __builtin_amdgcn_sched_barrier(0); }
        }
        asm volatile("" :: "v"(gk[0]), "v"(gk[1]), "v"(gk[2]), "v"(gk[3]), "v"(gk[4]), "v"(gk[5]), "v"(gk[6]), "v"(gk[7]));
        asm volatile("" :: "v"(gp[0]), "v"(gp[1]), "v"(gp[2]), "v"(gp[3]), "v"(gp[4]), "v"(gp[5]), "v"(gp[6]), "v"(gp[7]));
    }
};
struct EpiSwiGLU {
    static constexpr bool PERM = true, KEEP_ACC = false;
    bf16_t* O; int ldc;
    __device__ __forceinline__ void operator()(Acc& acc, const Unit& u, int wr, int wc, int fr, int fq) const {
        const int cbase = u.pn * HALF + wc * 32;
#pragma unroll
        for (int ai = 0; ai < 2; ++ai)
#pragma unroll
            for (int m = 0; m < 4; ++m) { bf16_t* rowp = O + tiled_a_off(u.pm, ldc, ai, wr, m, fr, fq, cbase);
                f32x4 v0, v1;
#pragma unroll
                for (int i = 0; i < 4; ++i) { v0[i] = siluf_(acc[ai][0][m][0][i]) * acc[ai][1][m][0][i]; v1[i] = siluf_(acc[ai][0][m][1][i]) * acc[ai][1][m][1][i]; }
                *(u32x4*)rowp = pack8(v0, v1); }
    }
};
struct EpiWin {
    static constexpr bool PERM = true, KEEP_ACC = false;
    bf16_t *U, *ZQ, *ZKV, *ZR, *G, *KR; const float* bgate; unsigned long long* stats;
    __device__ __forceinline__ void operator()(Acc& acc, const Unit& u, int wr, int wc, int fr, int fq) const {
        const int row0 = u.pm * BM + wr * 64 + fr, cl = wc * 32 + 8 * fq, pn = u.pn;
        if (pn < 4) {
#pragma unroll
            for (int ai = 0; ai < 2; ++ai)
#pragma unroll
                for (int m = 0; m < 4; ++m) { bf16_t* rowp = U + (size_t)(row0 + ai * HALF + m * 16) * 512 + pn * HALF + cl;
                    f32x4 v0, v1;
#pragma unroll
                    for (int i = 0; i < 4; ++i) { v0[i] = acc[ai][0][m][0][i] * sigmoidf_(acc[ai][1][m][0][i]); v1[i] = acc[ai][0][m][1][i] * sigmoidf_(acc[ai][1][m][1][i]); }
                    *(u32x4*)rowp = pack8(v0, v1); }
        } else if (pn == 24) {
            if (wc == 0) {
#pragma unroll
                for (int ai = 0; ai < 2; ++ai)
#pragma unroll
                    for (int m = 0; m < 4; ++m) { const int row = row0 + ai * HALF + m * 16;
                        *(u32x4*)(KR + (size_t)row * 32 + 8 * fq) = pack8(acc[ai][0][m][0], acc[ai][0][m][1]);
                        const f32x4 s4 = acc[ai][0][m][0] * acc[ai][0][m][0] + acc[ai][0][m][1] * acc[ai][0][m][1];
                        float sq = (s4[0] + s4[1]) + (s4[2] + s4[3]); sq += __shfl_xor(sq, 16); sq += __shfl_xor(sq, 32);
                        if (fq == 0) (void)__hip_atomic_fetch_add(stats + (size_t)row * 4 + 2, (unsigned long long)(sq * 1048576.0f), __ATOMIC_RELAXED, __HIP_MEMORY_SCOPE_AGENT); }
            }
        } else if (pn >= 12) {
            const int cb = (pn - 12) * BM;
            unsigned char* gq = (unsigned char*)G + ((((size_t)(u.pm * 12 + (pn - 12)) * 8 + (wr * 4 + wc)) * 8) * 64 + (fq * 16 + fr)) * 16;
            f32x4 bv[2][2];
#pragma unroll
            for (int bj = 0; bj < 2; ++bj)
#pragma unroll
                for (int n = 0; n < 2; ++n) bv[bj][n] = *(const f32x4*)(bgate + cb + bj * HALF + cl + 4 * n);
#pragma unroll
            for (int ai = 0; ai < 2; ++ai)
#pragma unroll
                for (int m = 0; m < 4; ++m) { unsigned w[4] = {0u, 0u, 0u, 0u};
#pragma unroll
                    for (int bj = 0; bj < 2; ++bj)
#pragma unroll
                        for (int n = 0; n < 2; ++n)
#pragma unroll
                            for (int i = 0; i < 4; ++i) w[bj * 2 + n] = __builtin_amdgcn_cvt_pk_u8_f32(fmaf(sigmoidf_(acc[ai][bj][m][n][i] + bv[bj][n][i]), 254.0f, 1.0f), i, w[bj * 2 + n]);
                    *(u32x4*)(gq + (size_t)((ai * 4 + m) * 64) * 16) = (u32x4){w[0], w[1], w[2], w[3]}; }
        } else {
            bf16_t* base; int ldc, cb, act = 0;
            if (pn < 7) { base = ZQ; ldc = 768; cb = (pn - 4) * BM; }
            else if (pn == 7) { base = ZKV; ldc = 256; cb = 0; }
            else { base = ZR; ldc = 1024; cb = (pn - 8) * BM; act = (pn >= 10) ? 1 : 0; }
#pragma unroll
            for (int ai = 0; ai < 2; ++ai)
#pragma unroll
                for (int m = 0; m < 4; ++m) { bf16_t* rowp = base + (size_t)(row0 + ai * HALF + m * 16) * ldc + cb + cl;
#pragma unroll
                    for (int bj = 0; bj < 2; ++bj) { f32x4 v0 = acc[ai][bj][m][0], v1 = acc[ai][bj][m][1];
                        if (act == 1) {
#pragma unroll
                            for (int i = 0; i < 4; ++i) { v0[i] = gelu_tanh_(v0[i]); v1[i] = gelu_tanh_(v1[i]); } }
                        *(u32x4*)(rowp + bj * HALF) = pack8(v0, v1); }
                    if (pn < 8) {
                        const f32x4 s4 = (acc[ai][0][m][0] * acc[ai][0][m][0] + acc[ai][0][m][1] * acc[ai][0][m][1]) + (acc[ai][1][m][0] * acc[ai][1][m][0] + acc[ai][1][m][1] * acc[ai][1][m][1]);
                        float sq = (s4[0] + s4[1]) + (s4[2] + s4[3]); sq += __shfl_xor(sq, 16); sq += __shfl_xor(sq, 32);
                        if (fq == 0) (void)__hip_atomic_fetch_add(stats + (size_t)(row0 + ai * HALF + m * 16) * 4 + (pn == 7 ? 1 : 0), (unsigned long long)(sq * 1048576.0f), __ATOMIC_RELAXED, __HIP_MEMORY_SCOPE_AGENT); } }
        }
    }
};
struct EpiMerge {
    static constexpr bool PERM = true, KEEP_ACC = true;
    const bf16_t* G; bf16_t* M;
    __device__ __forceinline__ static void codes(unsigned w, f32x4& v) { v[0] = (float)(w & 0xffu); v[1] = (float)((w >> 8) & 0xffu); v[2] = (float)((w >> 16) & 0xffu); v[3] = (float)(w >> 24); }
    __device__ __forceinline__ void operator()(Acc& acc, const Unit& u, int wr, int wc, int fr, int fq) const {
        const int seg = u.tag;
        const unsigned char* gbase = (const unsigned char*)G + ((((size_t)(u.pm * 12 + seg * 4 + u.pn) * 8 + (wr * 4 + wc)) * 8) * 64 + (fq * 16 + fr)) * 16;
        const size_t nxt = (seg < 2) ? (size_t)4 * 8 * 8 * 64 * 16 : 0;
#pragma unroll
        for (int ai = 0; ai < 2; ++ai)
#pragma unroll
            for (int mh = 0; mh < 2; ++mh) {
                u32x4 ga[2], gb[2];
#pragma unroll
                for (int mm = 0; mm < 2; ++mm) { const unsigned char* gp = gbase + (size_t)((ai * 4 + 2 * mh + mm) * 64) * 16; ga[mm] = *(const u32x4*)gp; gb[mm] = *(const u32x4*)(gp + nxt); }
                asm volatile("" ::: "memory");
#pragma unroll
                for (int mm = 0; mm < 2; ++mm) { const int m = 2 * mh + mm;
#pragma unroll
                    for (int bj = 0; bj < 2; ++bj) { f32x4 a0, a1; codes(ga[mm][2 * bj], a0); codes(ga[mm][2 * bj + 1], a1);
                        if (seg < 2) { f32x4 b0, b1; codes(gb[mm][2 * bj], b0); codes(gb[mm][2 * bj + 1], b1);
#pragma unroll
                            for (int i = 0; i < 4; ++i) { acc[ai][bj][m][0][i] *= a0[i] * fast_rcp(b0[i]); acc[ai][bj][m][1][i] *= a1[i] * fast_rcp(b1[i]); }
                        } else {
                            *(u32x4*)(M + tiled_a_off(u.pm, 1024, ai, wr, m, fr, fq, u.pn * BM + bj * HALF + wc * 32)) = pack8(acc[ai][bj][m][0] * (a0 * (1.0f / 255.0f)), acc[ai][bj][m][1] * (a1 * (1.0f / 255.0f)));
                            acc[ai][bj][m][0] = (f32x4){0.f, 0.f, 0.f, 0.f}; acc[ai][bj][m][1] = (f32x4){0.f, 0.f, 0.f, 0.f};
                        } } }
                asm volatile("" ::: "memory"); }
    }
};
struct EpiResid {
    static constexpr bool PERM = true, KEEP_ACC = false;
    bf16_t* X; const float* mod; int gsel;
    __device__ __forceinline__ void operator()(Acc& acc, const Unit& u, int wr, int wc, int fr, int fq) const {
        const int b = u.pm / 9, j = u.pm - b * 9, mi = (j == 0) ? 16 : b;
        const float* ga = mod + (size_t)mi * 6144 + gsel * 1024;
        const int col0 = u.pn * BM + wc * 32 + 8 * fq;
        bf16_t* xb = X + (size_t)(u.pm * BM + wr * 64 + fr) * DM + col0;
        f32x4 gv[2][2];
#pragma unroll
        for (int bj = 0; bj < 2; ++bj)
#pragma unroll
            for (int n = 0; n < 2; ++n) gv[bj][n] = *(const f32x4*)(ga + col0 + bj * HALF + 4 * n);
#pragma unroll
        for (int ai = 0; ai < 2; ++ai)
#pragma unroll
            for (int mh = 0; mh < 2; ++mh) {
                u32x4 xw[2][2];
#pragma unroll
                for (int mm = 0; mm < 2; ++mm)
#pragma unroll
                    for (int bj = 0; bj < 2; ++bj) xw[mm][bj] = *(const u32x4*)(xb + (size_t)(ai * HALF + (2 * mh + mm) * 16) * DM + bj * HALF);
                asm volatile("" ::: "memory");
#pragma unroll
                for (int mm = 0; mm < 2; ++mm) { const int m = 2 * mh + mm;
#pragma unroll
                    for (int bj = 0; bj < 2; ++bj) { f32x4 x0, x1; unpack8(xw[mm][bj], x0, x1);
                        *(u32x4*)(xb + (size_t)(ai * HALF + m * 16) * DM + bj * HALF) = pack8(x0 + gv[bj][0] * acc[ai][bj][m][0], x1 + gv[bj][1] * acc[ai][bj][m][1]); } }
                asm volatile("" ::: "memory"); }
    }
};
}

struct Args {
    const float* in[38];
    float* out; unsigned char* ws;
    int ph_lo, ph_hi;
};
enum InIdx { I_X = 0, I_C, I_CTX, I_CCTX, I_WADA, I_BADA, I_GN1, I_GN2, I_WIN, I_BGATE, I_CONVW, I_CONVB, I_CLNG, I_CLNB, I_WOCONV, I_GQA, I_WQB, I_GKVA, I_WKVB, I_GQN, I_GKN, I_WOMLA,
             I_RCW, I_RCB, I_WRA, I_BRA, I_WRI, I_BRI, I_LAM, I_WOREC, I_WOUT, I_WFG, I_WFU, I_WFD, I_WROUTER, I_WEG, I_WEU, I_WED };

struct Frame {
    LAS unsigned char* lds;
    int tid, lane, wave, G, bid;
    unsigned char* ws;
};

__device__ __forceinline__ void tr_tile(const float* src, int ld_src, int col0, int nvalid, int k0, const float* kscale, bf16_t* dst, int Ktot, int n0, int kd0, LAS float* scr, int lane) {
    const int c4 = (lane & 15) * 4, rsub = lane >> 4;
#pragma unroll 4
    for (int i = 0; i < 16; ++i) { const int kk = 4 * i + rsub;
        f32x4 v = (f32x4){0.f, 0.f, 0.f, 0.f};
        if (c4 < nvalid) v = *(const f32x4*)(src + (size_t)(k0 + kk) * ld_src + col0 + c4);
        if (kscale) v = v * kscale[k0 + kk];
        scr[kk * 65 + c4] = v[0]; scr[kk * 65 + c4 + 1] = v[1]; scr[kk * 65 + c4 + 2] = v[2]; scr[kk * 65 + c4 + 3] = v[3]; }
    LDS_WAIT(); asm volatile("" ::: "memory");
    const int c = lane & 7;
    bf16_t* tbase = dst + ((size_t)((n0 >> 8) * (Ktot >> 6) + (kd0 >> 6)) * 2 + ((n0 >> 7) & 1)) * 8192;
    float tv[8][8];
#pragma unroll
    for (int j = 0; j < 8; ++j) { const LAS float* s = scr + (8 * c) * 65 + (lane >> 3) + 8 * j;
#pragma unroll
        for (int q = 0; q < 8; ++q) tv[j][q] = s[q * 65]; }
    __builtin_amdgcn_sched_barrier(0);
#pragma unroll
    for (int j = 0; j < 8; ++j) { const int n = (lane >> 3) + 8 * j;
        u32x4 o; o.x = cvt_pk_bf16(tv[j][0], tv[j][1]); o.y = cvt_pk_bf16(tv[j][2], tv[j][3]); o.z = cvt_pk_bf16(tv[j][4], tv[j][5]); o.w = cvt_pk_bf16(tv[j][6], tv[j][7]);
        const int nh = (n0 & 64) + n, v32 = nh & 31, rho = (nh & ~31) + (((v32 >> 2) & 1) << 4) + ((v32 >> 3) << 2) + (v32 & 3);
        *(u32x4*)(tbase + (pg8::lds_byte(rho, 8 * c) >> 1)) = o; }
    LDS_WAIT(); asm volatile("" ::: "memory");
}
__device__ __forceinline__ void tr_plain(int item, const float* src, int K, int N, const float* kscale, bf16_t* dst, int ld_dst, int dk0, LAS float* scr, int lane) {
    const int nnb = N / 64, kb = item / nnb, nb = item - kb * nnb;
    tr_tile(src, N, nb * 64, 64, kb * 64, kscale, dst, ld_dst, nb * 64, dk0 + kb * 64, scr, lane);
}
__device__ __forceinline__ void tr_gu(int item, const float* wg, const float* wu, bf16_t* dst, LAS float* scr, int lane) {
    const int kb = item / 112, nb = item - kb * 112;
    const int tile = nb >> 2, sub = nb & 3;
    const float* src = (sub < 2) ? wg : wu; const int col = tile * 128 + (sub & 1) * 64;
    tr_tile(src, DFF, col, 64, kb * 64, nullptr, dst, 1024, nb * 64, kb * 64, scr, lane);
}
__device__ __forceinline__ void tr_win(int item, const float* w, bf16_t* dst, LAS float* scr, int lane) {
    const int kb = item / 96, nb = item - kb * 96;
    int col, nv = 64; const int row = nb * 64;
    if (nb < 16) { const int tile = nb >> 2, sub = nb & 3; col = (sub < 2 ? 0 : 512) + tile * 128 + (sub & 1) * 64; }
    else if (nb < 32) col = 1024 + (row - 1024);
    else if (nb < 48) col = 2080 + (row - 2048);
    else col = 3104 + (row - 3072);
    tr_tile(w, IN_COLS, col, nv, kb * 64, nullptr, dst, 1024, row, kb * 64, scr, lane);
}
__device__ __forceinline__ void rec_frag_item(int item, const float* wra, const float* wri, bf16_t* dst, int lane) {
    const int s = item & 3, cb = (item >> 2) & 1, g = (item >> 3) & 7, gate = (item >> 6) & 1, d = (item >> 7) & 1;
    const float* w = (gate ? wri : wra) + ((size_t)(d * 8 + g)) * 4096;
    const int r = lane & 31, h = lane >> 5;
    float v[8];
#pragma unroll
    for (int jj = 0; jj < 8; ++jj) v[jj] = w[(16 * s + 8 * h + jj) * 64 + 32 * cb + r];
    u32x4 o; o.x = cvt_pk_bf16(v[0], v[1]); o.y = cvt_pk_bf16(v[2], v[3]); o.z = cvt_pk_bf16(v[4], v[5]); o.w = cvt_pk_bf16(v[6], v[7]);
    *(u32x4*)(dst + ((size_t)item * 64 + lane) * 8) = o;
}

__device__ __forceinline__ void krope_frag_item(int s, const float* w, bf16_t* dst, int lane) {
    const int r = lane & 31, h = lane >> 5;
    float v[8];
#pragma unroll
    for (int jj = 0; jj < 8; ++jj) v[jj] = w[(size_t)(16 * s + 8 * h + jj) * IN_COLS + 2048 + r];
    u32x4 o; o.x = cvt_pk_bf16(v[0], v[1]); o.y = cvt_pk_bf16(v[2], v[3]); o.z = cvt_pk_bf16(v[4], v[5]); o.w = cvt_pk_bf16(v[6], v[7]);
    *(u32x4*)(dst + ((size_t)s * 64 + lane) * 8) = o;
}
constexpr int CC_PER_LAYER = 96 * 16 + 3 * 16 * 8 + 12 * 16 + 16 * 4 + 16 * 16 + 256 + 64, CC_PER_FF = 112 * 16 + 16 * 56, CC_NITEMS = DEPTH * CC_PER_LAYER + 2 * CC_PER_FF;
__device__ __forceinline__ void convert_common(const Args& a, const Frame& F, int it_lo, int it_hi, int wg_i, int n_wg) {
    if (wg_i < 0) return;
    LAS float* scr = (LAS float*)(F.lds + F.wave * 16640);
    const int gw = wg_i * NWAVES + F.wave, NGW = n_wg * NWAVES;
    constexpr int I_WIN_N = 96 * 16, I_CAT = 16 * 8, I_QB = 12 * 16, I_KVB = 16 * 4, I_OUT = 16 * 16, I_REC = 256, I_KR = 64;
    constexpr int PER_LAYER = I_WIN_N + 3 * I_CAT + I_QB + I_KVB + I_OUT + I_REC + I_KR;
    constexpr int I_GU = 112 * 16, I_D = 16 * 56, PER_FF = I_GU + I_D;
    static_assert(PER_LAYER == CC_PER_LAYER && PER_FF == CC_PER_FF, "conversion item counts");
    for (int it = it_lo + gw; it < it_hi; it += NGW) {
        if (it < DEPTH * PER_LAYER) {
            const int l = it / PER_LAYER; int r = it - l * PER_LAYER;
            if (r < I_WIN_N) { tr_win(r, a.in[I_WIN] + (size_t)l * DM * IN_COLS, (bf16_t*)(a.ws + WS_WIN) + (size_t)l * NWIN * DM, scr, F.lane); continue; } r -= I_WIN_N;
            if (r < 3 * I_CAT) { const int which = r / I_CAT; r -= which * I_CAT;
                const float* src = a.in[which == 0 ? I_WOCONV : (which == 1 ? I_WOMLA : I_WOREC)] + (size_t)l * 512 * 1024;
                tr_plain(r, src, 512, 1024, nullptr, (bf16_t*)(a.ws + WS_WCAT) + (size_t)l * 1024 * 1536, 1536, which * 512, scr, F.lane); continue; } r -= 3 * I_CAT;
            if (r < I_QB) { const int kb = r >> 4, nb = r & 15, hh = nb >> 1, sub = nb & 1;
                tr_tile(a.in[I_WQB] + (size_t)l * 768 * 768, 768, 96 * hh + 64 * sub, sub ? 32 : 64, kb * 64, a.in[I_GQA] + l * 768, (bf16_t*)(a.ws + WS_WQB) + (size_t)l * 1024 * 768, 768, nb * 64, kb * 64, scr, F.lane); continue; } r -= I_QB;
            if (r < I_KVB) { tr_plain(r, a.in[I_WKVB] + (size_t)l * 256 * 1024, 256, 1024, a.in[I_GKVA] + l * 256, (bf16_t*)(a.ws + WS_WKVB) + (size_t)l * 1024 * 256, 256, 0, scr, F.lane); continue; } r -= I_KVB;
            if (r < I_OUT) { tr_plain(r, a.in[I_WOUT] + (size_t)l * 1024 * 1024, 1024, 1024, nullptr, (bf16_t*)(a.ws + WS_WOUT) + (size_t)l * 1024 * 1024, 1024, 0, scr, F.lane); continue; } r -= I_OUT;
            if (r < I_REC) { rec_frag_item(r, a.in[I_WRA] + (size_t)l * 2 * 8 * 4096, a.in[I_WRI] + (size_t)l * 2 * 8 * 4096, (bf16_t*)(a.ws + WS_WREC) + (size_t)l * 256 * 512, F.lane); continue; } r -= I_REC;
            krope_frag_item(r, a.in[I_WIN] + (size_t)l * DM * IN_COLS, (bf16_t*)(a.ws + WS_WKR) + (size_t)l * 64 * 512, F.lane);
        } else {
            int r = it - DEPTH * PER_LAYER; const int j = r / PER_FF; r -= j * PER_FF;
            if (r < I_GU) tr_gu(r, a.in[I_WFG] + (size_t)j * DM * DFF, a.in[I_WFU] + (size_t)j * DM * DFF, (bf16_t*)(a.ws + WS_WFFGU) + (size_t)j * 7168 * 1024, scr, F.lane);
            else tr_plain(r - I_GU, a.in[I_WFD] + (size_t)j * DFF * DM, DFF, DM, nullptr, (bf16_t*)(a.ws + WS_WFFD) + (size_t)j * 1024 * DFF, DFF, 0, scr, F.lane);
        }
    }
}
constexpr int MOE_CVT_ITEMS = NEXP * (112 * 16 + 16 * 56), CVT_SPLIT1 = 6200, CVT_SPLIT2 = 10700;
__device__ __forceinline__ void convert_moe(const Args& a, const Frame& F, int j, int it_lo, int it_hi, int wg_i, int n_wg) {
    if (wg_i < 0) return;
    LAS float* scr = (LAS float*)(F.lds + F.wave * 16640);
    const int gw = wg_i * NWAVES + F.wave, NGW = n_wg * NWAVES;
    constexpr int I_GU = 112 * 16, I_D = 16 * 56, PER_E = I_GU + I_D;
    for (int it = it_lo + gw; it < it_hi; it += NGW) {
        const int e = it / PER_E; const int r = it - e * PER_E;
        const size_t eo = ((size_t)j * NEXP + e) * DM * DFF;
        if (r < I_GU) tr_gu(r, a.in[I_WEG] + eo, a.in[I_WEU] + eo, (bf16_t*)(a.ws + WS_WEGU) + (size_t)e * 7168 * 1024, scr, F.lane);
        else tr_plain(r - I_GU, a.in[I_WED] + eo, DFF, DM, nullptr, (bf16_t*)(a.ws + WS_WED) + (size_t)e * 1024 * DFF, DFF, 0, scr, F.lane);
    }
}
__device__ __forceinline__ void mod_job(const Args& a, const Frame& F) {
    LAS float* sc = (LAS float*)F.lds;
    LAS float* red = (LAS float*)(F.lds + 17 * 1024 * 4);
    for (int i = F.tid; i < NMOD * 1024; i += NTHREADS) { const int v = i >> 10, k = i & 1023; const float x = (v < 16) ? a.in[I_C][v * 1024 + k] : a.in[I_CCTX][k]; sc[i] = siluf_(x); }
    __syncthreads();
    float* MOD = (float*)(a.ws + WS_MOD);
    const int cl = F.lane & 31, kh = F.lane >> 5;
    for (int item = F.bid; item < DEPTH * 192; item += F.G) {
        const int l = item / 192, nb = item - l * 192;
        const float* w = a.in[I_WADA] + (size_t)l * 1024 * 6144 + nb * 32 + cl;
        float acc[NMOD];
#pragma unroll
        for (int v = 0; v < NMOD; ++v) acc[v] = 0.f;
        const int k0 = F.wave * 128 + kh * 64;
#pragma unroll 1
        for (int kk = 0; kk < 64; kk += 16) {
            float wv[16];
#pragma unroll
            for (int j = 0; j < 16; ++j) wv[j] = w[(size_t)(k0 + kk + j) * 6144];
#pragma unroll
            for (int j = 0; j < 16; ++j)
#pragma unroll
                for (int v = 0; v < NMOD; ++v) acc[v] += sc[v * 1024 + k0 + kk + j] * wv[j];
        }
#pragma unroll
        for (int v = 0; v < NMOD; ++v) acc[v] += __shfl_xor(acc[v], 32);
        if (kh == 0) {
#pragma unroll
            for (int v = 0; v < NMOD; ++v) red[(F.wave * NMOD + v) * 32 + cl] = acc[v]; }
        __syncthreads();
        for (int o = F.tid; o < NMOD * 32; o += NTHREADS) { const int v = o >> 5, c = o & 31; float s = a.in[I_BADA][l * 6144 + nb * 32 + c];
#pragma unroll
            for (int wv = 0; wv < 8; ++wv) s += red[(wv * NMOD + v) * 32 + c];
            MOD[((size_t)l * NMOD + v) * 6144 + nb * 32 + c] = s; }
        __syncthreads();
    }
}

struct NormP {
    const float* xin; const float* cin;
    bf16_t* X; bool from_f32; float* outf;
    const float* gain;
    const float* mod; int shsel;
    bf16_t* H;
    int* inv;
    bool combine; const bf16_t* Y; const i32x2* routeP; const f32x2* routeW; const float* modprev;
    bool do_norm; bool latent_only;
    const float* wrouter; i32x4* routeA; f32x2* routeWout; unsigned* cnt;
};
template <bool ROUTER>
__device__ __forceinline__ void norm_job(const NormP& P, const Frame& F) {
    const int nact = P.latent_only ? NB * SEQ : T;
    const int rpw = nact / F.G;
    LAS int* hist = (LAS int*)(F.lds);
    LAS int* wbase = (LAS int*)(F.lds + 256);
    LAS int* stg = (LAS int*)(F.lds + 512);
    LAS f32x4* lw = (LAS f32x4*)(F.lds + 8192);
    if (ROUTER) { if (F.tid < 64) hist[F.tid] = 0;
#pragma unroll
        for (int k = 0; k < 4; ++k) { const int f4 = F.tid + NTHREADS * k, c = f4 >> 1, h = f4 & 1, j = c >> 8, i = c & 3, ln = (c & 255) >> 2;
            lw[((j * 4 + i) * 2 + h) * 64 + ln] = *(const f32x4*)(P.wrouter + (size_t)f4 * 4); }
        __syncthreads(); }
    const int a_lo = F.bid * rpw, a_hi = (F.bid == F.G - 1) ? nact : a_lo + rpw;
    int cur_mi = -1; f32x4 gs[4], s0v[4];
#pragma unroll
    for (int j = 0; j < 4; ++j) { gs[j] = (f32x4){0.f, 0.f, 0.f, 0.f}; s0v[j] = gs[j]; }
    i32x2 npp = (i32x2){0, 0}; f32x2 nww = (f32x2){0.f, 0.f};
    if (P.combine && a_lo + F.wave < a_hi) { const int ai0 = a_lo + F.wave, row0 = P.latent_only ? (ai0 / SEQ) * LROW + CTXL + (ai0 % SEQ) : ai0; npp = P.routeP[row0]; nww = P.routeW[row0]; }
    for (int ai = a_lo + F.wave; ai < a_hi; ai += NWAVES) {
        const int row = P.latent_only ? (ai / SEQ) * LROW + CTXL + (ai % SEQ) : ai;
        const int b = row / LROW, t = row - b * LROW;
        const bool isctx = t < CTXL; const int mi = isctx ? 16 : b;
        const size_t roff = isctx ? ((size_t)b * CTXL + t) * DM : ((size_t)b * SEQ + (t - CTXL)) * DM;
        bf16_t* xrow = P.X + (size_t)row * DM;
        f32x4 v[4];
        if (P.from_f32) {
            const float* xr = (isctx ? P.cin : P.xin) + roff;
#pragma unroll
            for (int j = 0; j < 4; ++j) { v[j] = *(const f32x4*)(xr + 4 * F.lane + 256 * j);
                u32x2 o; o.x = cvt_pk_bf16(v[j][0], v[j][1]); o.y = cvt_pk_bf16(v[j][2], v[j][3]); *(u32x2*)(xrow + 4 * F.lane + 256 * j) = o; }
        } else {
#pragma unroll
            for (int j = 0; j < 4; ++j) { const u32x2 w = *(const u32x2*)(xrow + 4 * F.lane + 256 * j); v[j] = (f32x4){bflo(w.x), bfhi(w.x), bflo(w.y), bfhi(w.y)}; }
        }
        if (P.combine) {
            const i32x2 pp = npp; const f32x2 ww = nww;
            if (ai + NWAVES < a_hi) { const int ai1 = ai + NWAVES, row1 = P.latent_only ? (ai1 / SEQ) * LROW + CTXL + (ai1 % SEQ) : ai1; npp = P.routeP[row1]; nww = P.routeW[row1]; }
            const float* ga = P.modprev + (size_t)mi * 6144 + 5 * 1024;
#pragma unroll
            for (int j = 0; j < 4; ++j) {
                const u32x2 y0 = *(const u32x2*)(P.Y + (size_t)pp.x * DM + 4 * F.lane + 256 * j), y1 = *(const u32x2*)(P.Y + (size_t)pp.y * DM + 4 * F.lane + 256 * j);
                const f32x4 g = *(const f32x4*)(ga + 4 * F.lane + 256 * j);
                f32x4 f; f[0] = ww.x * bflo(y0.x) + ww.y * bflo(y1.x); f[1] = ww.x * bfhi(y0.x) + ww.y * bfhi(y1.x); f[2] = ww.x * bflo(y0.y) + ww.y * bflo(y1.y); f[3] = ww.x * bfhi(y0.y) + ww.y * bfhi(y1.y);
                v[j] = v[j] + g * f;
                if (P.outf) *(f32x4*)(P.outf + roff + 4 * F.lane + 256 * j) = v[j];
                else { u32x2 o; o.x = cvt_pk_bf16(v[j][0], v[j][1]); o.y = cvt_pk_bf16(v[j][2], v[j][3]); *(u32x2*)(xrow + 4 * F.lane + 256 * j) = o; } }
        }
        if (!P.do_norm) continue;
        float ss = 0.f;
#pragma unroll
        for (int j = 0; j < 4; ++j) ss += (v[j][0] * v[j][0] + v[j][1] * v[j][1]) + (v[j][2] * v[j][2] + v[j][3] * v[j][3]);
        const float rstd = 1.0f / sqrtf(wave_sum(ss) * (1.0f / DM) + NORM_EPS);
        if (mi != cur_mi) {
            cur_mi = mi; const float* sh = P.mod + (size_t)mi * 6144 + P.shsel * 1024; const float* sc = sh + 1024;
#pragma unroll
            for (int j = 0; j < 4; ++j) { const int c = 4 * F.lane + 256 * j; gs[j] = *(const f32x4*)(P.gain + c) * (*(const f32x4*)(sc + c) + 1.0f); s0v[j] = *(const f32x4*)(sh + c); } }
#pragma unroll
        for (int j = 0; j < 4; ++j) { const int c = 4 * F.lane + 256 * j;
            v[j] = (v[j] * rstd) * gs[j] + s0v[j];
            u32x2 o; o.x = cvt_pk_bf16(v[j][0], v[j][1]); o.y = cvt_pk_bf16(v[j][2], v[j][3]);
            *(u32x2*)(P.H + (size_t)row * DM + c) = o; }
        if (ROUTER) {
            float lg[8];
#pragma unroll
            for (int e = 0; e < 8; ++e) lg[e] = 0.f;
#pragma unroll
            for (int j = 0; j < 4; ++j)
#pragma unroll
                for (int i = 0; i < 4; ++i) { const f32x4 w0 = lw[((j * 4 + i) * 2 + 0) * 64 + F.lane], w1 = lw[((j * 4 + i) * 2 + 1) * 64 + F.lane];
                    lg[0] += v[j][i] * w0[0]; lg[1] += v[j][i] * w0[1]; lg[2] += v[j][i] * w0[2]; lg[3] += v[j][i] * w0[3];
                    lg[4] += v[j][i] * w1[0]; lg[5] += v[j][i] * w1[1]; lg[6] += v[j][i] * w1[2]; lg[7] += v[j][i] * w1[3]; }
#pragma unroll
            for (int e = 0; e < 8; ++e) lg[e] = wave_sum(lg[e]);
            int e0 = 0; float v0 = lg[0];
#pragma unroll
            for (int e = 1; e < 8; ++e) if (lg[e] > v0) { v0 = lg[e]; e0 = e; }
            int e1 = -1; float v1 = -3.0e38f;
#pragma unroll
            for (int e = 0; e < 8; ++e) if (e != e0 && lg[e] > v1) { v1 = lg[e]; e1 = e; }
            const float w0 = 1.0f / (1.0f + __expf(v1 - v0)), w1 = 1.0f - w0;
            if (F.lane == 0) { const int p0 = hist[F.wave * 8 + e0]; hist[F.wave * 8 + e0] = p0 + 1; const int p1 = hist[F.wave * 8 + e1]; hist[F.wave * 8 + e1] = p1 + 1;
                LAS int* s = stg + (ai - a_lo) * 6; s[0] = e0; s[1] = p0; s[2] = e1; s[3] = p1; s[4] = __float_as_int(w0); s[5] = __float_as_int(w1); }
        }
    }
    if (ROUTER) {
        __syncthreads();
        if (F.tid < 8) { int tot = 0;
#pragma unroll
            for (int w = 0; w < 8; ++w) tot += hist[w * 8 + F.tid];
            int base = (int)__hip_atomic_fetch_add(P.cnt + F.tid * 64, (unsigned)tot, __ATOMIC_RELAXED, __HIP_MEMORY_SCOPE_AGENT);
#pragma unroll
            for (int w = 0; w < 8; ++w) { wbase[w * 8 + F.tid] = base; base += hist[w * 8 + F.tid]; } }
        __syncthreads();
        for (int i = F.tid; i < a_hi - a_lo; i += NTHREADS) {
            const int ai = a_lo + i, w = i & 7;
            const int row = P.latent_only ? (ai / SEQ) * LROW + CTXL + (ai % SEQ) : ai;
            const LAS int* s = stg + i * 6;
            const int p0_ = wbase[w * 8 + s[0]] + s[1], p1_ = wbase[w * 8 + s[2]] + s[3];
            P.routeA[row] = (i32x4){s[0], p0_, s[2], p1_}; P.inv[s[0] * T + p0_] = row; P.inv[s[2] * T + p1_] = row;
            P.routeWout[row] = (f32x2){__int_as_float(s[4]), __int_as_float(s[5])};
        }
        __syncthreads();
    }
}
__device__ __forceinline__ void moe_offsets(const unsigned* cnt, int* off  ) {
    int o = 0;
#pragma unroll
    for (int e = 0; e < 8; ++e) { off[e] = o; const int c = (int)__hip_atomic_load(cnt + e * 64, __ATOMIC_RELAXED, __HIP_MEMORY_SCOPE_AGENT); o += (c + 255) & ~255; }
    off[8] = o;
}

struct ConvP { const bf16_t* U; bf16_t* CAT; const float* cw; const float* cb; const float* lng; const float* lnb; bool latent_only; };
constexpr int CV_ROWS = 62, CV_BUF = CV_ROWS * 1024, CV_PART = 2 * CV_BUF, CV_STATS = CV_PART + 8 * 64 * 4;
static_assert(CV_STATS + 32 * 8 <= LDSCTL_OFF, "conv LDS");
__device__ __forceinline__ void conv_stage(const ConvP& P, const Frame& F, int item, int buf) {
    int b, cc;
    if (P.latent_only) { b = item >> 6; cc = 8 + (item & 63); } else { b = item / 72; cc = item - b * 72; }
    const int rb = b * LROW + cc * 32, seq_lo = b * LROW + (cc < 8 ? 0 : CTXL), seq_hi = b * LROW + (cc < 8 ? CTXL : LROW);
    for (int j = F.wave; j < CV_ROWS; j += NWAVES) {
        const int row = rb - 15 + j;
        LAS unsigned char* dst = F.lds + buf * CV_BUF + j * 1024;
        if (row >= seq_lo && row < seq_hi) __builtin_amdgcn_global_load_lds((const unsigned*)(P.U + (size_t)row * 512 + F.lane * 8), (LAS unsigned*)dst, 16, 0, 0);
        else *(LAS u32x4*)(dst + F.lane * 16) = (u32x4){0u, 0u, 0u, 0u};
    }
}
__device__ __forceinline__ void conv_job(const ConvP& P, const Frame& F) {
    LAS float* part = (LAS float*)(F.lds + CV_PART);
    LAS f32x2* stats = (LAS f32x2*)(F.lds + CV_STATS);
    const int ch = F.tid;
    float w[31];
#pragma unroll
    for (int k = 0; k < 31; ++k) w[k] = P.cw[k * 512 + ch];
    const float bias = P.cb[ch], lg = P.lng[ch], lb = P.lnb[ch];
    const int nitems = P.latent_only ? NB * 64 : NB * 72;
    int item = F.bid, buf = 0;
    if (item < nitems) conv_stage(P, F, item, 0);
    for (; item < nitems; item += F.G, buf ^= 1) {
        asm volatile("s_waitcnt vmcnt(0)" ::: "memory");
        __syncthreads();
        if (item + F.G < nitems) conv_stage(P, F, item + F.G, buf ^ 1);
        int b, cc;
        if (P.latent_only) { b = item >> 6; cc = 8 + (item & 63); } else { b = item / 72; cc = item - b * 72; }
        const int rb = b * LROW + cc * 32;
        const LAS bf16_t* xin = (const LAS bf16_t*)(F.lds + buf * CV_BUF) + ch;
        float a0[32];
#pragma unroll
        for (int o = 0; o < 32; ++o) a0[o] = bias;
#pragma unroll
        for (int jb = 0; jb < 62; jb += 16) {
            float xv[16];
#pragma unroll
            for (int jj = 0; jj < 16; ++jj) if (jb + jj < 62) xv[jj] = bf2f(xin[(jb + jj) * 512]);
            __builtin_amdgcn_sched_barrier(0);
#pragma unroll
            for (int jj = 0; jj < 16; ++jj) { const int j = jb + jj;
                if (j < 62) {
#pragma unroll
                    for (int o = (j > 30 ? j - 30 : 0); o <= (j < 31 ? j : 31); ++o) a0[o] += w[j - o] * xv[jj]; } }
            __builtin_amdgcn_sched_barrier(0);
        }
        float v[64];
#pragma unroll
        for (int o = 0; o < 32; ++o) { v[2 * o] = a0[o]; v[2 * o + 1] = a0[o] * a0[o]; }
#pragma unroll
        for (int s_ = 32; s_ >= 1; s_ >>= 1) {
            const bool up = (F.lane & s_) != 0;
#pragma unroll
            for (int ib = 0; ib < s_; ib += 16) {
                float sh[16];
#pragma unroll
                for (int ii = 0; ii < 16; ++ii) if (ib + ii < s_) sh[ii] = __shfl_xor(up ? v[ib + ii] : v[ib + ii + s_], s_);
                __builtin_amdgcn_sched_barrier(0);
#pragma unroll
                for (int ii = 0; ii < 16; ++ii) if (ib + ii < s_) v[ib + ii] = (up ? v[ib + ii + s_] : v[ib + ii]) + sh[ii];
                __builtin_amdgcn_sched_barrier(0);
            }
        }
        part[F.wave * 64 + F.lane] = v[0];
        __syncthreads();
        if (F.tid < 64) { const int L = F.tid;
            float tot = 0.f;
#pragma unroll
            for (int wv = 0; wv < 8; ++wv) tot += part[wv * 64 + L];
            const float oth = __shfl_xor(tot, 1);
            if ((L & 1) == 0) { const float mean = tot * (1.0f / 512.0f), var = oth * (1.0f / 512.0f) - mean * mean; stats[L >> 1] = (f32x2){mean, 1.0f / sqrtf(var + NORM_EPS)}; } }
        __syncthreads();
#pragma unroll
        for (int ob = 0; ob < 32; ob += 16) {
            f32x2 stv[16];
#pragma unroll
            for (int oo = 0; oo < 16; ++oo) stv[oo] = stats[ob + oo];
            __builtin_amdgcn_sched_barrier(0);
#pragma unroll
            for (int oo = 0; oo < 16; ++oo) { const int o = ob + oo; const f32x2 st = stv[oo];
                const float y0 = (a0[o] - st.x) * st.y * lg + lb;
                P.CAT[(size_t)(rb + o) * 1536 + ch] = (bf16_t)(cvt_pk_bf16(siluf_(y0), 0.f) & 0xffffu); }
            __builtin_amdgcn_sched_barrier(0);
        }
    }
    __syncthreads();
}

constexpr int NCH = 72, XT_PITCH = 68, XT_BYTES = 32 * XT_PITCH * 4, SC_STAGE = 40 * 128;
static_assert(32768 + 8 * (XT_BYTES + SC_STAGE) <= LDSCTL_OFF, "scan LDS");
__device__ __forceinline__ int crow(int r, int hi) { return (r & 3) + 8 * (r >> 2) + 4 * hi; }
struct ScanP { const bf16_t* ZR; bf16_t* CAT; const float* rcw; const float* rcb; const bf16_t* wfrag; const float* bra; const float* bri; const float* lam; float* SUM; const float* CAR; };
template <bool FINAL>
__device__ __forceinline__ void scan_job(const ScanP& P, const Frame& F) {
    const int ngw = (F.G >= 8) ? F.G / 8 : 1, g = (F.G >= 8) ? (F.bid & 7) : 0, wgi = (F.G >= 8) ? (F.bid >> 3) : F.bid;
    LAS bf16_t* wl = (LAS bf16_t*)F.lds;
    LAS float* XT = (LAS float*)(F.lds + 32768 + F.wave * (XT_BYTES + SC_STAGE));
    LAS bf16_t* STG = (LAS bf16_t*)(F.lds + 32768 + F.wave * (XT_BYTES + SC_STAGE) + XT_BYTES);
    const int lane = F.lane, r32 = lane & 31, hi = lane >> 5;
    for (int gg = g; gg < 8; gg += (F.G >= 8 ? 8 : 1)) {
    __syncthreads();
#pragma unroll
    for (int i = 0; i < 4; ++i) { const int e = (i * NTHREADS + F.tid) * 8, piece = e >> 12, within = e & 4095;
        *(LAS u32x4*)(wl + e) = *(const u32x4*)(P.wfrag + ((size_t)(piece * 8 + gg)) * 4096 + within); }
    const int ch = 64 * gg + lane;
    float cw[2][4], cbias[2], ba[2][2], bi[2][2], c1[2][2];
#pragma unroll
    for (int d = 0; d < 2; ++d) {
#pragma unroll
        for (int k = 0; k < 4; ++k) cw[d][k] = P.rcw[(d * 4 + k) * 512 + ch];
        cbias[d] = P.rcb[d * 512 + ch];
#pragma unroll
        for (int cb = 0; cb < 2; ++cb) { const int chj = 64 * gg + 32 * cb + r32;
            ba[d][cb] = -1.4426950408889634f * P.bra[d * 512 + chj]; bi[d][cb] = -1.4426950408889634f * P.bri[d * 512 + chj];
            const float sp = 0.6931471805599453f * __builtin_amdgcn_logf(1.0f + fast_exp2(-1.4426950408889634f * P.lam[d * 512 + chj]));
            c1[d][cb] = -8.0f * 1.4426950408889634f * sp; }
    }
    __syncthreads();
    const int istep = ngw * NWAVES, w_ = wgi * NWAVES + F.wave; const bool even_deal = (istep == 256);
    int item = w_, cbm = 3;
#define SCAN_STAGE(it) do { const int c_ = (it) % NCH, b_ = (it) / NCH; const int rb_ = b_ * LROW + c_ * 32, lo_ = b_ * LROW + (c_ < 8 ? 0 : CTXL), hi_ = b_ * LROW + (c_ < 8 ? CTXL : LROW); \
        _Pragma("unroll") for (int q_ = 0; q_ < 5; ++q_) { int row_ = rb_ - 3 + q_ * 8 + (lane >> 3); row_ = row_ < lo_ ? lo_ : (row_ >= hi_ ? hi_ - 1 : row_); \
            __builtin_amdgcn_global_load_lds((const unsigned*)(P.ZR + (size_t)row_ * 1024 + 64 * gg + (lane & 7) * 8), (LAS unsigned*)(STG + q_ * 512), 16, 0, 0); } } while (0)
    if (item < NB * NCH) SCAN_STAGE(item);
    for (; item < NB * NCH; ) {
        int nitem = item + istep, ncbm = 3;
        if (even_deal) { if (item >= 1024) nitem = NB * NCH; else if (nitem >= 1024) { nitem = 1024 + (w_ >> 1); ncbm = 1 << (w_ & 1); } }
        const int c = item % NCH, b = item / NCH;
        const int rb = b * LROW + c * 32;
        asm volatile("s_waitcnt vmcnt(0)" ::: "memory");
        { const int lo_ = b * LROW + (c < 8 ? 0 : CTXL), hi_ = b * LROW + (c < 8 ? CTXL : LROW);
          if (rb - 3 < lo_ || rb + 36 >= hi_) {
#pragma unroll
              for (int q_ = 0; q_ < 5; ++q_) { const int row_ = rb - 3 + q_ * 8 + (lane >> 3); if (row_ < lo_ || row_ >= hi_) *(LAS u32x4*)(STG + q_ * 512 + lane * 8) = (u32x4){0u, 0u, 0u, 0u}; }
          } }
        unsigned xwp[19];
#pragma unroll
        for (int j = 0; j < 19; ++j) xwp[j] = (unsigned)STG[(2 * j) * 64 + lane] | ((unsigned)STG[(2 * j + 1) * 64 + lane] << 16);
        asm volatile("s_waitcnt lgkmcnt(0)" ::: "memory");
        if (nitem < NB * NCH) SCAN_STAGE(nitem);
#define SCAN_X(j) (((j) & 1) ? bfhi(xwp[(j) >> 1]) : bflo(xwp[(j) >> 1]))
        float carv[2][2];
        if (FINAL) {
#pragma unroll
            for (int d = 0; d < 2; ++d)
#pragma unroll
                for (int cb = 0; cb < 2; ++cb) carv[d][cb] = P.CAR[(size_t)(((b * 8 + gg) * 2 + d) * NCH + c) * 64 + 32 * cb + r32];
        }
        float hsum[2][16];
#pragma unroll
        for (int cb = 0; cb < 2; ++cb)
#pragma unroll
            for (int r = 0; r < 16; ++r) hsum[cb][r] = 0.f;
#pragma unroll
        for (int d = 0; d < 2; ++d) {
#pragma unroll
            for (int t = 0; t < 32; ++t) { const int o = t + 3 * d; XT[t * XT_PITCH + lane] = fmaf(cw[d][3], SCAN_X(o + 3), fmaf(cw[d][2], SCAN_X(o + 2), fmaf(cw[d][1], SCAN_X(o + 1), fmaf(cw[d][0], SCAN_X(o), cbias[d])))); }
            bf16x8 af[4];
#pragma unroll
            for (int s = 0; s < 4; ++s) { const f32x4 x0 = *(const LAS f32x4*)(XT + r32 * XT_PITCH + 16 * s + 8 * hi), x1 = *(const LAS f32x4*)(XT + r32 * XT_PITCH + 16 * s + 8 * hi + 4);
                const u32x4 w = pg8::pack8(x0, x1); af[s] = __builtin_bit_cast(bf16x8, w); }
#pragma unroll
            for (int cb = 0; cb < 2; ++cb) { if (!(cbm & (1 << cb))) continue;
                f32x16 ra = {}, ri = {};
#pragma unroll
                for (int s = 0; s < 4; ++s) {
                    const bf16x8 wa = *(const LAS bf16x8*)(wl + (d * 2 + 0) * 4096 + (cb * 4 + s) * 512 + lane * 8);
                    const bf16x8 wi = *(const LAS bf16x8*)(wl + (d * 2 + 1) * 4096 + (cb * 4 + s) * 512 + lane * 8);
                    ra = __builtin_amdgcn_mfma_f32_32x32x16_bf16(af[s], wa, ra, 0, 0, 0);
                    ri = __builtin_amdgcn_mfma_f32_32x32x16_bf16(af[s], wi, ri, 0, 0, 0);
                }
                float av[16], bx[16];
#pragma unroll
                for (int r = 0; r < 16; ++r) {
                    const float xcv = XT[crow(r, hi) * XT_PITCH + 32 * cb + r32];
                    const float rg = fast_rcp(1.0f + fast_exp2(fmaf(ra[r], -1.4426950408889634f, ba[d][cb]))), ig = fast_rcp(1.0f + fast_exp2(fmaf(ri[r], -1.4426950408889634f, bi[d][cb])));
                    const float a_ = fast_exp2(c1[d][cb] * rg);
                    av[r] = a_; bx[r] = __builtin_amdgcn_sqrtf(fmaf(-a_, a_, 1.0f)) * (ig * xcv);
                }
                float Ag[4], Bg[4];
#pragma unroll
                for (int q = 0; q < 4; ++q) {
                    Ag[q] = (av[4 * q] * av[4 * q + 1]) * (av[4 * q + 2] * av[4 * q + 3]);
                    if (d == 0) Bg[q] = ((bx[4 * q] * av[4 * q + 1] + bx[4 * q + 1]) * av[4 * q + 2] + bx[4 * q + 2]) * av[4 * q + 3] + bx[4 * q + 3];
                    else        Bg[q] = ((bx[4 * q + 3] * av[4 * q + 2] + bx[4 * q + 2]) * av[4 * q + 1] + bx[4 * q + 1]) * av[4 * q] + bx[4 * q];
                }
                float A0[4], A1[4], B0[4], B1[4];
#pragma unroll
                for (int q = 0; q < 4; ++q) {
                    auto ra_ = __builtin_amdgcn_permlane32_swap(__float_as_uint(Ag[q]), __float_as_uint(Ag[q]), false, false); A0[q] = __uint_as_float(ra_[0]); A1[q] = __uint_as_float(ra_[1]);
                    auto rb_ = __builtin_amdgcn_permlane32_swap(__float_as_uint(Bg[q]), __float_as_uint(Bg[q]), false, false); B0[q] = __uint_as_float(rb_[0]); B1[q] = __uint_as_float(rb_[1]);
                }
                if (!FINAL) {
                    float Ac = 1.f, Bc = 0.f;
                    if (d == 0) {
#pragma unroll
                        for (int q = 0; q < 4; ++q) { Bc = A0[q] * Bc + B0[q]; Ac *= A0[q]; Bc = A1[q] * Bc + B1[q]; Ac *= A1[q]; }
                    } else {
#pragma unroll
                        for (int q = 3; q >= 0; --q) { Bc = A1[q] * Bc + B1[q]; Ac *= A1[q]; Bc = A0[q] * Bc + B0[q]; Ac *= A0[q]; }
                    }
                    if (hi == 0) { float* sp_ = P.SUM + ((size_t)(((b * 8 + gg) * 2 + d) * NCH + c) * 2) * 64 + 32 * cb + r32; sp_[0] = Ac; sp_[64] = Bc; }
                } else {
                    float s = carv[d][cb];
                    float sin_[4];
                    if (d == 0) {
#pragma unroll
                        for (int q = 0; q < 4; ++q) { const float s0 = s; s = A0[q] * s + B0[q]; const float s1 = s; s = A1[q] * s + B1[q]; sin_[q] = hi ? s1 : s0; }
#pragma unroll
                        for (int q = 0; q < 4; ++q) { float h = sin_[q];
#pragma unroll
                            for (int e = 0; e < 4; ++e) { h = av[4 * q + e] * h + bx[4 * q + e]; hsum[cb][4 * q + e] += h; } }
                    } else {
#pragma unroll
                        for (int q = 3; q >= 0; --q) { const float s1 = s; s = A1[q] * s + B1[q]; const float s0 = s; s = A0[q] * s + B0[q]; sin_[q] = hi ? s1 : s0; }
#pragma unroll
                        for (int q = 0; q < 4; ++q) { float h = sin_[q];
#pragma unroll
                            for (int e = 3; e >= 0; --e) { h = av[4 * q + e] * h + bx[4 * q + e]; hsum[cb][4 * q + e] += h; } }
                    }
                }
            }
        }
        if (FINAL) {
            u32x4 gatev[4];
            const bool mine = (cbm >> ((lane & 7) >> 2)) & 1;
#pragma unroll
            for (int p = 0; p < 4; ++p) { gatev[p] = (u32x4){0u, 0u, 0u, 0u}; if (mine) gatev[p] = *(const u32x4*)(P.ZR + (size_t)(rb + p * 8 + (lane >> 3)) * 1024 + 512 + 64 * gg + (lane & 7) * 8); }
#pragma unroll
            for (int cb = 0; cb < 2; ++cb) { if (!(cbm & (1 << cb))) continue;
#pragma unroll
                for (int r = 0; r < 16; ++r) XT[crow(r, hi) * XT_PITCH + 32 * cb + r32] = hsum[cb][r]; }
#pragma unroll
            for (int p = 0; p < 4; ++p) { const int tl = p * 8 + (lane >> 3), c8 = (lane & 7) * 8; const size_t row = (size_t)(rb + tl);
                const f32x4 y0 = *(const LAS f32x4*)(XT + tl * XT_PITCH + c8), y1 = *(const LAS f32x4*)(XT + tl * XT_PITCH + c8 + 4);
                f32x4 g0, g1; pg8::unpack8(gatev[p], g0, g1);
                if (mine) *(u32x4*)(P.CAT + row * 1536 + 1024 + 64 * gg + c8) = pg8::pack8(y0 * g0, y1 * g1); }
        }
        item = nitem; cbm = ncbm;
    }
#undef SCAN_STAGE
#undef SCAN_X
    }
}
__device__ __forceinline__ void carry_job(const float* __restrict__ SUM, float* __restrict__ CAR, const Frame& F) {
    const int gw = F.bid * NWAVES + F.wave, NGW = F.G * NWAVES;
    for (int item = gw; item < NB * 8 * 2; item += NGW) {
        const int d = item & 1;
        const float* __restrict__ sp = SUM + (size_t)item * NCH * 128 + F.lane; float* __restrict__ cp = CAR + (size_t)item * NCH * 64 + F.lane;
        float s = 0.f;
#pragma unroll 1
        for (int c0 = 0; c0 < NCH; c0 += 24) {
            float av[24], bv[24];
#pragma unroll
            for (int j = 0; j < 24; ++j) { const int k = c0 + j, c = (d == 0) ? k : (k < 8 ? 7 - k : NCH + 7 - k); av[j] = sp[c * 128]; bv[j] = sp[c * 128 + 64]; }
#pragma unroll
            for (int j = 0; j < 24; ++j) { const int k = c0 + j, c = (d == 0) ? k : (k < 8 ? 7 - k : NCH + 7 - k); cp[c * 64] = s; s = av[j] * s + bv[j]; }
        }
    }
}

__device__ __forceinline__ void krope_job(const bf16_t* __restrict__ H, const bf16_t* __restrict__ WF, bf16_t* __restrict__ KR, unsigned long long* __restrict__ stats, int first, int step, const Frame& F) {
    if (first < 0) return;
    const int lane = F.lane, r32 = lane & 31, hi = lane >> 5, lrow = lane >> 3, lpc = lane & 7;
    LAS unsigned char* xa = F.lds + F.wave * 16384;
    for (int item = first; item < T / 32; item += step) {
        const bf16_t* abase = H + (size_t)(item * 32 + lrow) * DM + lpc * 8;
        f32x16 acc = {};
#pragma unroll 1
        for (int kb = 0; kb < 4; ++kb) {
            u32x4 t[16]; bf16x8 bv[16];
#pragma unroll
            for (int j = 0; j < 16; ++j) t[j] = *(const u32x4*)(abase + (size_t)((j & 3) * 8) * DM + kb * 256 + (j >> 2) * 64);
#pragma unroll
            for (int j = 0; j < 16; ++j) bv[j] = *(const bf16x8*)(WF + ((size_t)(kb * 16 + j) * 64 + lane) * 8);
#pragma unroll
            for (int j = 0; j < 16; ++j) *(LAS u32x4*)(xa + (j >> 2) * 4096 + ((j & 3) * 8 + lrow) * 128 + ((lpc ^ lrow) * 16)) = t[j];
#pragma unroll
            for (int j = 0; j < 16; ++j) { const bf16x8 av = *(const LAS bf16x8*)(xa + (j >> 2) * 4096 + r32 * 128 + ((((j & 3) * 2 + hi) ^ (r32 & 7)) * 16));
                acc = __builtin_amdgcn_mfma_f32_32x32x16_bf16(av, bv[j], acc, 0, 0, 0); }
        }
#pragma unroll
        for (int r = 0; r < 16; ++r) { const int row = item * 32 + crow(r, hi);
            KR[(size_t)row * 32 + r32] = (bf16_t)(cvt_pk_bf16(acc[r], 0.f) & 0xffffu);
            float sq = acc[r] * acc[r]; sq += __shfl_xor(sq, 1); sq += __shfl_xor(sq, 2); sq += __shfl_xor(sq, 4); sq += __shfl_xor(sq, 8); sq += __shfl_xor(sq, 16);
            if (r32 == 0) stats[(size_t)row * 4 + 2] = (unsigned long long)(sq * 1048576.0f); }
    }
}

constexpr int attn_NTB = LROW / 64;
__device__ __forceinline__ void rope_table_job(f32x2* tab, const Frame& F) {
    if (F.bid == 0) { const int p = F.tid >> 3, i = F.tid & 7; const float f = powf(10000.0f, -(float)i * 0.125f); float s_, c_; sincosf((float)p * f, &s_, &c_); tab[F.tid] = (f32x2){c_, s_}; }
}

namespace attn {
constexpr int KSLOT = 12288, VSLOT = 8192, NSLOT = 3, KTILE = 6144, VTILE = 4096, NTB = LROW / 64;
constexpr int L_K = 0, L_V = NSLOT * KSLOT, L_WS = L_V + NSLOT * VSLOT, L_OST = L_WS + 2048, L_END = L_OST + 8 * 4096;
static_assert(L_END <= RING_BYTES, "attention LDS");
struct AttnP { const bf16_t* Q; const bf16_t* Kt; const bf16_t* Vt; bf16_t* CAT; float mfix; };
#define AT_WAIT_V(n) asm volatile("s_waitcnt vmcnt(" #n ")" ::: "memory")
#define AT_SB() __builtin_amdgcn_sched_barrier(0)
__device__ __forceinline__ void unit(const AttnP& P, LAS unsigned char* lds, int bh, int qrow0, int NT, const int tid) {
    const int lane = tid & 63, r32 = lane & 31, hi = lane >> 5; const int wid = __builtin_amdgcn_readfirstlane(tid >> 6);
    const int h = bh & 7;
    const bf16_t* Qw = P.Q + (size_t)(qrow0 + wid * 32) * 768 + 96 * h;
    bf16x8 qr[6];
#pragma unroll
    for (int d0 = 0; d0 < 6; ++d0) qr[d0] = *(const bf16x8*)(Qw + (size_t)r32 * 768 + 16 * d0 + 8 * hi);
    const bf16_t* ksrcA = P.Kt + (size_t)bh * NTB * KTILE + wid * 512 + lane * 8;
    const bf16_t* ksrcB = P.Kt + (size_t)bh * NTB * KTILE + (8 + (wid & 3)) * 512 + lane * 8;
    const bf16_t* vsrc = P.Vt + (size_t)bh * NTB * VTILE + wid * 512 + lane * 8;
#define AT_DMA_K(t, slot) do { \
        __builtin_amdgcn_global_load_lds((const unsigned*)(ksrcA + (size_t)(t) * KTILE), (LAS unsigned*)(lds + L_K + (slot) * KSLOT + wid * 1024), 16, 0, 0); \
        __builtin_amdgcn_global_load_lds((const unsigned*)(ksrcB + (size_t)(t) * KTILE), (LAS unsigned*)(lds + L_K + (slot) * KSLOT + (8 + (wid & 3)) * 1024), 16, 0, 0); } while (0)
#define AT_DMA_V(t, slot) __builtin_amdgcn_global_load_lds((const unsigned*)(vsrc + (size_t)(t) * VTILE), (LAS unsigned*)(lds + L_V + (slot) * VSLOT + wid * 1024), 16, 0, 0)
    AT_DMA_K(0, 0); AT_DMA_K(1, 1); AT_DMA_V(0, 0);
    LAS float* wsf = (LAS float*)(lds + L_WS) + wid * 64;
    const unsigned vb0 = (unsigned)(uintptr_t)(lds + L_V) + ((lane >> 4) & 1) * 32 + (lane & 3) * 8 + (4 * hi + ((lane & 15) >> 2)) * 64;
    const LAS unsigned char* kb0 = lds + L_K + hi * 1024 + r32 * 16;
    f32x16 o[2]; o[0] = f32x16{}; o[1] = f32x16{};
    f32x16 negm;
#pragma unroll
    for (int r = 0; r < 16; ++r) negm[r] = -P.mfix;
    float lsum = 0.f;
    f32x16 pA0, pA1, pB0, pB1;
#define AT_KF(kb, i) (*(const LAS bf16x8*)((kb) + ((i) >> 1) * 2048 + ((i) & 1) * 512))
#define AT_PV(ks) __builtin_bit_cast(bf16x8, ((u32x4){pw[4 * (ks)], pw[4 * (ks) + 1], pw[4 * (ks) + 2], pw[4 * (ks) + 3]}))
    AT_WAIT_V(3); __builtin_amdgcn_s_barrier(); asm volatile("" ::: "memory");
    if (2 < NT) AT_DMA_K(2, 2);
    AT_DMA_V(1, 1);
    {
        const LAS unsigned char* kb = kb0;
        pA0 = negm; pA1 = negm;
#pragma unroll
        for (int i = 0; i < 12; ++i) { const bf16x8 kf = AT_KF(kb, i);
            if (i & 1) pA1 = __builtin_amdgcn_mfma_f32_32x32x16_bf16(kf, qr[i >> 1], pA1, 0, 0, 0); else pA0 = __builtin_amdgcn_mfma_f32_32x32x16_bf16(kf, qr[i >> 1], pA0, 0, 0, 0); }
#pragma unroll
        for (int r = 0; r < 16; ++r) { pA0[r] = fast_exp2(pA0[r]); pA1[r] = fast_exp2(pA1[r]); }
    }
#define AT_STEP(S0, S1, P0, P1, ksl, vsl) do { \
        const LAS unsigned char* kb = kb0 + (ksl) * KSLOT; const unsigned vb = vb0 + (vsl) * VSLOT; \
        s16x4 vlo[8], vhh[8]; unsigned pw[16]; float sacc = 0.f; \
        bf16x8 kfa = AT_KF(kb, 0), kfb = AT_KF(kb, 1), kfc = AT_KF(kb, 2), kfd = AT_KF(kb, 3); \
        AT_SB(); \
        _Pragma("unroll") for (int i = 0; i < 12; ++i) { \
            bf16x8 kfe = kfa; if (i + 4 < 12) kfe = AT_KF(kb, (i + 4 < 12 ? i + 4 : 0)); \
            if (i < 8) { asm volatile("ds_read_b64_tr_b16 %0,%1 offset:%c2" : "=&v"(vlo[i]) : "v"(vb), "i"(((i) >> 2) * 4096 + ((i) & 3) * 1024) : "memory"); \
                         asm volatile("ds_read_b64_tr_b16 %0,%1 offset:%c2" : "=&v"(vhh[i]) : "v"(vb), "i"(((i) >> 2) * 4096 + ((i) & 3) * 1024 + 512) : "memory"); } \
            if (i & 1) S1 = __builtin_amdgcn_mfma_f32_32x32x16_bf16(kfa, qr[i >> 1], (i == 1) ? negm : S1, 0, 0, 0); \
            else       S0 = __builtin_amdgcn_mfma_f32_32x32x16_bf16(kfa, qr[i >> 1], (i == 0) ? negm : S0, 0, 0, 0); \
            { const int j0 = (i < 8) ? 3 * i : 24 + 2 * (i - 8), j1 = (i < 8) ? 3 * i + 3 : 24 + 2 * (i - 8) + 2; \
              _Pragma("unroll") for (int j = j0; j < j1; ++j) sacc += (j < 16) ? P0[j & 15] : P1[j & 15]; } \
            if (i < 8) { const int e = 4 * i; pw[2 * i] = (e < 16) ? cvt_pk_bf16(P0[e & 15], P0[(e + 1) & 15]) : cvt_pk_bf16(P1[e & 15], P1[(e + 1) & 15]); \
                         pw[2 * i + 1] = (e < 16) ? cvt_pk_bf16(P0[(e + 2) & 15], P0[(e + 3) & 15]) : cvt_pk_bf16(P1[(e + 2) & 15], P1[(e + 3) & 15]); \
                         asm volatile("" : "+v"(pw[2 * i]), "+v"(pw[2 * i + 1])); } \
            asm volatile("" : "+v"(sacc)); \
            kfa = kfb; kfb = kfc; kfc = kfd; kfd = kfe; \
            AT_SB(); \
        } \
        lsum += sacc; \
        asm volatile("s_waitcnt lgkmcnt(0)" ::: "memory"); AT_SB(); \
        _Pragma("unroll") for (int j = 0; j < 8; ++j) { const int d0 = j & 1, ks = j >> 1, vi = d0 * 4 + ks; \
            const bf16x8 vf = (bf16x8){vlo[vi][0], vlo[vi][1], vlo[vi][2], vlo[vi][3], vhh[vi][0], vhh[vi][1], vhh[vi][2], vhh[vi][3]}; \
            const bf16x8 pa = AT_PV(ks); \
            o[d0] = __builtin_amdgcn_mfma_f32_32x32x16_bf16(pa, vf, o[d0], 0, 0, 0); \
            _Pragma("unroll") for (int e = 0; e < 4; ++e) { if (j < 4) S0[4 * j + e] = fast_exp2(S0[4 * j + e]); else S1[4 * (j - 4) + e] = fast_exp2(S1[4 * (j - 4) + e]); } \
            if (j < 4) asm volatile("" : "+v"(S0)); else asm volatile("" : "+v"(S1)); \
            AT_SB(); \
        } \
    } while (0)
    int ksl = 1, vsl = 0;
#define AT_TOP(t) do { if ((t) + 1 < NT) AT_WAIT_V(3); else AT_WAIT_V(1); __builtin_amdgcn_s_barrier(); asm volatile("" ::: "memory"); \
        const int nsl = (ksl == 2) ? 0 : ksl + 1; if ((t) + 2 < NT) AT_DMA_K((t) + 2, vsl); if ((t) + 1 < NT) AT_DMA_V((t) + 1, nsl); } while (0)
#define AT_ROT() do { vsl = ksl; ksl = (ksl == 2) ? 0 : ksl + 1; } while (0)
    int t = 1;
    for (; t + 1 < NT; t += 2) {
        AT_TOP(t);     AT_STEP(pB0, pB1, pA0, pA1, ksl, vsl); AT_ROT();
        AT_TOP(t + 1); AT_STEP(pA0, pA1, pB0, pB1, ksl, vsl); AT_ROT();
    }
    AT_TOP(t); AT_STEP(pB0, pB1, pA0, pA1, ksl, vsl); AT_ROT();
    AT_WAIT_V(0); __builtin_amdgcn_s_barrier(); asm volatile("" ::: "memory");
    {
        unsigned pw[16]; float sacc = 0.f;
#pragma unroll
        for (int r = 0; r < 16; ++r) sacc += pB0[r] + pB1[r];
        lsum += sacc;
#pragma unroll
        for (int i = 0; i < 4; ++i) { pw[2 * i] = cvt_pk_bf16(pB0[4 * i], pB0[4 * i + 1]); pw[2 * i + 1] = cvt_pk_bf16(pB0[4 * i + 2], pB0[4 * i + 3]);
                                      pw[8 + 2 * i] = cvt_pk_bf16(pB1[4 * i], pB1[4 * i + 1]); pw[8 + 2 * i + 1] = cvt_pk_bf16(pB1[4 * i + 2], pB1[4 * i + 3]); }
        const unsigned vb = vb0 + vsl * VSLOT;
#pragma unroll
        for (int d0 = 0; d0 < 2; ++d0) { s16x4 lo[4], hh[4];
#pragma unroll
            for (int ks = 0; ks < 4; ++ks) {
                asm volatile("ds_read_b64_tr_b16 %0,%1 offset:%c2" : "=&v"(lo[ks]) : "v"(vb), "i"(d0 * 4096 + ks * 1024) : "memory");
                asm volatile("ds_read_b64_tr_b16 %0,%1 offset:%c2" : "=&v"(hh[ks]) : "v"(vb), "i"(d0 * 4096 + ks * 1024 + 512) : "memory"); }
            asm volatile("s_waitcnt lgkmcnt(0)" ::: "memory"); AT_SB();
#pragma unroll
            for (int ks = 0; ks < 4; ++ks) { const bf16x8 vf = (bf16x8){lo[ks][0], lo[ks][1], lo[ks][2], lo[ks][3], hh[ks][0], hh[ks][1], hh[ks][2], hh[ks][3]};
                const bf16x8 pa = AT_PV(ks);
                o[d0] = __builtin_amdgcn_mfma_f32_32x32x16_bf16(pa, vf, o[d0], 0, 0, 0); }
        }
    }
    { auto rr = __builtin_amdgcn_permlane32_swap(__float_as_uint(lsum), __float_as_uint(lsum), false, false); lsum = __uint_as_float(rr[0]) + __uint_as_float(rr[1]); }
    if (hi == 0) wsf[32 + r32] = lsum;
    asm volatile("s_waitcnt lgkmcnt(0)" ::: "memory");
    float rli[16];
#pragma unroll
    for (int r = 0; r < 16; ++r) rli[r] = fast_rcp(wsf[32 + crow(r, hi)]);
    LAS bf16_t* stg = (LAS bf16_t*)(lds + L_OST) + wid * 2048;
#pragma unroll
    for (int r = 0; r < 16; ++r) { const int orow = crow(r, hi);
#pragma unroll
        for (int d0 = 0; d0 < 2; ++d0) stg[orow * 64 + d0 * 32 + r32] = (bf16_t)(cvt_pk_bf16(o[d0][r] * rli[r], 0.f) & 0xffffu); }
    asm volatile("s_waitcnt lgkmcnt(0)" ::: "memory");
    bf16_t* Ow = P.CAT + (size_t)(qrow0 + wid * 32) * 1536 + 512 + 64 * h;
#pragma unroll
    for (int i = 0; i < 4; ++i) { const int row = i * 8 + (lane >> 3), ch = lane & 7; const u32x4 v = *(const LAS u32x4*)(stg + row * 64 + ch * 8); *(u32x4*)(Ow + (size_t)row * 1536 + ch * 8) = v; }
    asm volatile("s_waitcnt lgkmcnt(0)" ::: "memory"); __builtin_amdgcn_s_barrier(); asm volatile("" ::: "memory");
#undef AT_DMA_K
#undef AT_DMA_V
#undef AT_KF
#undef AT_PV
#undef AT_STEP
#undef AT_TOP
#undef AT_ROT
}
__device__ __forceinline__ void phase(const AttnP& P, const Frame& F, bool with_ctx) {
    const int vcu = (F.G % 8 == 0) ? (F.bid % 8) * (F.G / 8) + F.bid / 8 : F.bid;
    for (int u = vcu; u < NB * 8 * 8; u += F.G) { const int bh = u >> 3, qb = u & 7, b = bh >> 3;
        unit(P, F.lds, bh, b * LROW + CTXL + qb * 256, LROW / 64, F.tid); }
    if (with_ctx) for (int u = vcu; u < NB * 8; u += F.G) { const int b = u >> 3; unit(P, F.lds, u, b * LROW, CTXL / 64, F.tid); }
}
}


constexpr int PH_PER_LAYER = 11, NPHASE = 1 + DEPTH * PH_PER_LAYER + 1;
#define IN(k) (lo <= (k) && (k) < hi)
#define PHASE_BEGIN() do { if (need_bar) xcd_barrier(bar); need_bar = true; int t_ = threadIdx.x; asm volatile("" : "+v"(t_)); F.tid = t_; F.lane = t_ & 63; F.wave = __builtin_amdgcn_readfirstlane(t_ >> 6); } while (0)
#define WSP(T_, off) ((T_*)(ws + (off)))

template <int L>
__device__ __forceinline__ void layer_phases(const Args& a, Frame& F, const XcdBarrier& bar, bool& need_bar, const int lo, const int hi) {
    constexpr int l = L, pb = 1 + l * PH_PER_LAYER;
    if (hi <= pb || lo >= pb + PH_PER_LAYER) return;
    constexpr bool last = (l == DEPTH - 1), moe = (l & 1) != 0; constexpr int jf = l >> 1;
    unsigned char* ws = a.ws;
    unsigned* ctl = (unsigned*)(ws + WS_CTL);
    float* MOD = WSP(float, WS_MOD); bf16_t* XRES = WSP(bf16_t, WS_XRES);
    const float* MODl = MOD + (size_t)l * NMOD * 6144;
    unsigned* cnt = ctl + CW_CNT + jf * 8 * 64;
    constexpr int nMrows = last ? NB * 8 : T / 256, rmode = last ? 1 : 0;
    bf16_t* H = WSP(bf16_t, A_H); bf16_t* Gt = WSP(bf16_t, A_G); bf16_t* ZR = WSP(bf16_t, A_ZR); bf16_t* ZQ = WSP(bf16_t, A_ZQ); bf16_t* Qb = WSP(bf16_t, A_Q);
    bf16_t* ZKV = WSP(bf16_t, A_ZKV); bf16_t* KR = WSP(bf16_t, A_KR); bf16_t* KVR = WSP(bf16_t, A_KVR); bf16_t* U = WSP(bf16_t, A_U); bf16_t* CAT = WSP(bf16_t, A_CAT);
    bf16_t* Kb = H; bf16_t* Vb = KVR;
    float* SUM = WSP(float, A_SUM); float* CAR = WSP(float, A_CAR);
    bf16_t* HID = WSP(bf16_t, A_HID); bf16_t* HP = WSP(bf16_t, A_HP); bf16_t* HIDM = WSP(bf16_t, A_HIDM);
    i32x4* routeA = WSP(i32x4, WS_ROUTE_A); f32x2* routeW = WSP(f32x2, WS_ROUTE_W); i32x2* routeP = WSP(i32x2, WS_ROUTE_P);

    if (IN(pb + 0)) { PHASE_BEGIN(); {
        NormP P{}; P.xin = a.in[I_X]; P.cin = a.in[I_CTX]; P.X = XRES; P.from_f32 = (l == 0); P.outf = nullptr; P.gain = a.in[I_GN1] + l * DM; P.mod = MODl; P.shsel = 0; P.H = H;
        P.combine = (l == 2); P.Y = HP; P.routeP = routeP; P.routeW = routeW; P.modprev = MOD + (size_t)(l > 0 ? l - 1 : 0) * NMOD * 6144; P.do_norm = true; P.latent_only = false;
        norm_job<false>(P, F);
        { u32x4* st = WSP(u32x4, WS_STATS); for (int i = F.bid * NTHREADS + F.tid; i < 2 * T; i += F.G * NTHREADS) st[i] = (u32x4){0u, 0u, 0u, 0u}; }
        if constexpr (moe) { u32x4* iv = WSP(u32x4, WS_INV); for (int i = F.bid * NTHREADS + F.tid; i < 2 * T; i += F.G * NTHREADS) iv[i] = (u32x4){0u, 0u, 0u, 0u}; } } }
    if (IN(pb + 1)) { PHASE_BEGIN(); {
        pg8::Gemm g{H, WSP(const bf16_t, WS_WIN) + (size_t)l * NWIN * DM, DM, DM, DM, 0};
        pg8::Order S; S.init(last ? NB * 8 : T / 256, NWIN / 256, F.G, F.bid, last ? 3 : 0, 1, DM, DM, 0);
        pg8::EpiWin E{U, ZQ, ZKV, ZR, Gt, KR, a.in[I_BGATE] + l * 3072, WSP(unsigned long long, WS_STATS)};
        pg8::gemm_phase<pg8::EpiWin, true>(F.lds, g, S, E, F.tid);
        if (F.G == 256) krope_job(H, WSP(const bf16_t, WS_WKR) + (size_t)l * 64 * 512, KR, WSP(unsigned long long, WS_STATS), F.bid >= 128 ? (F.bid - 128) * NWAVES + F.wave : -1, 128 * NWAVES, F);
        else krope_job(H, WSP(const bf16_t, WS_WKR) + (size_t)l * 64 * 512, KR, WSP(unsigned long long, WS_STATS), F.bid * NWAVES + F.wave, F.G * NWAVES, F); } }
    if (IN(pb + 2)) { PHASE_BEGIN(); {
        { ConvP P{U, CAT, a.in[I_CONVW] + l * 31 * 512, a.in[I_CONVB] + l * 512, a.in[I_CLNG] + l * 512, a.in[I_CLNB] + l * 512, last}; conv_job(P, F); }
        __syncthreads();
        { ScanP P{ZR, CAT, a.in[I_RCW] + l * 2 * 4 * 512, a.in[I_RCB] + l * 2 * 512, WSP(const bf16_t, WS_WREC) + (size_t)l * 256 * 512, a.in[I_BRA] + l * 1024, a.in[I_BRI] + l * 1024, a.in[I_LAM] + l * 1024, SUM, CAR};
          scan_job<false>(P, F); }
        __syncthreads();
        { LAS f32x2* tl = (LAS f32x2*)(F.lds + RING_BYTES + 10240); tl[F.tid] = WSP(const f32x2, WS_TAB)[F.tid]; __syncthreads(); }
        { pg8::Gemm g{ZQ, WSP(const bf16_t, WS_WQB) + (size_t)l * 1024 * 768, 768, 768, 768, 0};
          pg8::Order S; S.init(last ? NB * 8 : T / 256, 4, F.G, F.bid, last ? 1 : 0, 1, 768, 768, 0);
          pg8::EpiQ E{Qb, a.in[I_GQN] + l * 96, WSP(const unsigned long long, WS_STATS), (LAS float*)(F.lds + RING_BYTES)};
          pg8::gemm_phase<pg8::EpiQ, true>(F.lds, g, S, E, F.tid); }
        if (last || F.G != 256 || F.bid >= 64)
        { pg8::Gemm g{ZKV, WSP(const bf16_t, WS_WKVB) + (size_t)l * 1024 * 256, 256, 256, 256, 0};
          pg8::Order S; if (last || F.G != 256) S.init(T / 256, 4, F.G, F.bid, 0, 1, 256, 256, 0); else S.init(T / 256, 4, 192, F.bid - 64, 0, 1, 256, 256, 0);
          pg8::EpiKV E{Kb, Vb, KR, a.in[I_GKN] + l * 96, WSP(const unsigned long long, WS_STATS), (LAS float*)(F.lds + RING_BYTES)};
          pg8::gemm_phase<pg8::EpiKV, true>(F.lds, g, S, E, F.tid); }
        } }
    if (IN(pb + 3)) { PHASE_BEGIN(); {
        carry_job(SUM, CAR, F); } }
    if (IN(pb + 4)) { PHASE_BEGIN(); {
        { ScanP P{ZR, CAT, a.in[I_RCW] + l * 2 * 4 * 512, a.in[I_RCB] + l * 2 * 512, WSP(const bf16_t, WS_WREC) + (size_t)l * 256 * 512, a.in[I_BRA] + l * 1024, a.in[I_BRI] + l * 1024, a.in[I_LAM] + l * 1024, SUM, CAR};
          scan_job<true>(P, F); }
        __syncthreads();
        { float mq = 0.f, mk = 0.f;
          for (int d = 0; d < 96; ++d) { mq = fmaxf(mq, fabsf(a.in[I_GQN][l * 96 + d])); mk = fmaxf(mk, fabsf(a.in[I_GKN][l * 96 + d])); }
          attn::AttnP P{Qb, Kb, Vb, CAT, 96.0f * mq * mk * QSCALE};
          attn::phase(P, F, !last); } } }
    if (IN(pb + 5)) { PHASE_BEGIN(); {
        pg8::Gemm g{CAT, WSP(const bf16_t, WS_WCAT) + (size_t)l * 1024 * 1536, 1536, 1536, 512, 0};
        pg8::Order S; S.init(nMrows, 4, F.G, F.bid, rmode, 3, 1536, 1536, 512);
        pg8::EpiMerge E{Gt, H};
        pg8::gemm_phase<pg8::EpiMerge, true>(F.lds, g, S, E, F.tid);
        if constexpr (l == 0 || l == 2) { if (F.G == 256) convert_moe(a, F, jf, 0, CVT_SPLIT1, F.bid - 64, 192); }
        if constexpr (l == 1) { if (F.G == 256) convert_common(a, F, 2 * CC_PER_LAYER, 4 * CC_PER_LAYER, F.bid - 64, 192); }
        } }
    if (IN(pb + 6)) { PHASE_BEGIN(); {
        pg8::Gemm g{H, WSP(const bf16_t, WS_WOUT) + (size_t)l * 1024 * 1024, DM, DM, DM, 1};
        pg8::Order S; S.init(nMrows, 4, F.G, F.bid, rmode, 1, DM, DM, 0);
        pg8::EpiResid E{XRES, MODl, 2};
        pg8::gemm_phase<pg8::EpiResid, true>(F.lds, g, S, E, F.tid);
        if constexpr (l == 0 || l == 2) { if (F.G == 256) convert_moe(a, F, jf, CVT_SPLIT1, CVT_SPLIT2, F.bid - 64, 192); }
        if constexpr (l == 1) { if (F.G == 256) convert_common(a, F, DEPTH * CC_PER_LAYER + CC_PER_FF, CC_NITEMS, F.bid - 64, 192); } } }
    if (IN(pb + 7)) { PHASE_BEGIN(); {
        NormP P{}; P.X = XRES; P.from_f32 = false; P.outf = nullptr; P.gain = a.in[I_GN2] + l * DM; P.mod = MODl; P.shsel = 3; P.H = H;
        P.combine = false; P.do_norm = true; P.latent_only = last;
        P.wrouter = a.in[I_WROUTER] + (size_t)jf * DM * 8; P.routeA = routeA; P.routeWout = routeW; P.cnt = cnt; P.inv = WSP(int, WS_INV);
        if (moe) norm_job<true>(P, F); else norm_job<false>(P, F); } }
    if constexpr (moe) {
        if (IN(pb + 9)) { PHASE_BEGIN(); {
            int off[9]; moe_offsets(cnt, off);
            for (int ai = F.bid * NTHREADS + F.tid; ai < (last ? NB * SEQ : T); ai += F.G * NTHREADS) { const int row = last ? (ai / SEQ) * LROW + CTXL + (ai % SEQ) : ai;
                const i32x4 ra = routeA[row]; int p0 = ra.y, p1 = ra.w;
#pragma unroll
                for (int e = 0; e < 8; ++e) { p0 += (ra.x == e) ? off[e] : 0; p1 += (ra.z == e) ? off[e] : 0; }
                routeP[row] = (i32x2){p0, p1}; }
            pg8::Gemm g{H, WSP(const bf16_t, WS_WEGU), DM, DM, DM, 0, WSP(const int, WS_INV)};
            pg8::Order S; S.init(off[8] >> 8, 28, F.G, F.bid, 2, 1, DM, DM, 0); S.n_per_group = 7168; S.gathered = true;
#pragma unroll
            for (int e = 0; e < 9; ++e) S.tstart[e] = off[e] >> 8;
            pg8::EpiSwiGLU E{HIDM, DFF};
            pg8::gemm_phase<pg8::EpiSwiGLU, true, true>(F.lds, g, S, E, F.tid); } }
        if (IN(pb + 10)) { PHASE_BEGIN(); {
            int off[9]; moe_offsets(cnt, off);
            pg8::Gemm g{HIDM, WSP(const bf16_t, WS_WED), DFF, DFF, DFF, 1};
            pg8::Order S; S.init(off[8] >> 8, 4, F.G, F.bid, 2, 1, DFF, DFF, 0); S.n_per_group = 1024;
#pragma unroll
            for (int e = 0; e < 9; ++e) S.tstart[e] = off[e] >> 8;
            pg8::EpiPlain E{HP, DM};
            pg8::gemm_phase<pg8::EpiPlain, true>(F.lds, g, S, E, F.tid); } }
    } else {
        if (IN(pb + 9)) { PHASE_BEGIN(); {
            pg8::Gemm g{H, WSP(const bf16_t, WS_WFFGU) + (size_t)jf * 7168 * 1024, DM, DM, DM, 0};
            pg8::Order S; S.init(T / 256, 28, F.G, F.bid, 0, 1, DM, DM, 0);
            pg8::EpiSwiGLU E{HID, DFF};
            pg8::gemm_phase<pg8::EpiSwiGLU, true>(F.lds, g, S, E, F.tid); } }
        if (IN(pb + 10)) { PHASE_BEGIN(); {
            pg8::Gemm g{HID, WSP(const bf16_t, WS_WFFD) + (size_t)jf * 1024 * DFF, DFF, DFF, DFF, 1};
            pg8::Order S; S.init(T / 256, 4, F.G, F.bid, 0, 1, DFF, DFF, 0);
            pg8::EpiResid E{XRES, MODl, 5};
            pg8::gemm_phase<pg8::EpiResid, true>(F.lds, g, S, E, F.tid);
            if (F.G == 256) convert_moe(a, F, jf, CVT_SPLIT2, MOE_CVT_ITEMS, F.bid - 64, 192);
            else { __syncthreads(); convert_moe(a, F, jf, 0, MOE_CVT_ITEMS, F.bid, F.G); } } }
    }
}

__global__ void __launch_bounds__(NTHREADS, 2) fwd_kernel(Args a) {
    extern __shared__ __attribute__((aligned(16))) unsigned char lds_raw[];
    Frame F;
    F.lds = (LAS unsigned char*)lds_raw; F.tid = threadIdx.x; F.lane = F.tid & 63; F.wave = __builtin_amdgcn_readfirstlane(F.tid >> 6); F.G = gridDim.x; F.bid = blockIdx.x; F.ws = a.ws;
    volatile LAS unsigned* MISC = (volatile LAS unsigned*)(F.lds + LDSCTL_OFF);
    if (F.tid < 64) MISC[F.tid] = 0u;
    __syncthreads();
    XcdBarrier bar = xcd_barrier_post((unsigned*)(a.ws + WS_CTL) + CW_BAR, MISC + 8);
    const int lo = a.ph_lo, hi = a.ph_hi;
    bool need_bar = false;
    if (IN(0)) { PHASE_BEGIN(); {
        if (F.G == 256) { convert_common(a, F, 0, 2 * CC_PER_LAYER, F.bid, F.G); convert_common(a, F, DEPTH * CC_PER_LAYER, DEPTH * CC_PER_LAYER + CC_PER_FF, F.bid, F.G); }
        else convert_common(a, F, 0, CC_NITEMS, F.bid, F.G);
        rope_table_job((f32x2*)(a.ws + WS_TAB), F); __syncthreads(); mod_job(a, F); } }
    layer_phases<0>(a, F, bar, need_bar, lo, hi);
    layer_phases<1>(a, F, bar, need_bar, lo, hi);
    layer_phases<2>(a, F, bar, need_bar, lo, hi);
    layer_phases<3>(a, F, bar, need_bar, lo, hi);
    if (IN(NPHASE - 1)) { PHASE_BEGIN(); {
        unsigned char* ws = a.ws;
        NormP P{}; P.X = WSP(bf16_t, WS_XRES); P.from_f32 = false; P.outf = a.out; P.combine = true; P.Y = WSP(bf16_t, A_HP); P.routeP = WSP(i32x2, WS_ROUTE_P); P.routeW = WSP(f32x2, WS_ROUTE_W);
        P.modprev = WSP(float, WS_MOD) + (size_t)(DEPTH - 1) * NMOD * 6144; P.do_norm = false; P.latent_only = true;
        norm_job<false>(P, F); } }
}
#undef IN
#undef PHASE_BEGIN

extern "C" void kernel_launch(void* const* d_in, const int* in_sizes, int n_in, void* d_out, int out_size, void* d_ws, size_t ws_size, hipStream_t stream) {
    static int grid = 0;
    if (grid == 0) {
        if (n_in != 38 || out_size != NB * SEQ * DM || ws_size < WS_END) { fprintf(stderr, "kernel_launch: unexpected shapes (n_in %d out %d ws %zu need %zu)\n", n_in, out_size, ws_size, (size_t)WS_END); grid = -1; return; }
        int dev = 0, cus = 0;
        if (hipGetDevice(&dev) != hipSuccess || hipDeviceGetAttribute(&cus, hipDeviceAttributeMultiprocessorCount, dev) != hipSuccess) { grid = -1; return; }
        if (hipFuncSetAttribute((const void*)fwd_kernel, hipFuncAttributeMaxDynamicSharedMemorySize, LDS_BYTES) != hipSuccess) { fprintf(stderr, "kernel_launch: hipFuncSetAttribute failed\n"); grid = -1; return; }
        int per_cu = 0;
        if (hipOccupancyMaxActiveBlocksPerMultiprocessor(&per_cu, (const void*)fwd_kernel, NTHREADS, LDS_BYTES) != hipSuccess || per_cu < 1) { fprintf(stderr, "kernel_launch: occupancy query says %d\n", per_cu); }
        (void)hipGetLastError();
        grid = cus;
    }
    if (grid < 0) return;
    (void)hipMemsetAsync((char*)d_ws + WS_CTL, 0, CTL_BYTES, stream);
    Args a{};
    for (int i = 0; i < 38; ++i) a.in[i] = (const float*)d_in[i];
    a.out = (float*)d_out; a.ws = (unsigned char*)d_ws;
#if MK_ONE_LAUNCH
    a.ph_lo = 0; a.ph_hi = NPHASE;
    hipLaunchKernelGGL(fwd_kernel, dim3(grid), dim3(NTHREADS), LDS_BYTES, stream, a);
#else
    for (int k = 0; k < NPHASE; ++k) {
        if (k >= 1 && k < NPHASE - 1) { const int l = (k - 1) / PH_PER_LAYER, p = (k - 1) % PH_PER_LAYER; if (p == 8 && !(l & 1)) continue; }
        a.ph_lo = k; a.ph_hi = k + 1;
        hipLaunchKernelGGL(fwd_kernel, dim3(grid), dim3(NTHREADS), LDS_BYTES, stream, a);
    }
#endif
}
```

```cpp
#include <hip/hip_runtime.h>
#include <cstdio>
#include <cstdint>

#ifndef MK_ONE_LAUNCH
#define MK_ONE_LAUNCH 1
#endif

#define LAS __attribute__((address_space(3)))
#define GAS __attribute__((address_space(1)))
typedef unsigned short bf16_t;
typedef short bf16x8 __attribute__((ext_vector_type(8)));
typedef short s16x4 __attribute__((ext_vector_type(4)));
typedef float f32x2 __attribute__((ext_vector_type(2)));
typedef float f32x4 __attribute__((ext_vector_type(4)));
typedef float f32x16 __attribute__((ext_vector_type(16)));
typedef unsigned u32x2 __attribute__((ext_vector_type(2)));
typedef unsigned u32x4 __attribute__((ext_vector_type(4)));
typedef int i32x4 __attribute__((ext_vector_type(4)));
typedef int i32x2 __attribute__((ext_vector_type(2)));

constexpr int DM = 1024, NB = 16, SEQ = 2048, CTXL = 256, LROW = CTXL + SEQ  , T = NB * LROW  , DEPTH = 4;
constexpr int IN_COLS = 6176, NWIN = 6144, DFF = 3584, NEXP = 8, NMOD = 17;
constexpr int MOE_ROWS_MAX = 75776;
constexpr float NORM_EPS = 1e-6f;
constexpr float QSCALE = 0.10206207261596577f * 1.4426950408889634f;
constexpr int NTHREADS = 512, NWAVES = 8;

constexpr size_t al256(size_t x) { return (x + 255) & ~(size_t)255; }
constexpr size_t WS_CTL = 0, CTL_BYTES = 1u << 20;
constexpr size_t WS_MOD = WS_CTL + CTL_BYTES;
constexpr size_t WS_XRES = WS_MOD + al256((size_t)DEPTH * NMOD * 6144 * 4);
constexpr size_t WS_ROUTE_A = WS_XRES + (size_t)T * DM * 2;
constexpr size_t WS_ROUTE_W = WS_ROUTE_A + (size_t)T * 16;
constexpr size_t WS_ROUTE_P = WS_ROUTE_W + (size_t)T * 8;
constexpr size_t WS_TAB = WS_ROUTE_P + (size_t)T * 8;
constexpr size_t WS_STATS = WS_TAB + 4096;
constexpr size_t WS_INV = WS_STATS + (size_t)T * 32;
constexpr size_t WS_WIN = WS_INV + (size_t)8 * T * 4;
constexpr size_t WS_WQB = WS_WIN + (size_t)DEPTH * NWIN * DM * 2;
constexpr size_t WS_WKVB = WS_WQB + (size_t)DEPTH * 1024 * 768 * 2;
constexpr size_t WS_WCAT = WS_WKVB + (size_t)DEPTH * 1024 * 256 * 2;
constexpr size_t WS_WOUT = WS_WCAT + (size_t)DEPTH * 1024 * 1536 * 2;
constexpr size_t WS_WREC = WS_WOUT + (size_t)DEPTH * 1024 * 1024 * 2;
constexpr size_t WS_WKR = WS_WREC + (size_t)DEPTH * 2 * 2 * 8 * 4096 * 2;
constexpr size_t WS_WFFGU = WS_WKR + (size_t)DEPTH * 64 * 512 * 2;
constexpr size_t WS_WFFD = WS_WFFGU + (size_t)2 * 7168 * 1024 * 2;
constexpr size_t WS_WEGU = WS_WFFD + (size_t)2 * 1024 * 3584 * 2;
constexpr size_t WS_WED = WS_WEGU + (size_t)NEXP * 7168 * 1024 * 2;
constexpr size_t WS_ARENA = WS_WED + (size_t)NEXP * 1024 * 3584 * 2;
constexpr size_t A_H = WS_ARENA;
constexpr size_t A_G = A_H + (size_t)T * 1024 * 2;
constexpr size_t A_ZR = A_G + (size_t)T * 3072 * 2;
constexpr size_t A_ZQ = A_ZR + (size_t)T * 1024 * 2;
constexpr size_t A_Q = A_ZQ + (size_t)T * 768 * 2;
constexpr size_t A_ZKV = A_Q + (size_t)T * 768 * 2;
constexpr size_t A_KR = A_ZKV + (size_t)T * 256 * 2;
constexpr size_t A_KVR = A_KR + (size_t)T * 32 * 2;
constexpr size_t A_U = A_KVR + (size_t)T * 1024 * 2;
constexpr size_t A_CAT = A_U + (size_t)T * 512 * 2;
constexpr size_t A_SUM = A_CAT + (size_t)T * 1536 * 2;
constexpr size_t A_CAR = A_SUM + (size_t)NB * 8 * 2 * 72 * 2 * 64 * 4;
constexpr size_t A_MIX_END = A_CAR + (size_t)NB * 8 * 2 * 72 * 64 * 4;
constexpr size_t A_HID = A_G;
constexpr size_t A_HP = A_G;
constexpr size_t A_HIDM = A_HP + (size_t)MOE_ROWS_MAX * 1024 * 2;
constexpr size_t A_MOE_END = A_HIDM + (size_t)MOE_ROWS_MAX * 3584 * 2;
constexpr size_t WS_END = A_MIX_END > A_MOE_END ? A_MIX_END : A_MOE_END;
static_assert(WS_END < 1203000000ull, "workspace map must fit under sum(inputs)");
constexpr int CW_BAR = 4096, CW_CNT = 16384;

constexpr int RING_BYTES = 131072, LDS_BYTES = 147456, LDSCTL_OFF = LDS_BYTES - 1024;

__device__ __forceinline__ unsigned cvt_pk_bf16(float lo, float hi) { unsigned r; asm volatile("v_cvt_pk_bf16_f32 %0, %1, %2" : "=v"(r) : "v"(lo), "v"(hi)); return r; }
__device__ __forceinline__ float bf2f(unsigned short b) { return __uint_as_float(((unsigned)b) << 16); }
__device__ __forceinline__ float bflo(unsigned w) { return __uint_as_float(w << 16); }
__device__ __forceinline__ float bfhi(unsigned w) { return __uint_as_float(w & 0xffff0000u); }
__device__ __forceinline__ float fast_exp2(float x) { return __builtin_amdgcn_exp2f(x); }
__device__ __forceinline__ float fast_rcp(float x) { return __builtin_amdgcn_rcpf(x); }
__device__ __forceinline__ float sigmoidf_(float x) { return fast_rcp(1.0f + fast_exp2(-1.4426950408889634f * x)); }
__device__ __forceinline__ float siluf_(float x) { return x * sigmoidf_(x); }
__device__ __forceinline__ float gelu_tanh_(float x) { const float u = 0.7978845608028654f * (x + 0.044715f * x * x * x); return x * fast_rcp(1.0f + fast_exp2(-2.885390081777927f * u)); }
__device__ __forceinline__ float wave_sum(float v) {
    int x = __float_as_int(v);
    v += __int_as_float(__builtin_amdgcn_update_dpp(0, x, 0xB1, 0xF, 0xF, false)); x = __float_as_int(v);
    v += __int_as_float(__builtin_amdgcn_update_dpp(0, x, 0x4E, 0xF, 0xF, false)); x = __float_as_int(v);
    v += __int_as_float(__builtin_amdgcn_update_dpp(0, x, 0x141, 0xF, 0xF, false)); x = __float_as_int(v);
    v += __int_as_float(__builtin_amdgcn_update_dpp(0, x, 0x140, 0xF, 0xF, false)); x = __float_as_int(v);
    return (__int_as_float(__builtin_amdgcn_readlane(x, 0)) + __int_as_float(__builtin_amdgcn_readlane(x, 16))) + (__int_as_float(__builtin_amdgcn_readlane(x, 32)) + __int_as_float(__builtin_amdgcn_readlane(x, 48)));
}
__device__ __forceinline__ float sum_x16(float v) { auto r = __builtin_amdgcn_permlane16_swap(__float_as_uint(v), __float_as_uint(v), false, false); return __uint_as_float(r[0]) + __uint_as_float(r[1]); }
__device__ __forceinline__ float sum_x32(float v) { auto r = __builtin_amdgcn_permlane32_swap(__float_as_uint(v), __float_as_uint(v), false, false); return __uint_as_float(r[0]) + __uint_as_float(r[1]); }
__device__ __forceinline__ float row16_sum(float v) {
    int x = __float_as_int(v);
    v += __int_as_float(__builtin_amdgcn_update_dpp(0, x, 0xB1, 0xF, 0xF, false)); x = __float_as_int(v);
    v += __int_as_float(__builtin_amdgcn_update_dpp(0, x, 0x4E, 0xF, 0xF, false)); x = __float_as_int(v);
    v += __int_as_float(__builtin_amdgcn_update_dpp(0, x, 0x141, 0xF, 0xF, false)); x = __float_as_int(v);
    v += __int_as_float(__builtin_amdgcn_update_dpp(0, x, 0x140, 0xF, 0xF, false));
    return v;
}
#define LDS_WAIT() asm volatile("s_waitcnt lgkmcnt(0)" ::: "memory")
#define VM_WAIT() asm volatile("s_waitcnt vmcnt(0)" ::: "memory")

#define XB_TMO      128
#define XB_XCNT(j)  (256  + 64 * (j))
#define XB_XSUB(j)  (1280 + 64 * (j))
#define XB_XGEN(j)  (2304 + 64 * (j))
#define XB_TOP      3328
#define XB_TOPGEN   3392
#define XCD_BAR_WORDS 3456
#define XB_SPIN_CAP (1u << 20)
__device__ __forceinline__ unsigned xb_ld(unsigned* p)              { return __hip_atomic_load(p, __ATOMIC_RELAXED, __HIP_MEMORY_SCOPE_AGENT); }
__device__ __forceinline__ unsigned xb_add(unsigned* p, unsigned v) { return __hip_atomic_fetch_add(p, v, __ATOMIC_RELAXED, __HIP_MEMORY_SCOPE_AGENT); }
__device__ __forceinline__ unsigned xb_xcc_id() { return (unsigned)__builtin_amdgcn_s_getreg((3 << 11) | 20) & 0xFu; }
#define XB_SPIN(cond, bar) do { unsigned _sp = 0; while (cond) { __builtin_amdgcn_s_sleep(1); \
    if ((++_sp & 255u) == 0u) { if (xb_ld(&(bar)[XB_TMO])) break; if (_sp > XB_SPIN_CAP) { atomicAdd(&(bar)[XB_TMO], 1u); break; } } } } while (0)
struct XcdBarrier { unsigned* bar; unsigned x; volatile LAS unsigned* st; };
__device__ __forceinline__ XcdBarrier xcd_barrier_post(unsigned* bar, volatile LAS unsigned* st) {
    XcdBarrier b; b.bar = bar; b.x = xb_xcc_id(); b.st = st;
    if (threadIdx.x == 0) (void)xb_add(&bar[XB_XCNT(b.x)], 1u);
    return b;
}
__device__ __forceinline__ void xcd_barrier_complete(unsigned* bar, unsigned x, unsigned& nloc, unsigned& nx) {
    const unsigned G = gridDim.x * gridDim.y * gridDim.z;
    unsigned sum, cnt, mine, sp = 0u;
    for (;;) {
        sum = 0u; cnt = 0u; mine = 0u;
#pragma unroll
        for (unsigned j = 0; j < 16; ++j) { const unsigned c = xb_ld(&bar[XB_XCNT(j)]); sum += c; cnt += (c > 0u) ? 1u : 0u; mine = (j == x) ? c : mine; }
        if (sum == G) break;
        __builtin_amdgcn_s_sleep(1);
        if ((++sp & 255u) == 0u) { if (xb_ld(&bar[XB_TMO])) break; if (sp > XB_SPIN_CAP) { atomicAdd(&bar[XB_TMO], 1u); break; } }
    }
    nloc = mine > 0u ? mine : 1u; nx = cnt > 0u ? cnt : 1u;
}
__device__ __forceinline__ void xcd_barrier(const XcdBarrier& b) {
    asm volatile("s_waitcnt vmcnt(0)" ::: "memory");
    __syncthreads();
    if (threadIdx.x == 0) {
        unsigned* bar = b.bar;
        __builtin_amdgcn_s_waitcnt(0);
        unsigned nloc = b.st[0], nx = b.st[1];
        if (nloc == 0u) { xcd_barrier_complete(bar, b.x, nloc, nx); b.st[0] = nloc; b.st[1] = nx; }
        const unsigned old = xb_add(&bar[XB_XSUB(b.x)], 1u);
        const unsigned gen = old / nloc;
        if (old + 1u == (gen + 1u) * nloc) {
            __builtin_amdgcn_fence(__ATOMIC_RELEASE, "agent");
            asm volatile("s_waitcnt vmcnt(0)" ::: "memory");
            const unsigned og = xb_add(&bar[XB_TOP], 1u);
            const unsigned tg = og / nx;
            if (og + 1u == (tg + 1u) * nx) xb_add(&bar[XB_TOPGEN], 1u);
            else XB_SPIN(xb_ld(&bar[XB_TOPGEN]) == tg, bar);
            __builtin_amdgcn_fence(__ATOMIC_ACQUIRE, "agent");
            xb_add(&bar[XB_XGEN(b.x)], 1u);
            asm volatile("s_waitcnt vmcnt(0)" ::: "memory");
        } else {
            XB_SPIN(xb_ld(&bar[XB_XGEN(b.x)]) == gen, bar);
            __builtin_amdgcn_fence(__ATOMIC_ACQUIRE, "agent");
            asm volatile("s_waitcnt vmcnt(0)" ::: "memory");
        }
    }
    __syncthreads();
}

namespace pg8 {
constexpr int BM = 256, BK = 64, HALF = 128, HTB = HALF * BK * 2, STAGE_BYTES = 8 * HTB, NXCD = 8, WGM = 8;
__host__ __device__ __forceinline__ int lds_byte(int r, int c) { const int st = (r >> 4) * 2 + (c >> 5), rr = r & 15, cc = c & 31, ob = rr * 64 + cc * 2; return st * 1024 + (ob ^ (((ob >> 9) & 1) << 5)); }
__host__ __device__ __forceinline__ void stage_rc(int b, int& R, int& C) { const int st = b / 1024, sb = b % 1024, swz = sb ^ (((sb >> 9) & 1) << 5); R = (st >> 1) * 16 + swz / 64; C = (st & 1) * 32 + (swz % 64) / 2; }
__host__ __device__ __forceinline__ int perm32(int rho) { const int n = rho >> 4, i = rho & 15; return 8 * (i >> 2) + 4 * n + (i & 3); }

struct Unit { int pm, pn, tag, gidx; size_t a_off, b_off; };
struct Gemm { const bf16_t* A; const bf16_t* Bt; int lda, ldb, K; int tiledA; const int* gather = nullptr; };

struct Order {
    int nM, nN, nwg, G, c;
    int mode;
    int nseg;
    int lda_rows;
    int ldb_rows;
    int seg_k;
    int n_per_group;
    int tstart[9];
    bool gathered;
    __device__ __forceinline__ void init(int nM_, int nN_, int G_, int c_, int mode_, int nseg_, int lda_, int ldb_, int segk_) {
        nM = nM_; nN = nN_; nwg = nM * nN; G = G_; c = c_; mode = mode_; nseg = nseg_; lda_rows = lda_; ldb_rows = ldb_; seg_k = segk_; n_per_group = 0; gathered = false;
    }
    __device__ __forceinline__ bool next(int i, Unit& u) const {
        const int ti = i / nseg, seg = i - ti * nseg;
        const long L = (long)ti * G + c;
        if (mode == 3) {
            if (L >= nwg + 80) return false;
            if (L >= nwg) { const int idx = (int)L - nwg, cb = idx / 5, j = idx - cb * 5; u.pm = cb * 9; u.pn = 7 + j; u.tag = 0; u.gidx = 0;
                u.a_off = (size_t)u.pm * BM * lda_rows; u.b_off = (size_t)u.pn * BM * ldb_rows; return true; }
        }
        if (L >= nwg) return false;
        int wgid = (int)L; { const int q = nwg / NXCD, r = nwg % NXCD, xcd = wgid % NXCD, off = wgid / NXCD; wgid = (xcd < r ? xcd * (q + 1) : r * (q + 1) + (xcd - r) * q) + off; }
        const int nig = WGM * nN, gid = wgid / nig, fm = gid * WGM, gsz = (nM - fm) < WGM ? (nM - fm) : WGM;
        int pm = fm + ((wgid % nig) % gsz); const int pn = (wgid % nig) / gsz;
        int grp = 0, gts = 0;
        if (mode == 1 || mode == 3) pm = (pm >> 3) * 9 + 1 + (pm & 7);
        if (mode == 2) {
#pragma unroll
            for (int e = 1; e < 8; ++e) { const bool ge = pm >= tstart[e]; grp += ge ? 1 : 0; gts = ge ? tstart[e] : gts; }
        }
        u.pm = pm; u.pn = pn; u.tag = (mode == 2) ? grp : seg; u.gidx = (mode == 2) ? grp * T + (pm - gts) * BM : 0;
        u.a_off = (gathered ? (size_t)0 : (size_t)pm * BM * lda_rows) + (size_t)seg * seg_k;
        u.b_off = ((size_t)grp * n_per_group + (size_t)pn * BM) * ldb_rows + (size_t)seg * seg_k * BM;
        return true;
    }
};

typedef f32x4 Acc[2][2][4][2];

template <class Epi, bool ALIGN_EPI, bool GATHER = false>
__device__ __forceinline__ void gemm_phase(LAS unsigned char* lds, const Gemm g, const Order& S, const Epi& E, const int tid) {
    const int wid = __builtin_amdgcn_readfirstlane(tid >> 6), lane = tid & 63, wr = wid >> 2, wc = wid & 3, fr = lane & 15, fq = lane >> 4;
    const int nt = g.K / BK;
    unsigned voffA[2], voffB[2];
#pragma unroll
    for (int i = 0; i < 2; ++i) { int R, C; stage_rc(tid * 16 + i * 8192, R, C); const int Rb = Epi::PERM ? ((R & ~31) + perm32(R & 31)) : R;
        voffA[i] = g.tiledA ? (unsigned)(tid * 16 + i * 8192) : (unsigned)(R * g.lda + C) * 2u; voffB[i] = (unsigned)(tid * 16 + i * 8192); (void)Rb; }
    int gR[2], gC[2]; unsigned cvo0[2] = {0u, 0u}, cvo1[2] = {0u, 0u}, nvo0[2] = {0u, 0u}, nvo1[2] = {0u, 0u};
#pragma unroll
    for (int i = 0; i < 2; ++i) stage_rc(tid * 16 + i * 8192, gR[i], gC[i]);
#define PG8_GLOAD(u_, o0, o1) do { _Pragma("unroll") for (int _i = 0; _i < 2; ++_i) { \
        o0[_i] = (unsigned)(g.gather[(u_).gidx + gR[_i]] * g.lda + gC[_i]) * 2u; o1[_i] = (unsigned)(g.gather[(u_).gidx + HALF + gR[_i]] * g.lda + gC[_i]) * 2u; } } while (0)
    const size_t kstep = (size_t)(BK * 2), kstepA = g.tiledA ? (size_t)32768 : kstep;
    const size_t hstepA = g.tiledA ? (size_t)16384 : (size_t)HALF * g.lda * 2, hstepB = 16384, kstepB = 32768;
    static_assert(Epi::PERM, "the tiled weight copies carry the PERM row order");
    const unsigned ldsw = (unsigned)wid * 1024u;
    const int aoff = lds_byte(wr * 64 + fr, fq * 8), boff = lds_byte(wc * 32 + fr, fq * 8);
#define PG8_SA(b, h) (((b) * 2 + (h)) * HTB)
#define PG8_SB(b, h) ((4 + (b) * 2 + (h)) * HTB)
#define PG8_STAGE(bufoff, gbase, voff) do { _Pragma("unroll") for (int _i = 0; _i < 2; ++_i) \
        __builtin_amdgcn_global_load_lds((const unsigned*)((const char*)(gbase) + (voff)[_i]), (LAS unsigned*)(lds + (bufoff) + ldsw + _i * 8192), 16, 0, 0); } while (0)
#define PG8_STA(bufoff, gbase, h, v0, v1) do { if constexpr (GATHER) { if (h) PG8_STAGE(bufoff, gbase, v1); else PG8_STAGE(bufoff, gbase, v0); } else PG8_STAGE(bufoff, (gbase) + (h) * hstepA, voffA); } while (0)
#define PG8_LDA(dst, b, h) do { _Pragma("unroll") for (int m = 0; m < 4; ++m) _Pragma("unroll") for (int k = 0; k < 2; ++k) dst[m][k] = *(const LAS bf16x8*)(lds + PG8_SA(b, h) + aoff + m * 2048 + k * 1024); } while (0)
#define PG8_LDB(dst, b, h) do { _Pragma("unroll") for (int n = 0; n < 2; ++n) _Pragma("unroll") for (int k = 0; k < 2; ++k) dst[n][k] = *(const LAS bf16x8*)(lds + PG8_SB(b, h) + boff + n * 2048 + k * 1024); } while (0)
#define PG8_MMA(ai, bj, At, Bt) do { __builtin_amdgcn_s_setprio(1); _Pragma("unroll") for (int m = 0; m < 4; ++m) _Pragma("unroll") for (int n = 0; n < 2; ++n) _Pragma("unroll") for (int k = 0; k < 2; ++k) \
        acc[ai][bj][m][n] = __builtin_amdgcn_mfma_f32_16x16x32_bf16(Bt[n][k], At[m][k], acc[ai][bj][m][n], 0, 0, 0); __builtin_amdgcn_s_setprio(0); } while (0)
#define PG8_WAIT_V(n) asm volatile("s_waitcnt vmcnt(" #n ")" ::: "memory")
#define PG8_WAIT_L(n) asm volatile("s_waitcnt lgkmcnt(" #n ")" ::: "memory")
#define PG8_BAR __builtin_amdgcn_s_barrier()
#define PG8_SCHED __builtin_amdgcn_sched_barrier(0)
    Unit cur, nxt; int ui = 0;
    if (!S.next(0, cur)) return;
    Acc acc;
#pragma unroll
    for (int a = 0; a < 2; ++a)
#pragma unroll
        for (int b = 0; b < 2; ++b)
#pragma unroll
            for (int m = 0; m < 4; ++m)
#pragma unroll
                for (int n = 0; n < 2; ++n) acc[a][b][m][n] = (f32x4){0.f, 0.f, 0.f, 0.f};
    bf16x8 At[4][2], B0[2][2], B1[2][2];
    const char* cA = (const char*)g.A + cur.a_off * 2; const char* cB = (const char*)g.Bt + cur.b_off * 2;
    if constexpr (GATHER) PG8_GLOAD(cur, cvo0, cvo1);
    PG8_STAGE(PG8_SB(0, 0), cB, voffB); PG8_STAGE(PG8_SB(0, 1), cB + hstepB, voffB); PG8_STA(PG8_SA(0, 0), cA, 0, cvo0, cvo1); PG8_STA(PG8_SA(0, 1), cA, 1, cvo0, cvo1);
    if (wr == 1) PG8_BAR;
    PG8_WAIT_V(2); PG8_BAR;
    PG8_STAGE(PG8_SB(1, 0), cB + kstepB, voffB); PG8_STA(PG8_SA(1, 0), cA + kstepA, 0, cvo0, cvo1); PG8_STAGE(PG8_SB(1, 1), cB + hstepB + kstepB, voffB);
    PG8_WAIT_V(6); PG8_BAR;
    for (;;) {
        const bool has_next = S.next(ui + 1, nxt);
        const char* nA = has_next ? (const char*)g.A + nxt.a_off * 2 : cA; const char* nB = has_next ? (const char*)g.Bt + nxt.b_off * 2 : cB;
        if constexpr (GATHER) { if (has_next) {
#pragma unroll
            for (int k = 0; k < 4; ++k) __builtin_amdgcn_global_load_lds((const unsigned*)(g.gather + nxt.gidx + (k >> 1) * HALF + gR[k & 1]), (LAS unsigned*)(lds + RING_BYTES + (wid * 4 + k) * 256), 4, 0, 0); } }
        for (int t = 0; t < nt; t += 2) {
            const bool last = (t == nt - 2);
            const char* a1 = cA + (size_t)(t + 1) * kstepA;
            const char* a2 = last ? nA : cA + (size_t)(t + 2) * kstepA; const char* b2 = last ? nB : cB + (size_t)(t + 2) * kstepB;
            const char* a3 = a2 + kstepA; const char* b3 = b2 + kstepB;
            unsigned s0[2] = {0u, 0u}, s1[2] = {0u, 0u};
            if constexpr (GATHER) {
                if (last && has_next) {
#pragma unroll
                    for (int i = 0; i < 2; ++i) { const int t0 = *(const LAS int*)(lds + RING_BYTES + (wid * 4 + i) * 256 + lane * 4), t1 = *(const LAS int*)(lds + RING_BYTES + (wid * 4 + 2 + i) * 256 + lane * 4);
                        nvo0[i] = (unsigned)(t0 * g.lda + gC[i]) * 2u; nvo1[i] = (unsigned)(t1 * g.lda + gC[i]) * 2u; } }
                else if (last) { nvo0[0] = cvo0[0]; nvo0[1] = cvo0[1]; nvo1[0] = cvo1[0]; nvo1[1] = cvo1[1]; }
                s0[0] = last ? nvo0[0] : cvo0[0]; s0[1] = last ? nvo0[1] : cvo0[1]; s1[0] = last ? nvo1[0] : cvo1[0]; s1[1] = last ? nvo1[1] : cvo1[1]; }
            PG8_LDB(B0, 0, 0); PG8_LDB(B1, 0, 1); PG8_SCHED; PG8_LDA(At, 0, 0); PG8_STA(PG8_SA(1, 1), a1, 1, cvo0, cvo1);
            PG8_WAIT_V(8); PG8_WAIT_L(0); PG8_BAR; PG8_MMA(0, 0, At, B0); PG8_MMA(0, 1, At, B1); PG8_BAR; PG8_SCHED;
            PG8_LDA(At, 0, 1); PG8_STAGE(PG8_SB(0, 0), b2, voffB); PG8_STAGE(PG8_SB(0, 1), b2 + hstepB, voffB); PG8_STA(PG8_SA(0, 0), a2, 0, s0, s1);
            PG8_WAIT_V(8); PG8_WAIT_L(0); PG8_BAR; PG8_MMA(1, 0, At, B0); PG8_MMA(1, 1, At, B1); PG8_BAR; PG8_SCHED;
            PG8_LDB(B0, 1, 0); PG8_LDB(B1, 1, 1); PG8_SCHED; PG8_LDA(At, 1, 0); PG8_STA(PG8_SA(0, 1), a2, 1, s0, s1);
            PG8_WAIT_V(8); PG8_WAIT_L(0); PG8_BAR; PG8_MMA(0, 0, At, B0); PG8_MMA(0, 1, At, B1); PG8_BAR; PG8_SCHED;
            PG8_LDA(At, 1, 1); PG8_STAGE(PG8_SB(1, 0), b3, voffB); PG8_STAGE(PG8_SB(1, 1), b3 + hstepB, voffB); PG8_STA(PG8_SA(1, 0), a3, 0, s0, s1);
            PG8_WAIT_V(8); PG8_WAIT_L(0); PG8_BAR; PG8_MMA(1, 0, At, B0); PG8_MMA(1, 1, At, B1); PG8_BAR; PG8_SCHED;
        }
        if constexpr (ALIGN_EPI) { if (wr == 0) PG8_BAR; }
        E(acc, cur, wr, wc, fr, fq);
        if (!has_next) break;
        if constexpr (!Epi::KEEP_ACC) {
#pragma unroll
            for (int a = 0; a < 2; ++a)
#pragma unroll
                for (int b = 0; b < 2; ++b)
#pragma unroll
                    for (int m = 0; m < 4; ++m)
#pragma unroll
                        for (int n = 0; n < 2; ++n) acc[a][b][m][n] = (f32x4){0.f, 0.f, 0.f, 0.f};
        }
        cur = nxt; cA = nA; cB = nB; ++ui;
        if constexpr (GATHER) { cvo0[0] = nvo0[0]; cvo0[1] = nvo0[1]; cvo1[0] = nvo1[0]; cvo1[1] = nvo1[1]; }
        if constexpr (ALIGN_EPI) { if (wr == 1) PG8_BAR; }
    }
    PG8_WAIT_V(0);
    if constexpr (!ALIGN_EPI) { if (wr == 0) PG8_BAR; }
    PG8_BAR;
#undef PG8_SA
#undef PG8_SB
#undef PG8_STAGE
#undef PG8_LDA
#undef PG8_STA
#undef PG8_GLOAD
#undef PG8_LDB
#undef PG8_MMA
#undef PG8_WAIT_V
#undef PG8_WAIT_L
#undef PG8_BAR
#undef PG8_SCHED
}

__device__ __forceinline__ u32x4 pack8(const f32x4 v0, const f32x4 v1) { u32x4 w; w.x = cvt_pk_bf16(v0[0], v0[1]); w.y = cvt_pk_bf16(v0[2], v0[3]); w.z = cvt_pk_bf16(v1[0], v1[1]); w.w = cvt_pk_bf16(v1[2], v1[3]); return w; }
__device__ __forceinline__ void unpack8(const u32x4 w, f32x4& v0, f32x4& v1) { v0 = (f32x4){bflo(w.x), bfhi(w.x), bflo(w.y), bfhi(w.y)}; v1 = (f32x4){bflo(w.z), bfhi(w.z), bflo(w.w), bfhi(w.w)}; }

__device__ __forceinline__ size_t tiled_a_off(int pm, int Ktot, int ai, int wr, int m, int fr, int fq, int c) {
    const int kt = c >> 6, st = ((4 * wr + m) << 1) + ((c >> 5) & 1), ob = (64 * fr + 16 * fq) ^ ((fr >> 3) << 5);
    return (size_t)pm * BM * Ktot + (size_t)kt * 16384 + ai * 8192 + st * 512 + (ob >> 1);
}
struct EpiPlain {
    static constexpr bool PERM = true, KEEP_ACC = false;
    bf16_t* O; int ldc;
    __device__ __forceinline__ void operator()(Acc& acc, const Unit& u, int wr, int wc, int fr, int fq) const {
        const int row0 = u.pm * BM + wr * 64 + fr, col0 = u.pn * BM + wc * 32 + 8 * fq;
#pragma unroll
        for (int ai = 0; ai < 2; ++ai)
#pragma unroll
            for (int m = 0; m < 4; ++m) { bf16_t* rowp = O + (size_t)(row0 + ai * HALF + m * 16) * ldc + col0;
#pragma unroll
                for (int bj = 0; bj < 2; ++bj) *(u32x4*)(rowp + bj * HALF) = pack8(acc[ai][bj][m][0], acc[ai][bj][m][1]); }
    }
};
struct EpiQ {
    static constexpr bool PERM = true, KEEP_ACC = false;
    bf16_t* Q; const float* gqn; const unsigned long long* stats; LAS float* red;
    __device__ __forceinline__ void operator()(Acc& acc, const Unit& u, int wr, int wc, int fr, int fq) const {
        asm volatile("" : "+v"(fr), "+v"(fq));
        const int b = u.pm / 9, tq = u.pm - b * 9, row0 = u.pm * BM + wr * 64 + fr;
        LAS f32x4* info = (LAS f32x4*)(red + 1536);
        const int rl = wc * 64 + fq * 16 + fr;
        unsigned long long s0 = 0;
        if (wr == 0) s0 = stats[(size_t)(u.pm * BM + rl) * 4];
        float g[8];
#pragma unroll
        for (int j = 0; j < 8; ++j) g[j] = gqn[32 * (wc < 3 ? wc : 0) + 8 * fq + j];
        if (wc < 3) {
#pragma unroll
            for (int ai = 0; ai < 2; ++ai)
#pragma unroll
                for (int bj = 0; bj < 2; ++bj)
#pragma unroll
                    for (int m = 0; m < 4; ++m) { const f32x4 p = acc[ai][bj][m][0] * acc[ai][bj][m][0] + acc[ai][bj][m][1] * acc[ai][bj][m][1];
                        float sq = (p[0] + p[1]) + (p[2] + p[3]); sq = sum_x32(sum_x16(sq));
                        if (fq == 0) red[((wr * 4 + ai * 2 + bj) * 3 + wc) * 64 + m * 16 + fr] = sq; }
        }
        asm volatile("s_waitcnt lgkmcnt(0)" ::: "memory"); __builtin_amdgcn_s_barrier(); asm volatile("" ::: "memory");
        if (wr == 0) {
            const float r = 1.0f / sqrtf((float)s0 * (1.0f / (1048576.0f * 768.0f)) + NORM_EPS);
            const int ri = ((((rl >> 6) & 1) * 4 + (rl >> 7) * 2) * 3) * 64 + (rl & 63);
            const float ss0 = red[ri] + red[ri + 64] + red[ri + 128], ss1 = red[ri + 192] + red[ri + 256] + red[ri + 320];
            info[rl] = (f32x4){r * QSCALE / sqrtf(ss0 * r * r * (1.0f / 96.0f) + NORM_EPS), r * QSCALE / sqrtf(ss1 * r * r * (1.0f / 96.0f) + NORM_EPS), 0.f, 0.f};
        }
        asm volatile("s_waitcnt lgkmcnt(0)" ::: "memory"); __builtin_amdgcn_s_barrier(); asm volatile("" ::: "memory");
        if (wc < 3) {
            const float sgn = (fq & 1) ? 1.0f : -1.0f;
#pragma unroll
            for (int ai = 0; ai < 2; ++ai)
#pragma unroll
                for (int m = 0; m < 4; ++m) { const f32x4 inf = info[ai * HALF + wr * 64 + m * 16 + fr]; const int tk = tq * 4 + 2 * ai + wr;
                    bf16_t* qp = Q + (size_t)(row0 + ai * HALF + m * 16) * 768 + 96 * (2 * u.pn) + 32 * wc + 8 * fq;
#pragma unroll
                    for (int bj = 0; bj < 2; ++bj) { const float sc = inf[bj];
                        f32x4 v0, v1;
#pragma unroll
                        for (int i = 0; i < 4; ++i) { v0[i] = acc[ai][bj][m][0][i] * sc * g[i]; v1[i] = acc[ai][bj][m][1][i] * sc * g[4 + i]; }
                        if (wc == 2 && tq > 0) { const LAS f32x4* tp = (const LAS f32x4*)(red + 2560) + ((fq >> 1) == 0 ? (tk - 4) : (16 * m + fr)) * 4;
                            const f32x4 c0 = tp[0], c1 = tp[1], c2 = tp[2], c3 = tp[3];
                            f32x4 p0, p1;
#pragma unroll
                            for (int i = 0; i < 4; ++i) { p0[i] = __shfl_xor(v0[i], 16); p1[i] = __shfl_xor(v1[i], 16); }
                            v0[0] = v0[0] * c0[0] + sgn * p0[0] * c0[1]; v0[1] = v0[1] * c0[2] + sgn * p0[1] * c0[3]; v0[2] = v0[2] * c1[0] + sgn * p0[2] * c1[1]; v0[3] = v0[3] * c1[2] + sgn * p0[3] * c1[3];
                            v1[0] = v1[0] * c2[0] + sgn * p1[0] * c2[1]; v1[1] = v1[1] * c2[2] + sgn * p1[1] * c2[3]; v1[2] = v1[2] * c3[0] + sgn * p1[2] * c3[1]; v1[3] = v1[3] * c3[2] + sgn * p1[3] * c3[3]; }
                        *(u32x4*)(qp + 96 * bj) = pack8(v0, v1); } }
        }
        asm volatile("" :: "v"(g[0]), "v"(g[1]), "v"(g[2]), "v"(g[3]), "v"(g[4]), "v"(g[5]), "v"(g[6]), "v"(g[7]));
    }
};
struct EpiKV {
    static constexpr bool PERM = true, KEEP_ACC = false;
    bf16_t* Kt; bf16_t* Vt; const bf16_t* KR; const float* gkn; const unsigned long long* stats; LAS float* red;
    __device__ __forceinline__ void operator()(Acc& acc, const Unit& u, int wr, int wc, int fr, int fq) const {
        asm volatile("" : "+v"(fr), "+v"(fq));
        const int b = u.pm / 9, tq = u.pm - b * 9, row0 = u.pm * BM + wr * 64 + fr;
        const bool kw = wc < 2;
        LAS f32x4* info = (LAS f32x4*)(red + 1536);
        const int rl = wc * 64 + fq * 16 + fr;
        unsigned long long s1 = 0, s2 = 0;
        if (wr == 0) { s1 = stats[(size_t)(u.pm * BM + rl) * 4 + 1]; s2 = stats[(size_t)(u.pm * BM + rl) * 4 + 2]; }
        u32x4 krw[2][4];
#pragma unroll
        for (int ai = 0; ai < 2; ++ai)
#pragma unroll
            for (int m = 0; m < 4; ++m) { krw[ai][m] = (u32x4){0u, 0u, 0u, 0u}; if (!kw) krw[ai][m] = *(const u32x4*)(KR + (size_t)(row0 + ai * HALF + m * 16) * 32 + 8 * fq); }
        float gk[8], gp[8];
#pragma unroll
        for (int j = 0; j < 8; ++j) { gk[j] = gkn[(kw ? 32 * wc : 64) + 8 * fq + j]; gp[j] = gkn[64 + 8 * (fq ^ 1) + j]; }
        if (kw) {
#pragma unroll
            for (int ai = 0; ai < 2; ++ai)
#pragma unroll
                for (int bj = 0; bj < 2; ++bj)
#pragma unroll
                    for (int m = 0; m < 4; ++m) { const f32x4 p = acc[ai][bj][m][0] * acc[ai][bj][m][0] + acc[ai][bj][m][1] * acc[ai][bj][m][1];
                        float sq = (p[0] + p[1]) + (p[2] + p[3]); sq = sum_x32(sum_x16(sq));
                        if (fq == 0) red[((wr * 4 + ai * 2 + bj) * 2 + wc) * 64 + m * 16 + fr] = sq; }
        }
        asm volatile("s_waitcnt lgkmcnt(0)" ::: "memory"); __builtin_amdgcn_s_barrier(); asm volatile("" ::: "memory");
        if (wr == 0) {
            const float r = 1.0f / sqrtf((float)s1 * (1.0f / (1048576.0f * 256.0f)) + NORM_EPS), krss = (float)s2 * (1.0f / 1048576.0f);
            const int ri = ((((rl >> 6) & 1) * 4 + (rl >> 7) * 2) * 2) * 64 + (rl & 63);
            const float ss0 = red[ri] + red[ri + 64], ss1 = red[ri + 128] + red[ri + 192];
            info[rl] = (f32x4){r, 1.0f / sqrtf((ss0 * r * r + krss) * (1.0f / 96.0f) + NORM_EPS), 1.0f / sqrtf((ss1 * r * r + krss) * (1.0f / 96.0f) + NORM_EPS), 0.f};
        }
        asm volatile("s_waitcnt lgkmcnt(0)" ::: "memory"); __builtin_amdgcn_s_barrier(); asm volatile("" ::: "memory");
        if (kw) {
#pragma unroll
            for (int ai = 0; ai < 2; ++ai)
#pragma unroll
                for (int m = 0; m < 4; ++m) { const f32x4 inf = info[ai * HALF + wr * 64 + m * 16 + fr];
#pragma unroll
                    for (int bj = 0; bj < 2; ++bj) { const float sc = inf[0] * inf[1 + bj];
                        f32x4 v0, v1;
#pragma unroll
                        for (int i = 0; i < 4; ++i) { v0[i] = acc[ai][bj][m][0][i] * sc * gk[i]; v1[i] = acc[ai][bj][m][1][i] * sc * gk[4 + i]; }
                        *(u32x4*)(Kt + ((size_t)((b * 8 + 2 * u.pn + bj) * 36 + tq * 4 + 2 * ai + wr) * 12 + 4 * wc + fq) * 512 + (16 * m + fr) * 8) = pack8(v0, v1); } }
        } else {
            const int dh = wc - 2;
            const float sgn = (fq & 1) ? 1.0f : -1.0f;
#pragma unroll
            for (int ai = 0; ai < 2; ++ai)
#pragma unroll
                for (int m = 0; m < 4; ++m) { const int tk = tq * 4 + 2 * ai + wr; const float r = info[ai * HALF + wr * 64 + m * 16 + fr][0];
#pragma unroll
                    for (int bj = 0; bj < 2; ++bj)
                        *(u32x4*)(Vt + ((size_t)(((((b * 8 + 2 * u.pn + bj) * 36 + tk) * 2 + dh) * 4 + m) * 16 + fr)) * 32 + fq * 8) = pack8(acc[ai][bj][m][0] * r, acc[ai][bj][m][1] * r); }
            __builtin_amdgcn_sched_barrier(0);
#pragma unroll
            for (int ai = 0; ai < 2; ++ai)
#pragma unroll
                for (int m = 0; m < 4; ++m) { const int tk = tq * 4 + 2 * ai + wr; const f32x4 inf = info[ai * HALF + wr * 64 + m * 16 + fr]; const float n = dh ? inf[2] : inf[1];
                    const u32x4 wo = krw[ai][m]; u32x4 wp;
                    wp.x = (unsigned)__shfl_xor((int)wo.x, 16); wp.y = (unsigned)__shfl_xor((int)wo.y, 16); wp.z = (unsigned)__shfl_xor((int)wo.z, 16); wp.w = (unsigned)__shfl_xor((int)wo.w, 16);
                    f32x4 x0, x1, p0, p1; unpack8(wo, x0, x1); unpack8(wp, p0, p1);
                    f32x4 o0, o1;
                    if (tq > 0) { const LAS f32x4* tp = (const LAS f32x4*)(red + 2560) + ((fq >> 1) == 0 ? (tk - 4) : (16 * m + fr)) * 4;
                        const f32x4 c0 = tp[0], c1 = tp[1], c2 = tp[2], c3 = tp[3];
#define EKV_ROT(o, i, xo, xp, j, cc, sv) o[i] = (xo) * n * gk[j] * (cc) + sgn * ((xp) * n * gp[j]) * (sv);
                        EKV_ROT(o0, 0, x0[0], p0[0], 0, c0[0], c0[1]) EKV_ROT(o0, 1, x0[1], p0[1], 1, c0[2], c0[3]) EKV_ROT(o0, 2, x0[2], p0[2], 2, c1[0], c1[1]) EKV_ROT(o0, 3, x0[3], p0[3], 3, c1[2], c1[3])
                        EKV_ROT(o1, 0, x1[0], p1[0], 4, c2[0], c2[1]) EKV_ROT(o1, 1, x1[1], p1[1], 5, c2[2], c2[3]) EKV_ROT(o1, 2, x1[2], p1[2], 6, c3[0], c3[1]) EKV_ROT(o1, 3, x1[3], p1[3], 7, c3[2], c3[3])
#undef EKV_ROT
                    } else {
#pragma unroll
                        for (int i = 0; i < 4; ++i) { o0[i] = x0[i] * n * gk[i]; o1[i] = x1[i] * n * gk[4 + i]; }
                    }
                    *(u32x4*)(Kt + ((size_t)((b * 8 + 2 * u.pn + dh) * 36 + tk) * 12 + 8 + fq) * 512 + (16 * m + fr) * 8) = pack8(o0, o1);
                    __builtin_amdgcn_sched_barrier(0); }
        }
        asm volatile("" :: "v"(gk[0]), "v"(gk[1]), "v"(gk[2]), "v"(gk[3]), "v"(gk[4]), "v"(gk[5]), "v"(gk[6]), "v"(gk[7]));
        asm volatile("" :: "v"(gp[0]), "v"(gp[1]), "v"(gp[2]), "v"(gp[3]), "v"(gp[4]), "v"(gp[5]), "v"(gp[6]), "v"(gp[7]));
    }
};
struct EpiSwiGLU {
    static constexpr bool PERM = true, KEEP_ACC = false;
    bf16_t* O; int ldc;
    __device__ __forceinline__ void operator()(Acc& acc, const Unit& u, int wr, int wc, int fr, int fq) const {
        const int cbase = u.pn * HALF + wc * 32;
#pragma unroll
        for (int ai = 0; ai < 2; ++ai)
#pragma unroll
            for (int m = 0; m < 4; ++m) { bf16_t* rowp = O + tiled_a_off(u.pm, ldc, ai, wr, m, fr, fq, cbase);
                f32x4 v0, v1;
#pragma unroll
                for (int i = 0; i < 4; ++i) { v0[i] = siluf_(acc[ai][0][m][0][i]) * acc[ai][1][m][0][i]; v1[i] = siluf_(acc[ai][0][m][1][i]) * acc[ai][1][m][1][i]; }
                *(u32x4*)rowp = pack8(v0, v1); }
    }
};
struct EpiWin {
    static constexpr bool PERM = true, KEEP_ACC = false;
    bf16_t *U, *ZQ, *ZKV, *ZR, *G, *KR; const float* bgate; unsigned long long* stats;
    __device__ __forceinline__ void operator()(Acc& acc, const Unit& u, int wr, int wc, int fr, int fq) const {
        const int row0 = u.pm * BM + wr * 64 + fr, cl = wc * 32 + 8 * fq, pn = u.pn;
        if (pn < 4) {
#pragma unroll
            for (int ai = 0; ai < 2; ++ai)
#pragma unroll
                for (int m = 0; m < 4; ++m) { bf16_t* rowp = U + (size_t)(row0 + ai * HALF + m * 16) * 512 + pn * HALF + cl;
                    f32x4 v0, v1;
#pragma unroll
                    for (int i = 0; i < 4; ++i) { v0[i] = acc[ai][0][m][0][i] * sigmoidf_(acc[ai][1][m][0][i]); v1[i] = acc[ai][0][m][1][i] * sigmoidf_(acc[ai][1][m][1][i]); }
                    *(u32x4*)rowp = pack8(v0, v1); }
        } else if (pn == 24) {
            if (wc == 0) {
#pragma unroll
                for (int ai = 0; ai < 2; ++ai)
#pragma unroll
                    for (int m = 0; m < 4; ++m) { const int row = row0 + ai * HALF + m * 16;
                        *(u32x4*)(KR + (size_t)row * 32 + 8 * fq) = pack8(acc[ai][0][m][0], acc[ai][0][m][1]);
                        const f32x4 s4 = acc[ai][0][m][0] * acc[ai][0][m][0] + acc[ai][0][m][1] * acc[ai][0][m][1];
                        float sq = (s4[0] + s4[1]) + (s4[2] + s4[3]); sq = sum_x32(sum_x16(sq));
                        if (fq == 0) (void)__hip_atomic_fetch_add(stats + (size_t)row * 4 + 2, (unsigned long long)(sq * 1048576.0f), __ATOMIC_RELAXED, __HIP_MEMORY_SCOPE_AGENT); }
            }
        } else if (pn >= 12) {
            const int cb = (pn - 12) * BM;
            unsigned char* gq = (unsigned char*)G + ((((size_t)(u.pm * 12 + (pn - 12)) * 8 + (wr * 4 + wc)) * 8) * 64 + (fq * 16 + fr)) * 16;
            f32x4 bv[2][2];
#pragma unroll
            for (int bj = 0; bj < 2; ++bj)
#pragma unroll
                for (int n = 0; n < 2; ++n) bv[bj][n] = *(const f32x4*)(bgate + cb + bj * HALF + cl + 4 * n);
#pragma unroll
            for (int ai = 0; ai < 2; ++ai)
#pragma unroll
                for (int m = 0; m < 4; ++m) { unsigned w[4] = {0u, 0u, 0u, 0u};
#pragma unroll
                    for (int bj = 0; bj < 2; ++bj)
#pragma unroll
                        for (int n = 0; n < 2; ++n)
#pragma unroll
                            for (int i = 0; i < 4; ++i) w[bj * 2 + n] = __builtin_amdgcn_cvt_pk_u8_f32(fmaf(sigmoidf_(acc[ai][bj][m][n][i] + bv[bj][n][i]), 254.0f, 1.0f), i, w[bj * 2 + n]);
                    *(u32x4*)(gq + (size_t)((ai * 4 + m) * 64) * 16) = (u32x4){w[0], w[1], w[2], w[3]}; }
        } else {
            bf16_t* base; int ldc, cb, act = 0;
            if (pn < 7) { base = ZQ; ldc = 768; cb = (pn - 4) * BM; }
            else if (pn == 7) { base = ZKV; ldc = 256; cb = 0; }
            else { base = ZR; ldc = 1024; cb = (pn - 8) * BM; act = (pn >= 10) ? 1 : 0; }
#pragma unroll
            for (int ai = 0; ai < 2; ++ai)
#pragma unroll
                for (int m = 0; m < 4; ++m) { bf16_t* rowp = base + (size_t)(row0 + ai * HALF + m * 16) * ldc + cb + cl;
#pragma unroll
                    for (int bj = 0; bj < 2; ++bj) { f32x4 v0 = acc[ai][bj][m][0], v1 = acc[ai][bj][m][1];
                        if (act == 1) {
#pragma unroll
                            for (int i = 0; i < 4; ++i) { v0[i] = gelu_tanh_(v0[i]); v1[i] = gelu_tanh_(v1[i]); } }
                        *(u32x4*)(rowp + bj * HALF) = pack8(v0, v1); }
                    if (pn < 8) {
                        const f32x4 s4 = (acc[ai][0][m][0] * acc[ai][0][m][0] + acc[ai][0][m][1] * acc[ai][0][m][1]) + (acc[ai][1][m][0] * acc[ai][1][m][0] + acc[ai][1][m][1] * acc[ai][1][m][1]);
                        float sq = (s4[0] + s4[1]) + (s4[2] + s4[3]); sq = sum_x32(sum_x16(sq));
                        if (fq == 0) (void)__hip_atomic_fetch_add(stats + (size_t)(row0 + ai * HALF + m * 16) * 4 + (pn == 7 ? 1 : 0), (unsigned long long)(sq * 1048576.0f), __ATOMIC_RELAXED, __HIP_MEMORY_SCOPE_AGENT); } }
        }
    }
};
struct EpiMerge {
    static constexpr bool PERM = true, KEEP_ACC = true;
    const bf16_t* G; bf16_t* M;
    __device__ __forceinline__ static void codes(unsigned w, f32x4& v) { v[0] = (float)(w & 0xffu); v[1] = (float)((w >> 8) & 0xffu); v[2] = (float)((w >> 16) & 0xffu); v[3] = (float)(w >> 24); }
    __device__ __forceinline__ void operator()(Acc& acc, const Unit& u, int wr, int wc, int fr, int fq) const {
        const int seg = u.tag;
        const unsigned char* gbase = (const unsigned char*)G + ((((size_t)(u.pm * 12 + seg * 4 + u.pn) * 8 + (wr * 4 + wc)) * 8) * 64 + (fq * 16 + fr)) * 16;
        const size_t nxt = (seg < 2) ? (size_t)4 * 8 * 8 * 64 * 16 : 0;
#pragma unroll
        for (int ai = 0; ai < 2; ++ai)
#pragma unroll
            for (int mh = 0; mh < 2; ++mh) {
                u32x4 ga[2], gb[2];
#pragma unroll
                for (int mm = 0; mm < 2; ++mm) { const unsigned char* gp = gbase + (size_t)((ai * 4 + 2 * mh + mm) * 64) * 16; ga[mm] = *(const u32x4*)gp; gb[mm] = *(const u32x4*)(gp + nxt); }
                asm volatile("" ::: "memory");
#pragma unroll
                for (int mm = 0; mm < 2; ++mm) { const int m = 2 * mh + mm;
#pragma unroll
                    for (int bj = 0; bj < 2; ++bj) { f32x4 a0, a1; codes(ga[mm][2 * bj], a0); codes(ga[mm][2 * bj + 1], a1);
                        if (seg < 2) { f32x4 b0, b1; codes(gb[mm][2 * bj], b0); codes(gb[mm][2 * bj + 1], b1);
#pragma unroll
                            for (int i = 0; i < 4; ++i) { acc[ai][bj][m][0][i] *= a0[i] * fast_rcp(b0[i]); acc[ai][bj][m][1][i] *= a1[i] * fast_rcp(b1[i]); }
                        } else {
                            *(u32x4*)(M + tiled_a_off(u.pm, 1024, ai, wr, m, fr, fq, u.pn * BM + bj * HALF + wc * 32)) = pack8(acc[ai][bj][m][0] * (a0 * (1.0f / 255.0f)), acc[ai][bj][m][1] * (a1 * (1.0f / 255.0f)));
                            acc[ai][bj][m][0] = (f32x4){0.f, 0.f, 0.f, 0.f}; acc[ai][bj][m][1] = (f32x4){0.f, 0.f, 0.f, 0.f};
                        } } }
                asm volatile("" ::: "memory"); }
    }
};
struct EpiResid {
    static constexpr bool PERM = true, KEEP_ACC = false;
    bf16_t* X; const float* mod; int gsel;
    __device__ __forceinline__ void operator()(Acc& acc, const Unit& u, int wr, int wc, int fr, int fq) const {
        const int b = u.pm / 9, j = u.pm - b * 9, mi = (j == 0) ? 16 : b;
        const float* ga = mod + (size_t)mi * 6144 + gsel * 1024;
        const int col0 = u.pn * BM + wc * 32 + 8 * fq;
        bf16_t* xb = X + (size_t)(u.pm * BM + wr * 64 + fr) * DM + col0;
        f32x4 gv[2][2];
#pragma unroll
        for (int bj = 0; bj < 2; ++bj)
#pragma unroll
            for (int n = 0; n < 2; ++n) gv[bj][n] = *(const f32x4*)(ga + col0 + bj * HALF + 4 * n);
#pragma unroll
        for (int ai = 0; ai < 2; ++ai)
#pragma unroll
            for (int mh = 0; mh < 2; ++mh) {
                u32x4 xw[2][2];
#pragma unroll
                for (int mm = 0; mm < 2; ++mm)
#pragma unroll
                    for (int bj = 0; bj < 2; ++bj) xw[mm][bj] = *(const u32x4*)(xb + (size_t)(ai * HALF + (2 * mh + mm) * 16) * DM + bj * HALF);
                asm volatile("" ::: "memory");
#pragma unroll
                for (int mm = 0; mm < 2; ++mm) { const int m = 2 * mh + mm;
#pragma unroll
                    for (int bj = 0; bj < 2; ++bj) { f32x4 x0, x1; unpack8(xw[mm][bj], x0, x1);
                        *(u32x4*)(xb + (size_t)(ai * HALF + m * 16) * DM + bj * HALF) = pack8(x0 + gv[bj][0] * acc[ai][bj][m][0], x1 + gv[bj][1] * acc[ai][bj][m][1]); } }
                asm volatile("" ::: "memory"); }
    }
};
}

struct Args {
    const float* in[38];
    float* out; unsigned char* ws;
    int ph_lo, ph_hi;
};
enum InIdx { I_X = 0, I_C, I_CTX, I_CCTX, I_WADA, I_BADA, I_GN1, I_GN2, I_WIN, I_BGATE, I_CONVW, I_CONVB, I_CLNG, I_CLNB, I_WOCONV, I_GQA, I_WQB, I_GKVA, I_WKVB, I_GQN, I_GKN, I_WOMLA,
             I_RCW, I_RCB, I_WRA, I_BRA, I_WRI, I_BRI, I_LAM, I_WOREC, I_WOUT, I_WFG, I_WFU, I_WFD, I_WROUTER, I_WEG, I_WEU, I_WED };

struct Frame {
    LAS unsigned char* lds;
    int tid, lane, wave, G, bid;
    unsigned char* ws;
};

__device__ __forceinline__ void tr_tile(const float* src, int ld_src, int col0, int nvalid, int k0, const float* kscale, bf16_t* dst, int Ktot, int n0, int kd0, LAS float* scr, int lane) {
    const int c4 = (lane & 15) * 4, rsub = lane >> 4;
#pragma unroll 4
    for (int i = 0; i < 16; ++i) { const int kk = 4 * i + rsub;
        f32x4 v = (f32x4){0.f, 0.f, 0.f, 0.f};
        if (c4 < nvalid) v = *(const f32x4*)(src + (size_t)(k0 + kk) * ld_src + col0 + c4);
        if (kscale) v = v * kscale[k0 + kk];
        scr[kk * 65 + c4] = v[0]; scr[kk * 65 + c4 + 1] = v[1]; scr[kk * 65 + c4 + 2] = v[2]; scr[kk * 65 + c4 + 3] = v[3]; }
    LDS_WAIT(); asm volatile("" ::: "memory");
    const int c = lane & 7;
    bf16_t* tbase = dst + ((size_t)((n0 >> 8) * (Ktot >> 6) + (kd0 >> 6)) * 2 + ((n0 >> 7) & 1)) * 8192;
    float tv[8][8];
#pragma unroll
    for (int j = 0; j < 8; ++j) { const LAS float* s = scr + (8 * c) * 65 + (lane >> 3) + 8 * j;
#pragma unroll
        for (int q = 0; q < 8; ++q) tv[j][q] = s[q * 65]; }
    __builtin_amdgcn_sched_barrier(0);
#pragma unroll
    for (int j = 0; j < 8; ++j) { const int n = (lane >> 3) + 8 * j;
        u32x4 o; o.x = cvt_pk_bf16(tv[j][0], tv[j][1]); o.y = cvt_pk_bf16(tv[j][2], tv[j][3]); o.z = cvt_pk_bf16(tv[j][4], tv[j][5]); o.w = cvt_pk_bf16(tv[j][6], tv[j][7]);
        const int nh = (n0 & 64) + n, v32 = nh & 31, rho = (nh & ~31) + (((v32 >> 2) & 1) << 4) + ((v32 >> 3) << 2) + (v32 & 3);
        *(u32x4*)(tbase + (pg8::lds_byte(rho, 8 * c) >> 1)) = o; }
    LDS_WAIT(); asm volatile("" ::: "memory");
}
__device__ __forceinline__ void tr_plain(int item, const float* src, int K, int N, const float* kscale, bf16_t* dst, int ld_dst, int dk0, LAS float* scr, int lane) {
    const int nnb = N / 64, kb = item / nnb, nb = item - kb * nnb;
    tr_tile(src, N, nb * 64, 64, kb * 64, kscale, dst, ld_dst, nb * 64, dk0 + kb * 64, scr, lane);
}
__device__ __forceinline__ void tr_gu(int item, const float* wg, const float* wu, bf16_t* dst, LAS float* scr, int lane) {
    const int kb = item / 112, nb = item - kb * 112;
    const int tile = nb >> 2, sub = nb & 3;
    const float* src = (sub < 2) ? wg : wu; const int col = tile * 128 + (sub & 1) * 64;
    tr_tile(src, DFF, col, 64, kb * 64, nullptr, dst, 1024, nb * 64, kb * 64, scr, lane);
}
__device__ __forceinline__ void tr_win(int item, const float* w, bf16_t* dst, LAS float* scr, int lane) {
    const int kb = item / 96, nb = item - kb * 96;
    int col, nv = 64; const int row = nb * 64;
    if (nb < 16) { const int tile = nb >> 2, sub = nb & 3; col = (sub < 2 ? 0 : 512) + tile * 128 + (sub & 1) * 64; }
    else if (nb < 32) col = 1024 + (row - 1024);
    else if (nb < 48) col = 2080 + (row - 2048);
    else col = 3104 + (row - 3072);
    tr_tile(w, IN_COLS, col, nv, kb * 64, nullptr, dst, 1024, row, kb * 64, scr, lane);
}
__device__ __forceinline__ void rec_frag_item(int item, const float* wra, const float* wri, bf16_t* dst, int lane) {
    const int s = item & 3, cb = (item >> 2) & 1, g = (item >> 3) & 7, gate = (item >> 6) & 1, d = (item >> 7) & 1;
    const float* w = (gate ? wri : wra) + ((size_t)(d * 8 + g)) * 4096;
    const int r = lane & 31, h = lane >> 5;
    float v[8];
#pragma unroll
    for (int jj = 0; jj < 8; ++jj) v[jj] = w[(16 * s + 8 * h + jj) * 64 + 32 * cb + r];
    u32x4 o; o.x = cvt_pk_bf16(v[0], v[1]); o.y = cvt_pk_bf16(v[2], v[3]); o.z = cvt_pk_bf16(v[4], v[5]); o.w = cvt_pk_bf16(v[6], v[7]);
    *(u32x4*)(dst + ((size_t)item * 64 + lane) * 8) = o;
}

__device__ __forceinline__ void krope_frag_item(int s, const float* w, bf16_t* dst, int lane) {
    const int r = lane & 31, h = lane >> 5;
    float v[8];
#pragma unroll
    for (int jj = 0; jj < 8; ++jj) v[jj] = w[(size_t)(16 * s + 8 * h + jj) * IN_COLS + 2048 + r];
    u32x4 o; o.x = cvt_pk_bf16(v[0], v[1]); o.y = cvt_pk_bf16(v[2], v[3]); o.z = cvt_pk_bf16(v[4], v[5]); o.w = cvt_pk_bf16(v[6], v[7]);
    *(u32x4*)(dst + ((size_t)s * 64 + lane) * 8) = o;
}
constexpr int CC_PER_LAYER = 96 * 16 + 3 * 16 * 8 + 12 * 16 + 16 * 4 + 16 * 16 + 256 + 64, CC_PER_FF = 112 * 16 + 16 * 56, CC_NITEMS = DEPTH * CC_PER_LAYER + 2 * CC_PER_FF;
__device__ __forceinline__ void convert_common(const Args& a, const Frame& F, int it_lo, int it_hi, int wg_i, int n_wg) {
    if (wg_i < 0) return;
    LAS float* scr = (LAS float*)(F.lds + F.wave * 16640);
    const int gw = wg_i * NWAVES + F.wave, NGW = n_wg * NWAVES;
    constexpr int I_WIN_N = 96 * 16, I_CAT = 16 * 8, I_QB = 12 * 16, I_KVB = 16 * 4, I_OUT = 16 * 16, I_REC = 256, I_KR = 64;
    constexpr int PER_LAYER = I_WIN_N + 3 * I_CAT + I_QB + I_KVB + I_OUT + I_REC + I_KR;
    constexpr int I_GU = 112 * 16, I_D = 16 * 56, PER_FF = I_GU + I_D;
    static_assert(PER_LAYER == CC_PER_LAYER && PER_FF == CC_PER_FF, "conversion item counts");
    for (int it = it_lo + gw; it < it_hi; it += NGW) {
        if (it < DEPTH * PER_LAYER) {
            const int l = it / PER_LAYER; int r = it - l * PER_LAYER;
            if (r < I_WIN_N) { tr_win(r, a.in[I_WIN] + (size_t)l * DM * IN_COLS, (bf16_t*)(a.ws + WS_WIN) + (size_t)l * NWIN * DM, scr, F.lane); continue; } r -= I_WIN_N;
            if (r < 3 * I_CAT) { const int which = r / I_CAT; r -= which * I_CAT;
                const float* src = a.in[which == 0 ? I_WOCONV : (which == 1 ? I_WOMLA : I_WOREC)] + (size_t)l * 512 * 1024;
                tr_plain(r, src, 512, 1024, nullptr, (bf16_t*)(a.ws + WS_WCAT) + (size_t)l * 1024 * 1536, 1536, which * 512, scr, F.lane); continue; } r -= 3 * I_CAT;
            if (r < I_QB) { const int kb = r >> 4, nb = r & 15, hh = nb >> 1, sub = nb & 1;
                tr_tile(a.in[I_WQB] + (size_t)l * 768 * 768, 768, 96 * hh + 64 * sub, sub ? 32 : 64, kb * 64, a.in[I_GQA] + l * 768, (bf16_t*)(a.ws + WS_WQB) + (size_t)l * 1024 * 768, 768, nb * 64, kb * 64, scr, F.lane); continue; } r -= I_QB;
            if (r < I_KVB) { tr_plain(r, a.in[I_WKVB] + (size_t)l * 256 * 1024, 256, 1024, a.in[I_GKVA] + l * 256, (bf16_t*)(a.ws + WS_WKVB) + (size_t)l * 1024 * 256, 256, 0, scr, F.lane); continue; } r -= I_KVB;
            if (r < I_OUT) { tr_plain(r, a.in[I_WOUT] + (size_t)l * 1024 * 1024, 1024, 1024, nullptr, (bf16_t*)(a.ws + WS_WOUT) + (size_t)l * 1024 * 1024, 1024, 0, scr, F.lane); continue; } r -= I_OUT;
            if (r < I_REC) { rec_frag_item(r, a.in[I_WRA] + (size_t)l * 2 * 8 * 4096, a.in[I_WRI] + (size_t)l * 2 * 8 * 4096, (bf16_t*)(a.ws + WS_WREC) + (size_t)l * 256 * 512, F.lane); continue; } r -= I_REC;
            krope_frag_item(r, a.in[I_WIN] + (size_t)l * DM * IN_COLS, (bf16_t*)(a.ws + WS_WKR) + (size_t)l * 64 * 512, F.lane);
        } else {
            int r = it - DEPTH * PER_LAYER; const int j = r / PER_FF; r -= j * PER_FF;
            if (r < I_GU) tr_gu(r, a.in[I_WFG] + (size_t)j * DM * DFF, a.in[I_WFU] + (size_t)j * DM * DFF, (bf16_t*)(a.ws + WS_WFFGU) + (size_t)j * 7168 * 1024, scr, F.lane);
            else tr_plain(r - I_GU, a.in[I_WFD] + (size_t)j * DFF * DM, DFF, DM, nullptr, (bf16_t*)(a.ws + WS_WFFD) + (size_t)j * 1024 * DFF, DFF, 0, scr, F.lane);
        }
    }
}
constexpr int MOE_CVT_ITEMS = NEXP * (112 * 16 + 16 * 56), CVT_SPLIT1 = 6200, CVT_SPLIT2 = 10700;
__device__ __forceinline__ void convert_moe(const Args& a, const Frame& F, int j, int it_lo, int it_hi, int wg_i, int n_wg) {
    if (wg_i < 0) return;
    LAS float* scr = (LAS float*)(F.lds + F.wave * 16640);
    const int gw = wg_i * NWAVES + F.wave, NGW = n_wg * NWAVES;
    constexpr int I_GU = 112 * 16, I_D = 16 * 56, PER_E = I_GU + I_D;
    for (int it = it_lo + gw; it < it_hi; it += NGW) {
        const int e = it / PER_E; const int r = it - e * PER_E;
        const size_t eo = ((size_t)j * NEXP + e) * DM * DFF;
        if (r < I_GU) tr_gu(r, a.in[I_WEG] + eo, a.in[I_WEU] + eo, (bf16_t*)(a.ws + WS_WEGU) + (size_t)e * 7168 * 1024, scr, F.lane);
        else tr_plain(r - I_GU, a.in[I_WED] + eo, DFF, DM, nullptr, (bf16_t*)(a.ws + WS_WED) + (size_t)e * 1024 * DFF, DFF, 0, scr, F.lane);
    }
}
__device__ __forceinline__ void mod_job(const Args& a, const Frame& F) {
    LAS float* sc = (LAS float*)F.lds;
    LAS float* red = (LAS float*)(F.lds + 17 * 1024 * 4);
    for (int i = F.tid; i < NMOD * 1024; i += NTHREADS) { const int v = i >> 10, k = i & 1023; const float x = (v < 16) ? a.in[I_C][v * 1024 + k] : a.in[I_CCTX][k]; sc[i] = siluf_(x); }
    __syncthreads();
    float* MOD = (float*)(a.ws + WS_MOD);
    const int cl = F.lane & 31, kh = F.lane >> 5;
    for (int item = F.bid; item < DEPTH * 192; item += F.G) {
        const int l = item / 192, nb = item - l * 192;
        const float* w = a.in[I_WADA] + (size_t)l * 1024 * 6144 + nb * 32 + cl;
        float acc[NMOD];
#pragma unroll
        for (int v = 0; v < NMOD; ++v) acc[v] = 0.f;
        const int k0 = F.wave * 128 + kh * 64;
#pragma unroll 1
        for (int kk = 0; kk < 64; kk += 16) {
            float wv[16];
#pragma unroll
            for (int j = 0; j < 16; ++j) wv[j] = w[(size_t)(k0 + kk + j) * 6144];
#pragma unroll
            for (int j = 0; j < 16; ++j)
#pragma unroll
                for (int v = 0; v < NMOD; ++v) acc[v] += sc[v * 1024 + k0 + kk + j] * wv[j];
        }
#pragma unroll
        for (int v = 0; v < NMOD; ++v) acc[v] = sum_x32(acc[v]);
        if (kh == 0) {
#pragma unroll
            for (int v = 0; v < NMOD; ++v) red[(F.wave * NMOD + v) * 32 + cl] = acc[v]; }
        __syncthreads();
        for (int o = F.tid; o < NMOD * 32; o += NTHREADS) { const int v = o >> 5, c = o & 31; float s = a.in[I_BADA][l * 6144 + nb * 32 + c];
#pragma unroll
            for (int wv = 0; wv < 8; ++wv) s += red[(wv * NMOD + v) * 32 + c];
            MOD[((size_t)l * NMOD + v) * 6144 + nb * 32 + c] = s; }
        __syncthreads();
    }
}

struct NormP {
    const float* xin; const float* cin;
    bf16_t* X; bool from_f32; float* outf;
    const float* gain;
    const float* mod; int shsel;
    bf16_t* H;
    int* inv;
    bool combine; const bf16_t* Y; const i32x2* routeP; const f32x2* routeW; const float* modprev;
    bool do_norm; bool latent_only;
    const float* wrouter; i32x4* routeA; f32x2* routeWout; unsigned* cnt;
};
template <bool ROUTER>
__device__ __forceinline__ void norm_job(const NormP& P, const Frame& F) {
    const int nact = P.latent_only ? NB * SEQ : T;
    const int rpw = nact / F.G;
    LAS int* hist = (LAS int*)(F.lds);
    LAS int* wbase = (LAS int*)(F.lds + 256);
    LAS int* stg = (LAS int*)(F.lds + 512);
    LAS f32x4* lw = (LAS f32x4*)(F.lds + 8192);
    if (ROUTER) { if (F.tid < 64) hist[F.tid] = 0;
#pragma unroll
        for (int k = 0; k < 4; ++k) { const int f4 = F.tid + NTHREADS * k, c = f4 >> 1, h = f4 & 1, j = c >> 8, i = c & 3, ln = (c & 255) >> 2;
            lw[((j * 4 + i) * 2 + h) * 64 + ln] = *(const f32x4*)(P.wrouter + (size_t)f4 * 4); }
        __syncthreads(); }
    const int a_lo = F.bid * rpw, a_hi = (F.bid == F.G - 1) ? nact : a_lo + rpw;
    int cur_mi = -1; f32x4 gs[4], s0v[4];
#pragma unroll
    for (int j = 0; j < 4; ++j) { gs[j] = (f32x4){0.f, 0.f, 0.f, 0.f}; s0v[j] = gs[j]; }
    i32x2 npp = (i32x2){0, 0}; f32x2 nww = (f32x2){0.f, 0.f};
    if (P.combine && a_lo + F.wave < a_hi) { const int ai0 = a_lo + F.wave, row0 = P.latent_only ? (ai0 / SEQ) * LROW + CTXL + (ai0 % SEQ) : ai0; npp = P.routeP[row0]; nww = P.routeW[row0]; }
    for (int ai = a_lo + F.wave; ai < a_hi; ai += NWAVES) {
        const int row = P.latent_only ? (ai / SEQ) * LROW + CTXL + (ai % SEQ) : ai;
        const int b = row / LROW, t = row - b * LROW;
        const bool isctx = t < CTXL; const int mi = isctx ? 16 : b;
        const size_t roff = isctx ? ((size_t)b * CTXL + t) * DM : ((size_t)b * SEQ + (t - CTXL)) * DM;
        bf16_t* xrow = P.X + (size_t)row * DM;
        f32x4 v[4];
        if (P.from_f32) {
            const float* xr = (isctx ? P.cin : P.xin) + roff;
#pragma unroll
            for (int j = 0; j < 4; ++j) { v[j] = *(const f32x4*)(xr + 4 * F.lane + 256 * j);
                u32x2 o; o.x = cvt_pk_bf16(v[j][0], v[j][1]); o.y = cvt_pk_bf16(v[j][2], v[j][3]); *(u32x2*)(xrow + 4 * F.lane + 256 * j) = o; }
        } else {
#pragma unroll
            for (int j = 0; j < 4; ++j) { const u32x2 w = *(const u32x2*)(xrow + 4 * F.lane + 256 * j); v[j] = (f32x4){bflo(w.x), bfhi(w.x), bflo(w.y), bfhi(w.y)}; }
        }
        if (P.combine) {
            const i32x2 pp = npp; const f32x2 ww = nww;
            if (ai + NWAVES < a_hi) { const int ai1 = ai + NWAVES, row1 = P.latent_only ? (ai1 / SEQ) * LROW + CTXL + (ai1 % SEQ) : ai1; npp = P.routeP[row1]; nww = P.routeW[row1]; }
            const float* ga = P.modprev + (size_t)mi * 6144 + 5 * 1024;
#pragma unroll
            for (int j = 0; j < 4; ++j) {
                const u32x2 y0 = *(const u32x2*)(P.Y + (size_t)pp.x * DM + 4 * F.lane + 256 * j), y1 = *(const u32x2*)(P.Y + (size_t)pp.y * DM + 4 * F.lane + 256 * j);
                const f32x4 g = *(const f32x4*)(ga + 4 * F.lane + 256 * j);
                f32x4 f; f[0] = ww.x * bflo(y0.x) + ww.y * bflo(y1.x); f[1] = ww.x * bfhi(y0.x) + ww.y * bfhi(y1.x); f[2] = ww.x * bflo(y0.y) + ww.y * bflo(y1.y); f[3] = ww.x * bfhi(y0.y) + ww.y * bfhi(y1.y);
                v[j] = v[j] + g * f;
                if (P.outf) *(f32x4*)(P.outf + roff + 4 * F.lane + 256 * j) = v[j];
                else { u32x2 o; o.x = cvt_pk_bf16(v[j][0], v[j][1]); o.y = cvt_pk_bf16(v[j][2], v[j][3]); *(u32x2*)(xrow + 4 * F.lane + 256 * j) = o; } }
        }
        if (!P.do_norm) continue;
        float ss = 0.f;
#pragma unroll
        for (int j = 0; j < 4; ++j) ss += (v[j][0] * v[j][0] + v[j][1] * v[j][1]) + (v[j][2] * v[j][2] + v[j][3] * v[j][3]);
        const float rstd = 1.0f / sqrtf(wave_sum(ss) * (1.0f / DM) + NORM_EPS);
        if (mi != cur_mi) {
            cur_mi = mi; const float* sh = P.mod + (size_t)mi * 6144 + P.shsel * 1024; const float* sc = sh + 1024;
#pragma unroll
            for (int j = 0; j < 4; ++j) { const int c = 4 * F.lane + 256 * j; gs[j] = *(const f32x4*)(P.gain + c) * (*(const f32x4*)(sc + c) + 1.0f); s0v[j] = *(const f32x4*)(sh + c); } }
#pragma unroll
        for (int j = 0; j < 4; ++j) { const int c = 4 * F.lane + 256 * j;
            v[j] = (v[j] * rstd) * gs[j] + s0v[j];
            u32x2 o; o.x = cvt_pk_bf16(v[j][0], v[j][1]); o.y = cvt_pk_bf16(v[j][2], v[j][3]);
            *(u32x2*)(P.H + (size_t)row * DM + c) = o; }
        if (ROUTER) {
            float lg[8];
#pragma unroll
            for (int e = 0; e < 8; ++e) lg[e] = 0.f;
#pragma unroll
            for (int j = 0; j < 4; ++j)
#pragma unroll
                for (int i = 0; i < 4; ++i) { const f32x4 w0 = lw[((j * 4 + i) * 2 + 0) * 64 + F.lane], w1 = lw[((j * 4 + i) * 2 + 1) * 64 + F.lane];
                    lg[0] += v[j][i] * w0[0]; lg[1] += v[j][i] * w0[1]; lg[2] += v[j][i] * w0[2]; lg[3] += v[j][i] * w0[3];
                    lg[4] += v[j][i] * w1[0]; lg[5] += v[j][i] * w1[1]; lg[6] += v[j][i] * w1[2]; lg[7] += v[j][i] * w1[3]; }
#pragma unroll
            for (int e = 0; e < 8; ++e) lg[e] = wave_sum(lg[e]);
            int e0 = 0; float v0 = lg[0];
#pragma unroll
            for (int e = 1; e < 8; ++e) if (lg[e] > v0) { v0 = lg[e]; e0 = e; }
            int e1 = -1; float v1 = -3.0e38f;
#pragma unroll
            for (int e = 0; e < 8; ++e) if (e != e0 && lg[e] > v1) { v1 = lg[e]; e1 = e; }
            const float w0 = 1.0f / (1.0f + __expf(v1 - v0)), w1 = 1.0f - w0;
            if (F.lane == 0) { const int p0 = hist[F.wave * 8 + e0]; hist[F.wave * 8 + e0] = p0 + 1; const int p1 = hist[F.wave * 8 + e1]; hist[F.wave * 8 + e1] = p1 + 1;
                LAS int* s = stg + (ai - a_lo) * 6; s[0] = e0; s[1] = p0; s[2] = e1; s[3] = p1; s[4] = __float_as_int(w0); s[5] = __float_as_int(w1); }
        }
    }
    if (ROUTER) {
        __syncthreads();
        if (F.tid < 8) { int tot = 0;
#pragma unroll
            for (int w = 0; w < 8; ++w) tot += hist[w * 8 + F.tid];
            int base = (int)__hip_atomic_fetch_add(P.cnt + F.tid * 64, (unsigned)tot, __ATOMIC_RELAXED, __HIP_MEMORY_SCOPE_AGENT);
#pragma unroll
            for (int w = 0; w < 8; ++w) { wbase[w * 8 + F.tid] = base; base += hist[w * 8 + F.tid]; } }
        __syncthreads();
        for (int i = F.tid; i < a_hi - a_lo; i += NTHREADS) {
            const int ai = a_lo + i, w = i & 7;
            const int row = P.latent_only ? (ai / SEQ) * LROW + CTXL + (ai % SEQ) : ai;
            const LAS int* s = stg + i * 6;
            const int p0_ = wbase[w * 8 + s[0]] + s[1], p1_ = wbase[w * 8 + s[2]] + s[3];
            P.routeA[row] = (i32x4){s[0], p0_, s[2], p1_}; P.inv[s[0] * T + p0_] = row; P.inv[s[2] * T + p1_] = row;
            P.routeWout[row] = (f32x2){__int_as_float(s[4]), __int_as_float(s[5])};
        }
        __syncthreads();
    }
}
__device__ __forceinline__ void moe_offsets(const unsigned* cnt, int* off  ) {
    int o = 0;
#pragma unroll
    for (int e = 0; e < 8; ++e) { off[e] = o; const int c = (int)__hip_atomic_load(cnt + e * 64, __ATOMIC_RELAXED, __HIP_MEMORY_SCOPE_AGENT); o += (c + 255) & ~255; }
    off[8] = o;
}

struct ConvP { const bf16_t* U; bf16_t* CAT; const float* cw; const float* cb; const float* lng; const float* lnb; bool latent_only; };
constexpr int CV_ROWS = 62, CV_BUF = CV_ROWS * 1024, CV_PART = 2 * CV_BUF, CV_STATS = CV_PART + 8 * 64 * 4;
static_assert(CV_STATS + 32 * 8 <= LDSCTL_OFF, "conv LDS");
__device__ __forceinline__ void conv_stage(const ConvP& P, const Frame& F, int item, int buf) {
    int b, cc;
    if (P.latent_only) { b = item >> 6; cc = 8 + (item & 63); } else { b = item / 72; cc = item - b * 72; }
    const int rb = b * LROW + cc * 32, seq_lo = b * LROW + (cc < 8 ? 0 : CTXL), seq_hi = b * LROW + (cc < 8 ? CTXL : LROW);
    for (int j = F.wave; j < CV_ROWS; j += NWAVES) {
        const int row = rb - 15 + j;
        LAS unsigned char* dst = F.lds + buf * CV_BUF + j * 1024;
        if (row >= seq_lo && row < seq_hi) __builtin_amdgcn_global_load_lds((const unsigned*)(P.U + (size_t)row * 512 + F.lane * 8), (LAS unsigned*)dst, 16, 0, 0);
        else *(LAS u32x4*)(dst + F.lane * 16) = (u32x4){0u, 0u, 0u, 0u};
    }
}
__device__ __forceinline__ void conv_job(const ConvP& P, const Frame& F) {
    LAS float* part = (LAS float*)(F.lds + CV_PART);
    LAS f32x2* stats = (LAS f32x2*)(F.lds + CV_STATS);
    const int ch = F.tid;
    float w[31];
#pragma unroll
    for (int k = 0; k < 31; ++k) w[k] = P.cw[k * 512 + ch];
    const float bias = P.cb[ch], lg = P.lng[ch], lb = P.lnb[ch];
    const int nitems = P.latent_only ? NB * 64 : NB * 72;
    int item = F.bid, buf = 0;
    if (item < nitems) conv_stage(P, F, item, 0);
    for (; item < nitems; item += F.G, buf ^= 1) {
        asm volatile("s_waitcnt vmcnt(0)" ::: "memory");
        __syncthreads();
        if (item + F.G < nitems) conv_stage(P, F, item + F.G, buf ^ 1);
        int b, cc;
        if (P.latent_only) { b = item >> 6; cc = 8 + (item & 63); } else { b = item / 72; cc = item - b * 72; }
        const int rb = b * LROW + cc * 32;
        const LAS bf16_t* xin = (const LAS bf16_t*)(F.lds + buf * CV_BUF) + ch;
        float a0[32];
#pragma unroll
        for (int o = 0; o < 32; ++o) a0[o] = bias;
#pragma unroll
        for (int jb = 0; jb < 62; jb += 16) {
            float xv[16];
#pragma unroll
            for (int jj = 0; jj < 16; ++jj) if (jb + jj < 62) xv[jj] = bf2f(xin[(jb + jj) * 512]);
            __builtin_amdgcn_sched_barrier(0);
#pragma unroll
            for (int jj = 0; jj < 16; ++jj) { const int j = jb + jj;
                if (j < 62) {
#pragma unroll
                    for (int o = (j > 30 ? j - 30 : 0); o <= (j < 31 ? j : 31); ++o) a0[o] += w[j - o] * xv[jj]; } }
            __builtin_amdgcn_sched_barrier(0);
        }
        float v[64];
#pragma unroll
        for (int o = 0; o < 32; ++o) { v[2 * o] = a0[o]; v[2 * o + 1] = a0[o] * a0[o]; }
#pragma unroll
        for (int s_ = 32; s_ >= 1; s_ >>= 1) {
            const bool up = (F.lane & s_) != 0;
#pragma unroll
            for (int ib = 0; ib < s_; ib += 16) {
                float sh[16];
#pragma unroll
                for (int ii = 0; ii < 16; ++ii) if (ib + ii < s_) sh[ii] = __shfl_xor(up ? v[ib + ii] : v[ib + ii + s_], s_);
                __builtin_amdgcn_sched_barrier(0);
#pragma unroll
                for (int ii = 0; ii < 16; ++ii) if (ib + ii < s_) v[ib + ii] = (up ? v[ib + ii + s_] : v[ib + ii]) + sh[ii];
                __builtin_amdgcn_sched_barrier(0);
            }
        }
        part[F.wave * 64 + F.lane] = v[0];
        __syncthreads();
        if (F.tid < 64) { const int L = F.tid;
            float tot = 0.f;
#pragma unroll
            for (int wv = 0; wv < 8; ++wv) tot += part[wv * 64 + L];
            const float oth = __shfl_xor(tot, 1);
            if ((L & 1) == 0) { const float mean = tot * (1.0f / 512.0f), var = oth * (1.0f / 512.0f) - mean * mean; stats[L >> 1] = (f32x2){mean, 1.0f / sqrtf(var + NORM_EPS)}; } }
        __syncthreads();
#pragma unroll
        for (int ob = 0; ob < 32; ob += 16) {
            f32x2 stv[16];
#pragma unroll
            for (int oo = 0; oo < 16; ++oo) stv[oo] = stats[ob + oo];
            __builtin_amdgcn_sched_barrier(0);
#pragma unroll
            for (int oo = 0; oo < 16; ++oo) { const int o = ob + oo; const f32x2 st = stv[oo];
                const float y0 = (a0[o] - st.x) * st.y * lg + lb;
                P.CAT[(size_t)(rb + o) * 1536 + ch] = (bf16_t)(cvt_pk_bf16(siluf_(y0), 0.f) & 0xffffu); }
            __builtin_amdgcn_sched_barrier(0);
        }
    }
    __syncthreads();
}

constexpr int NCH = 72, XT_PITCH = 68, XT_BYTES = 32 * XT_PITCH * 4, SC_STAGE = 40 * 128;
static_assert(32768 + 8 * (XT_BYTES + SC_STAGE) <= LDSCTL_OFF, "scan LDS");
__device__ __forceinline__ int crow(int r, int hi) { return (r & 3) + 8 * (r >> 2) + 4 * hi; }
struct ScanP { const bf16_t* ZR; bf16_t* CAT; const float* rcw; const float* rcb; const bf16_t* wfrag; const float* bra; const float* bri; const float* lam; float* SUM; const float* CAR; };
template <bool FINAL>
__device__ __forceinline__ void scan_job(const ScanP& P, const Frame& F) {
    const int ngw = (F.G >= 8) ? F.G / 8 : 1, g = (F.G >= 8) ? (F.bid & 7) : 0, wgi = (F.G >= 8) ? (F.bid >> 3) : F.bid;
    LAS bf16_t* wl = (LAS bf16_t*)F.lds;
    LAS float* XT = (LAS float*)(F.lds + 32768 + F.wave * (XT_BYTES + SC_STAGE));
    LAS bf16_t* STG = (LAS bf16_t*)(F.lds + 32768 + F.wave * (XT_BYTES + SC_STAGE) + XT_BYTES);
    const int lane = F.lane, r32 = lane & 31, hi = lane >> 5;
    for (int gg = g; gg < 8; gg += (F.G >= 8 ? 8 : 1)) {
    __syncthreads();
#pragma unroll
    for (int i = 0; i < 4; ++i) { const int e = (i * NTHREADS + F.tid) * 8, piece = e >> 12, within = e & 4095;
        *(LAS u32x4*)(wl + e) = *(const u32x4*)(P.wfrag + ((size_t)(piece * 8 + gg)) * 4096 + within); }
    const int ch = 64 * gg + lane;
    float cw[2][4], cbias[2], ba[2][2], bi[2][2], c1[2][2];
#pragma unroll
    for (int d = 0; d < 2; ++d) {
#pragma unroll
        for (int k = 0; k < 4; ++k) cw[d][k] = P.rcw[(d * 4 + k) * 512 + ch];
        cbias[d] = P.rcb[d * 512 + ch];
#pragma unroll
        for (int cb = 0; cb < 2; ++cb) { const int chj = 64 * gg + 32 * cb + r32;
            ba[d][cb] = -1.4426950408889634f * P.bra[d * 512 + chj]; bi[d][cb] = -1.4426950408889634f * P.bri[d * 512 + chj];
            const float sp = 0.6931471805599453f * __builtin_amdgcn_logf(1.0f + fast_exp2(-1.4426950408889634f * P.lam[d * 512 + chj]));
            c1[d][cb] = -8.0f * 1.4426950408889634f * sp; }
    }
    __syncthreads();
    const int istep = ngw * NWAVES, w_ = wgi * NWAVES + F.wave; const bool even_deal = (istep == 256);
    int item = w_, cbm = 3;
#define SCAN_STAGE(it) do { const int c_ = (it) % NCH, b_ = (it) / NCH; const int rb_ = b_ * LROW + c_ * 32, lo_ = b_ * LROW + (c_ < 8 ? 0 : CTXL), hi_ = b_ * LROW + (c_ < 8 ? CTXL : LROW); \
        _Pragma("unroll") for (int q_ = 0; q_ < 5; ++q_) { int row_ = rb_ - 3 + q_ * 8 + (lane >> 3); row_ = row_ < lo_ ? lo_ : (row_ >= hi_ ? hi_ - 1 : row_); \
            __builtin_amdgcn_global_load_lds((const unsigned*)(P.ZR + (size_t)row_ * 1024 + 64 * gg + (lane & 7) * 8), (LAS unsigned*)(STG + q_ * 512), 16, 0, 0); } } while (0)
    if (item < NB * NCH) SCAN_STAGE(item);
    for (; item < NB * NCH; ) {
        int nitem = item + istep, ncbm = 3;
        if (even_deal) { if (item >= 1024) nitem = NB * NCH; else if (nitem >= 1024) { nitem = 1024 + (w_ >> 1); ncbm = 1 << (w_ & 1); } }
        const int c = item % NCH, b = item / NCH;
        const int rb = b * LROW + c * 32;
        asm volatile("s_waitcnt vmcnt(0)" ::: "memory");
        { const int lo_ = b * LROW + (c < 8 ? 0 : CTXL), hi_ = b * LROW + (c < 8 ? CTXL : LROW);
          if (rb - 3 < lo_ || rb + 36 >= hi_) {
#pragma unroll
              for (int q_ = 0; q_ < 5; ++q_) { const int row_ = rb - 3 + q_ * 8 + (lane >> 3); if (row_ < lo_ || row_ >= hi_) *(LAS u32x4*)(STG + q_ * 512 + lane * 8) = (u32x4){0u, 0u, 0u, 0u}; }
          } }
        unsigned xwp[19];
#pragma unroll
        for (int j = 0; j < 19; ++j) xwp[j] = (unsigned)STG[(2 * j) * 64 + lane] | ((unsigned)STG[(2 * j + 1) * 64 + lane] << 16);
        asm volatile("s_waitcnt lgkmcnt(0)" ::: "memory");
        if (nitem < NB * NCH) SCAN_STAGE(nitem);
#define SCAN_X(j) (((j) & 1) ? bfhi(xwp[(j) >> 1]) : bflo(xwp[(j) >> 1]))
        float carv[2][2];
        if (FINAL) {
#pragma unroll
            for (int d = 0; d < 2; ++d)
#pragma unroll
                for (int cb = 0; cb < 2; ++cb) carv[d][cb] = P.CAR[(size_t)(((b * 8 + gg) * 2 + d) * NCH + c) * 64 + 32 * cb + r32];
        }
        float hsum[2][16];
#pragma unroll
        for (int cb = 0; cb < 2; ++cb)
#pragma unroll
            for (int r = 0; r < 16; ++r) hsum[cb][r] = 0.f;
#pragma unroll
        for (int d = 0; d < 2; ++d) {
#pragma unroll
            for (int t = 0; t < 32; ++t) { const int o = t + 3 * d; XT[t * XT_PITCH + lane] = fmaf(cw[d][3], SCAN_X(o + 3), fmaf(cw[d][2], SCAN_X(o + 2), fmaf(cw[d][1], SCAN_X(o + 1), fmaf(cw[d][0], SCAN_X(o), cbias[d])))); }
            bf16x8 af[4];
#pragma unroll
            for (int s = 0; s < 4; ++s) { const f32x4 x0 = *(const LAS f32x4*)(XT + r32 * XT_PITCH + 16 * s + 8 * hi), x1 = *(const LAS f32x4*)(XT + r32 * XT_PITCH + 16 * s + 8 * hi + 4);
                const u32x4 w = pg8::pack8(x0, x1); af[s] = __builtin_bit_cast(bf16x8, w); }
#pragma unroll
            for (int cb = 0; cb < 2; ++cb) { if (!(cbm & (1 << cb))) continue;
                f32x16 ra = {}, ri = {};
#pragma unroll
                for (int s = 0; s < 4; ++s) {
                    const bf16x8 wa = *(const LAS bf16x8*)(wl + (d * 2 + 0) * 4096 + (cb * 4 + s) * 512 + lane * 8);
                    const bf16x8 wi = *(const LAS bf16x8*)(wl + (d * 2 + 1) * 4096 + (cb * 4 + s) * 512 + lane * 8);
                    ra = __builtin_amdgcn_mfma_f32_32x32x16_bf16(af[s], wa, ra, 0, 0, 0);
                    ri = __builtin_amdgcn_mfma_f32_32x32x16_bf16(af[s], wi, ri, 0, 0, 0);
                }
                float av[16], bx[16];
#pragma unroll
                for (int r = 0; r < 16; ++r) {
                    const float xcv = XT[crow(r, hi) * XT_PITCH + 32 * cb + r32];
                    const float rg = fast_rcp(1.0f + fast_exp2(fmaf(ra[r], -1.4426950408889634f, ba[d][cb]))), ig = fast_rcp(1.0f + fast_exp2(fmaf(ri[r], -1.4426950408889634f, bi[d][cb])));
                    const float a_ = fast_exp2(c1[d][cb] * rg);
                    av[r] = a_; bx[r] = __builtin_amdgcn_sqrtf(fmaf(-a_, a_, 1.0f)) * (ig * xcv);
                }
                float Ag[4], Bg[4];
#pragma unroll
                for (int q = 0; q < 4; ++q) {
                    Ag[q] = (av[4 * q] * av[4 * q + 1]) * (av[4 * q + 2] * av[4 * q + 3]);
                    if (d == 0) Bg[q] = ((bx[4 * q] * av[4 * q + 1] + bx[4 * q + 1]) * av[4 * q + 2] + bx[4 * q + 2]) * av[4 * q + 3] + bx[4 * q + 3];
                    else        Bg[q] = ((bx[4 * q + 3] * av[4 * q + 2] + bx[4 * q + 2]) * av[4 * q + 1] + bx[4 * q + 1]) * av[4 * q] + bx[4 * q];
                }
                float A0[4], A1[4], B0[4], B1[4];
#pragma unroll
                for (int q = 0; q < 4; ++q) {
                    auto ra_ = __builtin_amdgcn_permlane32_swap(__float_as_uint(Ag[q]), __float_as_uint(Ag[q]), false, false); A0[q] = __uint_as_float(ra_[0]); A1[q] = __uint_as_float(ra_[1]);
                    auto rb_ = __builtin_amdgcn_permlane32_swap(__float_as_uint(Bg[q]), __float_as_uint(Bg[q]), false, false); B0[q] = __uint_as_float(rb_[0]); B1[q] = __uint_as_float(rb_[1]);
                }
                if (!FINAL) {
                    float Ac = 1.f, Bc = 0.f;
                    if (d == 0) {
#pragma unroll
                        for (int q = 0; q < 4; ++q) { Bc = A0[q] * Bc + B0[q]; Ac *= A0[q]; Bc = A1[q] * Bc + B1[q]; Ac *= A1[q]; }
                    } else {
#pragma unroll
                        for (int q = 3; q >= 0; --q) { Bc = A1[q] * Bc + B1[q]; Ac *= A1[q]; Bc = A0[q] * Bc + B0[q]; Ac *= A0[q]; }
                    }
                    if (hi == 0) { float* sp_ = P.SUM + ((size_t)(((b * 8 + gg) * 2 + d) * NCH + c) * 2) * 64 + 32 * cb + r32; sp_[0] = Ac; sp_[64] = Bc; }
                } else {
                    float s = carv[d][cb];
                    float sin_[4];
                    if (d == 0) {
#pragma unroll
                        for (int q = 0; q < 4; ++q) { const float s0 = s; s = A0[q] * s + B0[q]; const float s1 = s; s = A1[q] * s + B1[q]; sin_[q] = hi ? s1 : s0; }
#pragma unroll
                        for (int q = 0; q < 4; ++q) { float h = sin_[q];
#pragma unroll
                            for (int e = 0; e < 4; ++e) { h = av[4 * q + e] * h + bx[4 * q + e]; hsum[cb][4 * q + e] += h; } }
                    } else {
#pragma unroll
                        for (int q = 3; q >= 0; --q) { const float s1 = s; s = A1[q] * s + B1[q]; const float s0 = s; s = A0[q] * s + B0[q]; sin_[q] = hi ? s1 : s0; }
#pragma unroll
                        for (int q = 0; q < 4; ++q) { float h = sin_[q];
#pragma unroll
                            for (int e = 3; e >= 0; --e) { h = av[4 * q + e] * h + bx[4 * q + e]; hsum[cb][4 * q + e] += h; } }
                    }
                }
            }
        }
        if (FINAL) {
            u32x4 gatev[4];
            const bool mine = (cbm >> ((lane & 7) >> 2)) & 1;
#pragma unroll
            for (int p = 0; p < 4; ++p) { gatev[p] = (u32x4){0u, 0u, 0u, 0u}; if (mine) gatev[p] = *(const u32x4*)(P.ZR + (size_t)(rb + p * 8 + (lane >> 3)) * 1024 + 512 + 64 * gg + (lane & 7) * 8); }
#pragma unroll
            for (int cb = 0; cb < 2; ++cb) { if (!(cbm & (1 << cb))) continue;
#pragma unroll
                for (int r = 0; r < 16; ++r) XT[crow(r, hi) * XT_PITCH + 32 * cb + r32] = hsum[cb][r]; }
#pragma unroll
            for (int p = 0; p < 4; ++p) { const int tl = p * 8 + (lane >> 3), c8 = (lane & 7) * 8; const size_t row = (size_t)(rb + tl);
                const f32x4 y0 = *(const LAS f32x4*)(XT + tl * XT_PITCH + c8), y1 = *(const LAS f32x4*)(XT + tl * XT_PITCH + c8 + 4);
                f32x4 g0, g1; pg8::unpack8(gatev[p], g0, g1);
                if (mine) *(u32x4*)(P.CAT + row * 1536 + 1024 + 64 * gg + c8) = pg8::pack8(y0 * g0, y1 * g1); }
        }
        item = nitem; cbm = ncbm;
    }
#undef SCAN_STAGE
#undef SCAN_X
    }
}
__device__ __forceinline__ void carry_job(const float* __restrict__ SUM, float* __restrict__ CAR, const Frame& F) {
    const int gw = F.bid * NWAVES + F.wave, NGW = F.G * NWAVES;
    for (int item = gw; item < NB * 8 * 2; item += NGW) {
        const int d = item & 1;
        const float* __restrict__ sp = SUM + (size_t)item * NCH * 128 + F.lane; float* __restrict__ cp = CAR + (size_t)item * NCH * 64 + F.lane;
        float s = 0.f;
#pragma unroll 1
        for (int c0 = 0; c0 < NCH; c0 += 24) {
            float av[24], bv[24];
#pragma unroll
            for (int j = 0; j < 24; ++j) { const int k = c0 + j, c = (d == 0) ? k : (k < 8 ? 7 - k : NCH + 7 - k); av[j] = sp[c * 128]; bv[j] = sp[c * 128 + 64]; }
#pragma unroll
            for (int j = 0; j < 24; ++j) { const int k = c0 + j, c = (d == 0) ? k : (k < 8 ? 7 - k : NCH + 7 - k); cp[c * 64] = s; s = av[j] * s + bv[j]; }
        }
    }
}

__device__ __forceinline__ void krope_job(const bf16_t* __restrict__ H, const bf16_t* __restrict__ WF, bf16_t* __restrict__ KR, unsigned long long* __restrict__ stats, int first, int step, const Frame& F) {
    if (first < 0) return;
    const int lane = F.lane, r32 = lane & 31, hi = lane >> 5, lrow = lane >> 3, lpc = lane & 7;
    LAS unsigned char* xa = F.lds + F.wave * 16384;
    for (int item = first; item < T / 32; item += step) {
        const bf16_t* abase = H + (size_t)(item * 32 + lrow) * DM + lpc * 8;
        f32x16 acc = {};
#pragma unroll 1
        for (int kb = 0; kb < 4; ++kb) {
            u32x4 t[16]; bf16x8 bv[16];
#pragma unroll
            for (int j = 0; j < 16; ++j) t[j] = *(const u32x4*)(abase + (size_t)((j & 3) * 8) * DM + kb * 256 + (j >> 2) * 64);
#pragma unroll
            for (int j = 0; j < 16; ++j) bv[j] = *(const bf16x8*)(WF + ((size_t)(kb * 16 + j) * 64 + lane) * 8);
#pragma unroll
            for (int j = 0; j < 16; ++j) *(LAS u32x4*)(xa + (j >> 2) * 4096 + ((j & 3) * 8 + lrow) * 128 + ((lpc ^ lrow) * 16)) = t[j];
#pragma unroll
            for (int j = 0; j < 16; ++j) { const bf16x8 av = *(const LAS bf16x8*)(xa + (j >> 2) * 4096 + r32 * 128 + ((((j & 3) * 2 + hi) ^ (r32 & 7)) * 16));
                acc = __builtin_amdgcn_mfma_f32_32x32x16_bf16(av, bv[j], acc, 0, 0, 0); }
        }
#pragma unroll
        for (int r = 0; r < 16; ++r) { const int row = item * 32 + crow(r, hi);
            KR[(size_t)row * 32 + r32] = (bf16_t)(cvt_pk_bf16(acc[r], 0.f) & 0xffffu);
            float sq = sum_x16(row16_sum(acc[r] * acc[r]));
            if (r32 == 0) stats[(size_t)row * 4 + 2] = (unsigned long long)(sq * 1048576.0f); }
    }
}

constexpr int attn_NTB = LROW / 64;
__device__ __forceinline__ void rope_table_job(f32x2* tab, const Frame& F) {
    if (F.bid == 0) { const int p = F.tid >> 3, i = F.tid & 7; const float f = powf(10000.0f, -(float)i * 0.125f); float s_, c_; sincosf((float)p * f, &s_, &c_); tab[F.tid] = (f32x2){c_, s_}; }
}

namespace attn {
constexpr int KSLOT = 12288, VSLOT = 8192, NSLOT = 3, KTILE = 6144, VTILE = 4096, NTB = LROW / 64;
constexpr int L_K = 0, L_V = NSLOT * KSLOT, L_WS = L_V + NSLOT * VSLOT, L_OST = L_WS + 2048, L_END = L_OST + 8 * 4096;
static_assert(L_END <= RING_BYTES, "attention LDS");
struct AttnP { const bf16_t* Q; const bf16_t* Kt; const bf16_t* Vt; bf16_t* CAT; float mfix; };
#define AT_WAIT_V(n) asm volatile("s_waitcnt vmcnt(" #n ")" ::: "memory")
#define AT_SB() __builtin_amdgcn_sched_barrier(0)
__device__ __forceinline__ void unit(const AttnP& P, LAS unsigned char* lds, int bh, int qrow0, int NT, const int tid) {
    const int lane = tid & 63, r32 = lane & 31, hi = lane >> 5; const int wid = __builtin_amdgcn_readfirstlane(tid >> 6);
    const int h = bh & 7;
    const bf16_t* Qw = P.Q + (size_t)(qrow0 + wid * 32) * 768 + 96 * h;
    bf16x8 qr[6];
#pragma unroll
    for (int d0 = 0; d0 < 6; ++d0) qr[d0] = *(const bf16x8*)(Qw + (size_t)r32 * 768 + 16 * d0 + 8 * hi);
    const bf16_t* ksrcA = P.Kt + (size_t)bh * NTB * KTILE + wid * 512 + lane * 8;
    const bf16_t* ksrcB = P.Kt + (size_t)bh * NTB * KTILE + (8 + (wid & 3)) * 512 + lane * 8;
    const bf16_t* vsrc = P.Vt + (size_t)bh * NTB * VTILE + wid * 512 + lane * 8;
#define AT_DMA_K(t, slot) do { \
        __builtin_amdgcn_global_load_lds((const unsigned*)(ksrcA + (size_t)(t) * KTILE), (LAS unsigned*)(lds + L_K + (slot) * KSLOT + wid * 1024), 16, 0, 0); \
        __builtin_amdgcn_global_load_lds((const unsigned*)(ksrcB + (size_t)(t) * KTILE), (LAS unsigned*)(lds + L_K + (slot) * KSLOT + (8 + (wid & 3)) * 1024), 16, 0, 0); } while (0)
#define AT_DMA_V(t, slot) __builtin_amdgcn_global_load_lds((const unsigned*)(vsrc + (size_t)(t) * VTILE), (LAS unsigned*)(lds + L_V + (slot) * VSLOT + wid * 1024), 16, 0, 0)
    AT_DMA_K(0, 0); AT_DMA_K(1, 1); AT_DMA_V(0, 0);
    LAS float* wsf = (LAS float*)(lds + L_WS) + wid * 64;
    const unsigned vb0 = (unsigned)(uintptr_t)(lds + L_V) + ((lane >> 4) & 1) * 32 + (lane & 3) * 8 + (4 * hi + ((lane & 15) >> 2)) * 64;
    const LAS unsigned char* kb0 = lds + L_K + hi * 1024 + r32 * 16;
    f32x16 o[2]; o[0] = f32x16{}; o[1] = f32x16{};
    f32x16 negm;
#pragma unroll
    for (int r = 0; r < 16; ++r) negm[r] = -P.mfix;
    float lsum = 0.f;
    f32x16 pA0, pA1, pB0, pB1;
#define AT_KF(kb, i) (*(const LAS bf16x8*)((kb) + ((i) >> 1) * 2048 + ((i) & 1) * 512))
#define AT_PV(ks) __builtin_bit_cast(bf16x8, ((u32x4){pw[4 * (ks)], pw[4 * (ks) + 1], pw[4 * (ks) + 2], pw[4 * (ks) + 3]}))
    AT_WAIT_V(3); __builtin_amdgcn_s_barrier(); asm volatile("" ::: "memory");
    if (2 < NT) AT_DMA_K(2, 2);
    AT_DMA_V(1, 1);
    {
        const LAS unsigned char* kb = kb0;
        pA0 = negm; pA1 = negm;
#pragma unroll
        for (int i = 0; i < 12; ++i) { const bf16x8 kf = AT_KF(kb, i);
            if (i & 1) pA1 = __builtin_amdgcn_mfma_f32_32x32x16_bf16(kf, qr[i >> 1], pA1, 0, 0, 0); else pA0 = __builtin_amdgcn_mfma_f32_32x32x16_bf16(kf, qr[i >> 1], pA0, 0, 0, 0); }
#pragma unroll
        for (int r = 0; r < 16; ++r) { pA0[r] = fast_exp2(pA0[r]); pA1[r] = fast_exp2(pA1[r]); }
    }
#define AT_STEP(S0, S1, P0, P1, ksl, vsl) do { \
        const LAS unsigned char* kb = kb0 + (ksl) * KSLOT; const unsigned vb = vb0 + (vsl) * VSLOT; \
        s16x4 vlo[8], vhh[8]; unsigned pw[16]; float sacc = 0.f; \
        bf16x8 kfa = AT_KF(kb, 0), kfb = AT_KF(kb, 1), kfc = AT_KF(kb, 2), kfd = AT_KF(kb, 3); \
        AT_SB(); \
        _Pragma("unroll") for (int i = 0; i < 12; ++i) { \
            bf16x8 kfe = kfa; if (i + 4 < 12) kfe = AT_KF(kb, (i + 4 < 12 ? i + 4 : 0)); \
            if (i < 8) { asm volatile("ds_read_b64_tr_b16 %0,%1 offset:%c2" : "=&v"(vlo[i]) : "v"(vb), "i"(((i) >> 2) * 4096 + ((i) & 3) * 1024) : "memory"); \
                         asm volatile("ds_read_b64_tr_b16 %0,%1 offset:%c2" : "=&v"(vhh[i]) : "v"(vb), "i"(((i) >> 2) * 4096 + ((i) & 3) * 1024 + 512) : "memory"); } \
            if (i & 1) S1 = __builtin_amdgcn_mfma_f32_32x32x16_bf16(kfa, qr[i >> 1], (i == 1) ? negm : S1, 0, 0, 0); \
            else       S0 = __builtin_amdgcn_mfma_f32_32x32x16_bf16(kfa, qr[i >> 1], (i == 0) ? negm : S0, 0, 0, 0); \
            { const int j0 = (i < 8) ? 3 * i : 24 + 2 * (i - 8), j1 = (i < 8) ? 3 * i + 3 : 24 + 2 * (i - 8) + 2; \
              _Pragma("unroll") for (int j = j0; j < j1; ++j) sacc += (j < 16) ? P0[j & 15] : P1[j & 15]; } \
            if (i < 8) { const int e = 4 * i; pw[2 * i] = (e < 16) ? cvt_pk_bf16(P0[e & 15], P0[(e + 1) & 15]) : cvt_pk_bf16(P1[e & 15], P1[(e + 1) & 15]); \
                         pw[2 * i + 1] = (e < 16) ? cvt_pk_bf16(P0[(e + 2) & 15], P0[(e + 3) & 15]) : cvt_pk_bf16(P1[(e + 2) & 15], P1[(e + 3) & 15]); \
                         asm volatile("" : "+v"(pw[2 * i]), "+v"(pw[2 * i + 1])); } \
            asm volatile("" : "+v"(sacc)); \
            kfa = kfb; kfb = kfc; kfc = kfd; kfd = kfe; \
            AT_SB(); \
        } \
        lsum += sacc; \
        asm volatile("s_waitcnt lgkmcnt(0)" ::: "memory"); AT_SB(); \
        _Pragma("unroll") for (int j = 0; j < 8; ++j) { const int d0 = j & 1, ks = j >> 1, vi = d0 * 4 + ks; \
            const bf16x8 vf = (bf16x8){vlo[vi][0], vlo[vi][1], vlo[vi][2], vlo[vi][3], vhh[vi][0], vhh[vi][1], vhh[vi][2], vhh[vi][3]}; \
            const bf16x8 pa = AT_PV(ks); \
            o[d0] = __builtin_amdgcn_mfma_f32_32x32x16_bf16(pa, vf, o[d0], 0, 0, 0); \
            _Pragma("unroll") for (int e = 0; e < 4; ++e) { if (j < 4) S0[4 * j + e] = fast_exp2(S0[4 * j + e]); else S1[4 * (j - 4) + e] = fast_exp2(S1[4 * (j - 4) + e]); } \
            if (j < 4) asm volatile("" : "+v"(S0)); else asm volatile("" : "+v"(S1)); \
            AT_SB(); \
        } \
    } while (0)
    int ksl = 1, vsl = 0;
#define AT_TOP(t) do { if ((t) + 1 < NT) AT_WAIT_V(3); else AT_WAIT_V(1); __builtin_amdgcn_s_barrier(); asm volatile("" ::: "memory"); \
        const int nsl = (ksl == 2) ? 0 : ksl + 1; if ((t) + 2 < NT) AT_DMA_K((t) + 2, vsl); if ((t) + 1 < NT) AT_DMA_V((t) + 1, nsl); } while (0)
#define AT_ROT() do { vsl = ksl; ksl = (ksl == 2) ? 0 : ksl + 1; } while (0)
    int t = 1;
    for (; t + 1 < NT; t += 2) {
        AT_TOP(t);     AT_STEP(pB0, pB1, pA0, pA1, ksl, vsl); AT_ROT();
        AT_TOP(t + 1); AT_STEP(pA0, pA1, pB0, pB1, ksl, vsl); AT_ROT();
    }
    AT_TOP(t); AT_STEP(pB0, pB1, pA0, pA1, ksl, vsl); AT_ROT();
    AT_WAIT_V(0); __builtin_amdgcn_s_barrier(); asm volatile("" ::: "memory");
    {
        unsigned pw[16]; float sacc = 0.f;
#pragma unroll
        for (int r = 0; r < 16; ++r) sacc += pB0[r] + pB1[r];
        lsum += sacc;
#pragma unroll
        for (int i = 0; i < 4; ++i) { pw[2 * i] = cvt_pk_bf16(pB0[4 * i], pB0[4 * i + 1]); pw[2 * i + 1] = cvt_pk_bf16(pB0[4 * i + 2], pB0[4 * i + 3]);
                                      pw[8 + 2 * i] = cvt_pk_bf16(pB1[4 * i], pB1[4 * i + 1]); pw[8 + 2 * i + 1] = cvt_pk_bf16(pB1[4 * i + 2], pB1[4 * i + 3]); }
        const unsigned vb = vb0 + vsl * VSLOT;
#pragma unroll
        for (int d0 = 0; d0 < 2; ++d0) { s16x4 lo[4], hh[4];
#pragma unroll
            for (int ks = 0; ks < 4; ++ks) {
                asm volatile("ds_read_b64_tr_b16 %0,%1 offset:%c2" : "=&v"(lo[ks]) : "v"(vb), "i"(d0 * 4096 + ks * 1024) : "memory");
                asm volatile("ds_read_b64_tr_b16 %0,%1 offset:%c2" : "=&v"(hh[ks]) : "v"(vb), "i"(d0 * 4096 + ks * 1024 + 512) : "memory"); }
            asm volatile("s_waitcnt lgkmcnt(0)" ::: "memory"); AT_SB();
#pragma unroll
            for (int ks = 0; ks < 4; ++ks) { const bf16x8 vf = (bf16x8){lo[ks][0], lo[ks][1], lo[ks][2], lo[ks][3], hh[ks][0], hh[ks][1], hh[ks][2], hh[ks][3]};
                const bf16x8 pa = AT_PV(ks);
                o[d0] = __builtin_amdgcn_mfma_f32_32x32x16_bf16(pa, vf, o[d0], 0, 0, 0); }
        }
    }
    { auto rr = __builtin_amdgcn_permlane32_swap(__float_as_uint(lsum), __float_as_uint(lsum), false, false); lsum = __uint_as_float(rr[0]) + __uint_as_float(rr[1]); }
    if (hi == 0) wsf[32 + r32] = lsum;
    asm volatile("s_waitcnt lgkmcnt(0)" ::: "memory");
    float rli[16];
#pragma unroll
    for (int r = 0; r < 16; ++r) rli[r] = fast_rcp(wsf[32 + crow(r, hi)]);
    LAS bf16_t* stg = (LAS bf16_t*)(lds + L_OST) + wid * 2048;
#pragma unroll
    for (int r = 0; r < 16; ++r) { const int orow = crow(r, hi);
#pragma unroll
        for (int d0 = 0; d0 < 2; ++d0) stg[orow * 64 + d0 * 32 + r32] = (bf16_t)(cvt_pk_bf16(o[d0][r] * rli[r], 0.f) & 0xffffu); }
    asm volatile("s_waitcnt lgkmcnt(0)" ::: "memory");
    bf16_t* Ow = P.CAT + (size_t)(qrow0 + wid * 32) * 1536 + 512 + 64 * h;
#pragma unroll
    for (int i = 0; i < 4; ++i) { const int row = i * 8 + (lane >> 3), ch = lane & 7; const u32x4 v = *(const LAS u32x4*)(stg + row * 64 + ch * 8); *(u32x4*)(Ow + (size_t)row * 1536 + ch * 8) = v; }
    asm volatile("s_waitcnt lgkmcnt(0)" ::: "memory"); __builtin_amdgcn_s_barrier(); asm volatile("" ::: "memory");
#undef AT_DMA_K
#undef AT_DMA_V
#undef AT_KF
#undef AT_PV
#undef AT_STEP
#undef AT_TOP
#undef AT_ROT
}
__device__ __forceinline__ void phase(const AttnP& P, const Frame& F, bool with_ctx) {
    const int vcu = (F.G % 8 == 0) ? (F.bid % 8) * (F.G / 8) + F.bid / 8 : F.bid;
    for (int u = vcu; u < NB * 8 * 8; u += F.G) { const int bh = u >> 3, qb = u & 7, b = bh >> 3;
        unit(P, F.lds, bh, b * LROW + CTXL + qb * 256, LROW / 64, F.tid); }
    if (with_ctx) for (int u = vcu; u < NB * 8; u += F.G) { const int b = u >> 3; unit(P, F.lds, u, b * LROW, CTXL / 64, F.tid); }
}
}


constexpr int PH_PER_LAYER = 11, NPHASE = 1 + DEPTH * PH_PER_LAYER + 1;
#define IN(k) (lo <= (k) && (k) < hi)
#define PHASE_BEGIN() do { if (need_bar) xcd_barrier(bar); need_bar = true; int t_ = threadIdx.x; asm volatile("" : "+v"(t_)); F.tid = t_; F.lane = t_ & 63; F.wave = __builtin_amdgcn_readfirstlane(t_ >> 6); } while (0)
#define WSP(T_, off) ((T_*)(ws + (off)))

template <int L>
__device__ __forceinline__ void layer_phases(const Args& a, Frame& F, const XcdBarrier& bar, bool& need_bar, const int lo, const int hi) {
    constexpr int l = L, pb = 1 + l * PH_PER_LAYER;
    if (hi <= pb || lo >= pb + PH_PER_LAYER) return;
    constexpr bool last = (l == DEPTH - 1), moe = (l & 1) != 0; constexpr int jf = l >> 1;
    unsigned char* ws = a.ws;
    unsigned* ctl = (unsigned*)(ws + WS_CTL);
    float* MOD = WSP(float, WS_MOD); bf16_t* XRES = WSP(bf16_t, WS_XRES);
    const float* MODl = MOD + (size_t)l * NMOD * 6144;
    unsigned* cnt = ctl + CW_CNT + jf * 8 * 64;
    constexpr int nMrows = last ? NB * 8 : T / 256, rmode = last ? 1 : 0;
    bf16_t* H = WSP(bf16_t, A_H); bf16_t* Gt = WSP(bf16_t, A_G); bf16_t* ZR = WSP(bf16_t, A_ZR); bf16_t* ZQ = WSP(bf16_t, A_ZQ); bf16_t* Qb = WSP(bf16_t, A_Q);
    bf16_t* ZKV = WSP(bf16_t, A_ZKV); bf16_t* KR = WSP(bf16_t, A_KR); bf16_t* KVR = WSP(bf16_t, A_KVR); bf16_t* U = WSP(bf16_t, A_U); bf16_t* CAT = WSP(bf16_t, A_CAT);
    bf16_t* Kb = H; bf16_t* Vb = KVR;
    float* SUM = WSP(float, A_SUM); float* CAR = WSP(float, A_CAR);
    bf16_t* HID = WSP(bf16_t, A_HID); bf16_t* HP = WSP(bf16_t, A_HP); bf16_t* HIDM = WSP(bf16_t, A_HIDM);
    i32x4* routeA = WSP(i32x4, WS_ROUTE_A); f32x2* routeW = WSP(f32x2, WS_ROUTE_W); i32x2* routeP = WSP(i32x2, WS_ROUTE_P);

    if (IN(pb + 0)) { PHASE_BEGIN(); {
        NormP P{}; P.xin = a.in[I_X]; P.cin = a.in[I_CTX]; P.X = XRES; P.from_f32 = (l == 0); P.outf = nullptr; P.gain = a.in[I_GN1] + l * DM; P.mod = MODl; P.shsel = 0; P.H = H;
        P.combine = (l == 2); P.Y = HP; P.routeP = routeP; P.routeW = routeW; P.modprev = MOD + (size_t)(l > 0 ? l - 1 : 0) * NMOD * 6144; P.do_norm = true; P.latent_only = false;
        norm_job<false>(P, F);
        { u32x4* st = WSP(u32x4, WS_STATS); for (int i = F.bid * NTHREADS + F.tid; i < 2 * T; i += F.G * NTHREADS) st[i] = (u32x4){0u, 0u, 0u, 0u}; }
        if constexpr (moe) { u32x4* iv = WSP(u32x4, WS_INV); for (int i = F.bid * NTHREADS + F.tid; i < 2 * T; i += F.G * NTHREADS) iv[i] = (u32x4){0u, 0u, 0u, 0u}; } } }
    if (IN(pb + 1)) { PHASE_BEGIN(); {
        pg8::Gemm g{H, WSP(const bf16_t, WS_WIN) + (size_t)l * NWIN * DM, DM, DM, DM, 0};
        pg8::Order S; S.init(last ? NB * 8 : T / 256, NWIN / 256, F.G, F.bid, last ? 3 : 0, 1, DM, DM, 0);
        pg8::EpiWin E{U, ZQ, ZKV, ZR, Gt, KR, a.in[I_BGATE] + l * 3072, WSP(unsigned long long, WS_STATS)};
        pg8::gemm_phase<pg8::EpiWin, true>(F.lds, g, S, E, F.tid);
        if (F.G == 256) krope_job(H, WSP(const bf16_t, WS_WKR) + (size_t)l * 64 * 512, KR, WSP(unsigned long long, WS_STATS), F.bid >= 128 ? (F.bid - 128) * NWAVES + F.wave : -1, 128 * NWAVES, F);
        else krope_job(H, WSP(const bf16_t, WS_WKR) + (size_t)l * 64 * 512, KR, WSP(unsigned long long, WS_STATS), F.bid * NWAVES + F.wave, F.G * NWAVES, F); } }
    if (IN(pb + 2)) { PHASE_BEGIN(); {
        { ConvP P{U, CAT, a.in[I_CONVW] + l * 31 * 512, a.in[I_CONVB] + l * 512, a.in[I_CLNG] + l * 512, a.in[I_CLNB] + l * 512, last}; conv_job(P, F); }
        __syncthreads();
        { ScanP P{ZR, CAT, a.in[I_RCW] + l * 2 * 4 * 512, a.in[I_RCB] + l * 2 * 512, WSP(const bf16_t, WS_WREC) + (size_t)l * 256 * 512, a.in[I_BRA] + l * 1024, a.in[I_BRI] + l * 1024, a.in[I_LAM] + l * 1024, SUM, CAR};
          scan_job<false>(P, F); }
        __syncthreads();
        { LAS f32x2* tl = (LAS f32x2*)(F.lds + RING_BYTES + 10240); tl[F.tid] = WSP(const f32x2, WS_TAB)[F.tid]; __syncthreads(); }
        { pg8::Gemm g{ZQ, WSP(const bf16_t, WS_WQB) + (size_t)l * 1024 * 768, 768, 768, 768, 0};
          pg8::Order S; S.init(last ? NB * 8 : T / 256, 4, F.G, F.bid, last ? 1 : 0, 1, 768, 768, 0);
          pg8::EpiQ E{Qb, a.in[I_GQN] + l * 96, WSP(const unsigned long long, WS_STATS), (LAS float*)(F.lds + RING_BYTES)};
          pg8::gemm_phase<pg8::EpiQ, true>(F.lds, g, S, E, F.tid); }
        if (last || F.G != 256 || F.bid >= 64)
        { pg8::Gemm g{ZKV, WSP(const bf16_t, WS_WKVB) + (size_t)l * 1024 * 256, 256, 256, 256, 0};
          pg8::Order S; if (last || F.G != 256) S.init(T / 256, 4, F.G, F.bid, 0, 1, 256, 256, 0); else S.init(T / 256, 4, 192, F.bid - 64, 0, 1, 256, 256, 0);
          pg8::EpiKV E{Kb, Vb, KR, a.in[I_GKN] + l * 96, WSP(const unsigned long long, WS_STATS), (LAS float*)(F.lds + RING_BYTES)};
          pg8::gemm_phase<pg8::EpiKV, true>(F.lds, g, S, E, F.tid); }
        } }
    if (IN(pb + 3)) { PHASE_BEGIN(); {
        carry_job(SUM, CAR, F); } }
    if (IN(pb + 4)) { PHASE_BEGIN(); {
        { ScanP P{ZR, CAT, a.in[I_RCW] + l * 2 * 4 * 512, a.in[I_RCB] + l * 2 * 512, WSP(const bf16_t, WS_WREC) + (size_t)l * 256 * 512, a.in[I_BRA] + l * 1024, a.in[I_BRI] + l * 1024, a.in[I_LAM] + l * 1024, SUM, CAR};
          scan_job<true>(P, F); }
        __syncthreads();
        { float mq = 0.f, mk = 0.f;
          for (int d = 0; d < 96; ++d) { mq = fmaxf(mq, fabsf(a.in[I_GQN][l * 96 + d])); mk = fmaxf(mk, fabsf(a.in[I_GKN][l * 96 + d])); }
          attn::AttnP P{Qb, Kb, Vb, CAT, 96.0f * mq * mk * QSCALE};
          attn::phase(P, F, !last); } } }
    if (IN(pb + 5)) { PHASE_BEGIN(); {
        pg8::Gemm g{CAT, WSP(const bf16_t, WS_WCAT) + (size_t)l * 1024 * 1536, 1536, 1536, 512, 0};
        pg8::Order S; S.init(nMrows, 4, F.G, F.bid, rmode, 3, 1536, 1536, 512);
        pg8::EpiMerge E{Gt, H};
        pg8::gemm_phase<pg8::EpiMerge, true>(F.lds, g, S, E, F.tid);
        if constexpr (l == 0 || l == 2) { if (F.G == 256) convert_moe(a, F, jf, 0, CVT_SPLIT1, F.bid - 64, 192); }
        if constexpr (l == 1) { if (F.G == 256) convert_common(a, F, 2 * CC_PER_LAYER, 4 * CC_PER_LAYER, F.bid - 64, 192); }
        } }
    if (IN(pb + 6)) { PHASE_BEGIN(); {
        pg8::Gemm g{H, WSP(const bf16_t, WS_WOUT) + (size_t)l * 1024 * 1024, DM, DM, DM, 1};
        pg8::Order S; S.init(nMrows, 4, F.G, F.bid, rmode, 1, DM, DM, 0);
        pg8::EpiResid E{XRES, MODl, 2};
        pg8::gemm_phase<pg8::EpiResid, true>(F.lds, g, S, E, F.tid);
        if constexpr (l == 0 || l == 2) { if (F.G == 256) convert_moe(a, F, jf, CVT_SPLIT1, CVT_SPLIT2, F.bid - 64, 192); }
        if constexpr (l == 1) { if (F.G == 256) convert_common(a, F, DEPTH * CC_PER_LAYER + CC_PER_FF, CC_NITEMS, F.bid - 64, 192); } } }
    if (IN(pb + 7)) { PHASE_BEGIN(); {
        NormP P{}; P.X = XRES; P.from_f32 = false; P.outf = nullptr; P.gain = a.in[I_GN2] + l * DM; P.mod = MODl; P.shsel = 3; P.H = H;
        P.combine = false; P.do_norm = true; P.latent_only = last;
        P.wrouter = a.in[I_WROUTER] + (size_t)jf * DM * 8; P.routeA = routeA; P.routeWout = routeW; P.cnt = cnt; P.inv = WSP(int, WS_INV);
        if (moe) norm_job<true>(P, F); else norm_job<false>(P, F); } }
    if constexpr (moe) {
        if (IN(pb + 9)) { PHASE_BEGIN(); {
            int off[9]; moe_offsets(cnt, off);
            for (int ai = F.bid * NTHREADS + F.tid; ai < (last ? NB * SEQ : T); ai += F.G * NTHREADS) { const int row = last ? (ai / SEQ) * LROW + CTXL + (ai % SEQ) : ai;
                const i32x4 ra = routeA[row]; int p0 = ra.y, p1 = ra.w;
#pragma unroll
                for (int e = 0; e < 8; ++e) { p0 += (ra.x == e) ? off[e] : 0; p1 += (ra.z == e) ? off[e] : 0; }
                routeP[row] = (i32x2){p0, p1}; }
            pg8::Gemm g{H, WSP(const bf16_t, WS_WEGU), DM, DM, DM, 0, WSP(const int, WS_INV)};
            pg8::Order S; S.init(off[8] >> 8, 28, F.G, F.bid, 2, 1, DM, DM, 0); S.n_per_group = 7168; S.gathered = true;
#pragma unroll
            for (int e = 0; e < 9; ++e) S.tstart[e] = off[e] >> 8;
            pg8::EpiSwiGLU E{HIDM, DFF};
            pg8::gemm_phase<pg8::EpiSwiGLU, true, true>(F.lds, g, S, E, F.tid); } }
        if (IN(pb + 10)) { PHASE_BEGIN(); {
            int off[9]; moe_offsets(cnt, off);
            pg8::Gemm g{HIDM, WSP(const bf16_t, WS_WED), DFF, DFF, DFF, 1};
            pg8::Order S; S.init(off[8] >> 8, 4, F.G, F.bid, 2, 1, DFF, DFF, 0); S.n_per_group = 1024;
#pragma unroll
            for (int e = 0; e < 9; ++e) S.tstart[e] = off[e] >> 8;
            pg8::EpiPlain E{HP, DM};
            pg8::gemm_phase<pg8::EpiPlain, true>(F.lds, g, S, E, F.tid); } }
    } else {
        if (IN(pb + 9)) { PHASE_BEGIN(); {
            pg8::Gemm g{H, WSP(const bf16_t, WS_WFFGU) + (size_t)jf * 7168 * 1024, DM, DM, DM, 0};
            pg8::Order S; S.init(T / 256, 28, F.G, F.bid, 0, 1, DM, DM, 0);
            pg8::EpiSwiGLU E{HID, DFF};
            pg8::gemm_phase<pg8::EpiSwiGLU, true>(F.lds, g, S, E, F.tid); } }
        if (IN(pb + 10)) { PHASE_BEGIN(); {
            pg8::Gemm g{HID, WSP(const bf16_t, WS_WFFD) + (size_t)jf * 1024 * DFF, DFF, DFF, DFF, 1};
            pg8::Order S; S.init(T / 256, 4, F.G, F.bid, 0, 1, DFF, DFF, 0);
            pg8::EpiResid E{XRES, MODl, 5};
            pg8::gemm_phase<pg8::EpiResid, true>(F.lds, g, S, E, F.tid);
            if (F.G == 256) convert_moe(a, F, jf, CVT_SPLIT2, MOE_CVT_ITEMS, F.bid - 64, 192);
            else { __syncthreads(); convert_moe(a, F, jf, 0, MOE_CVT_ITEMS, F.bid, F.G); } } }
    }
}

__global__ void __launch_bounds__(NTHREADS, 2) fwd_kernel(Args a) {
    extern __shared__ __attribute__((aligned(16))) unsigned char lds_raw[];
    Frame F;
    F.lds = (LAS unsigned char*)lds_raw; F.tid = threadIdx.x; F.lane = F.tid & 63; F.wave = __builtin_amdgcn_readfirstlane(F.tid >> 6); F.G = gridDim.x; F.bid = blockIdx.x; F.ws = a.ws;
    volatile LAS unsigned* MISC = (volatile LAS unsigned*)(F.lds + LDSCTL_OFF);
    if (F.tid < 64) MISC[F.tid] = 0u;
    __syncthreads();
    XcdBarrier bar = xcd_barrier_post((unsigned*)(a.ws + WS_CTL) + CW_BAR, MISC + 8);
    const int lo = a.ph_lo, hi = a.ph_hi;
    bool need_bar = false;
    if (IN(0)) { PHASE_BEGIN(); {
        if (F.G == 256) { convert_common(a, F, 0, 2 * CC_PER_LAYER, F.bid, F.G); convert_common(a, F, DEPTH * CC_PER_LAYER, DEPTH * CC_PER_LAYER + CC_PER_FF, F.bid, F.G); }
        else convert_common(a, F, 0, CC_NITEMS, F.bid, F.G);
        rope_table_job((f32x2*)(a.ws + WS_TAB), F); __syncthreads(); mod_job(a, F); } }
    layer_phases<0>(a, F, bar, need_bar, lo, hi);
    layer_phases<1>(a, F, bar, need_bar, lo, hi);
    layer_phases<2>(a, F, bar, need_bar, lo, hi);
    layer_phases<3>(a, F, bar, need_bar, lo, hi);
    if (IN(NPHASE - 1)) { PHASE_BEGIN(); {
        unsigned char* ws = a.ws;
        NormP P{}; P.X = WSP(bf16_t, WS_XRES); P.from_f32 = false; P.outf = a.out; P.combine = true; P.Y = WSP(bf16_t, A_HP); P.routeP = WSP(i32x2, WS_ROUTE_P); P.routeW = WSP(f32x2, WS_ROUTE_W);
        P.modprev = WSP(float, WS_MOD) + (size_t)(DEPTH - 1) * NMOD * 6144; P.do_norm = false; P.latent_only = true;
        norm_job<false>(P, F); } }
}
#undef IN
#undef PHASE_BEGIN

extern "C" void kernel_launch(void* const* d_in, const int* in_sizes, int n_in, void* d_out, int out_size, void* d_ws, size_t ws_size, hipStream_t stream) {
    static int grid = 0;
    if (grid == 0) {
        if (n_in != 38 || out_size != NB * SEQ * DM || ws_size < WS_END) { fprintf(stderr, "kernel_launch: unexpected shapes (n_in %d out %d ws %zu need %zu)\n", n_in, out_size, ws_size, (size_t)WS_END); grid = -1; return; }
        int dev = 0, cus = 0;
        if (hipGetDevice(&dev) != hipSuccess || hipDeviceGetAttribute(&cus, hipDeviceAttributeMultiprocessorCount, dev) != hipSuccess) { grid = -1; return; }
        if (hipFuncSetAttribute((const void*)fwd_kernel, hipFuncAttributeMaxDynamicSharedMemorySize, LDS_BYTES) != hipSuccess) { fprintf(stderr, "kernel_launch: hipFuncSetAttribute failed\n"); grid = -1; return; }
        int per_cu = 0;
        if (hipOccupancyMaxActiveBlocksPerMultiprocessor(&per_cu, (const void*)fwd_kernel, NTHREADS, LDS_BYTES) != hipSuccess || per_cu < 1) { fprintf(stderr, "kernel_launch: occupancy query says %d\n", per_cu); }
        (void)hipGetLastError();
        grid = cus;
    }
    if (grid < 0) return;
    (void)hipMemsetAsync((char*)d_ws + WS_CTL, 0, CTL_BYTES, stream);
    Args a{};
    for (int i = 0; i < 38; ++i) a.in[i] = (const float*)d_in[i];
    a.out = (float*)d_out; a.ws = (unsigned char*)d_ws;
#if MK_ONE_LAUNCH
    a.ph_lo = 0; a.ph_hi = NPHASE;
    hipLaunchKernelGGL(fwd_kernel, dim3(grid), dim3(NTHREADS), LDS_BYTES, stream, a);
#else
    for (int k = 0; k < NPHASE; ++k) {
        if (k >= 1 && k < NPHASE - 1) { const int l = (k - 1) / PH_PER_LAYER, p = (k - 1) % PH_PER_LAYER; if (p == 8 && !(l & 1)) continue; }
        a.ph_lo = k; a.ph_hi = k + 1;
        hipLaunchKernelGGL(fwd_kernel, dim3(grid), dim3(NTHREADS), LDS_BYTES, stream, a);
    }
#endif
}
```

```cpp
#include <hip/hip_runtime.h>
#include <cstdio>
#include <cstdint>

#ifndef MK_ONE_LAUNCH
#define MK_ONE_LAUNCH 1
#endif

#define LAS __attribute__((address_space(3)))
#define GAS __attribute__((address_space(1)))
typedef unsigned short bf16_t;
typedef short bf16x8 __attribute__((ext_vector_type(8)));
typedef short s16x4 __attribute__((ext_vector_type(4)));
typedef float f32x2 __attribute__((ext_vector_type(2)));
typedef float f32x4 __attribute__((ext_vector_type(4)));
typedef float f32x16 __attribute__((ext_vector_type(16)));
typedef unsigned u32x2 __attribute__((ext_vector_type(2)));
typedef unsigned u32x4 __attribute__((ext_vector_type(4)));
typedef int i32x4 __attribute__((ext_vector_type(4)));
typedef int i32x2 __attribute__((ext_vector_type(2)));

constexpr int DM = 1024, NB = 16, SEQ = 2048, CTXL = 256, LROW = CTXL + SEQ  , T = NB * LROW  , DEPTH = 4;
constexpr int IN_COLS = 6176, NWIN = 6144, DFF = 3584, NEXP = 8, NMOD = 17;
constexpr int MOE_ROWS_MAX = 75776;
constexpr float NORM_EPS = 1e-6f;
constexpr float QSCALE = 0.10206207261596577f * 1.4426950408889634f;
constexpr int NTHREADS = 512, NWAVES = 8;

constexpr size_t al256(size_t x) { return (x + 255) & ~(size_t)255; }
constexpr size_t WS_CTL = 0, CTL_BYTES = 1u << 20;
constexpr size_t WS_MOD = WS_CTL + CTL_BYTES;
constexpr size_t WS_XRES = WS_MOD + al256((size_t)DEPTH * NMOD * 6144 * 4);
constexpr size_t WS_ROUTE_A = WS_XRES + (size_t)T * DM * 2;
constexpr size_t WS_ROUTE_W = WS_ROUTE_A + (size_t)T * 16;
constexpr size_t WS_ROUTE_P = WS_ROUTE_W + (size_t)T * 8;
constexpr size_t WS_TAB = WS_ROUTE_P + (size_t)T * 8;
constexpr size_t WS_STATS = WS_TAB + 4096;
constexpr size_t WS_INV = WS_STATS + (size_t)T * 32;
constexpr size_t WS_WIN = WS_INV + (size_t)8 * T * 4;
constexpr size_t WS_WQB = WS_WIN + (size_t)DEPTH * NWIN * DM * 2;
constexpr size_t WS_WKVB = WS_WQB + (size_t)DEPTH * 1024 * 768 * 2;
constexpr size_t WS_WCAT = WS_WKVB + (size_t)DEPTH * 1024 * 256 * 2;
constexpr size_t WS_WOUT = WS_WCAT + (size_t)DEPTH * 1024 * 1536 * 2;
constexpr size_t WS_WREC = WS_WOUT + (size_t)DEPTH * 1024 * 1024 * 2;
constexpr size_t WS_WKR = WS_WREC + (size_t)DEPTH * 2 * 2 * 8 * 4096 * 2;
constexpr size_t WS_WFFGU = WS_WKR + (size_t)DEPTH * 64 * 512 * 2;
constexpr size_t WS_WFFD = WS_WFFGU + (size_t)2 * 7168 * 1024 * 2;
constexpr size_t WS_WEGU = WS_WFFD + (size_t)2 * 1024 * 3584 * 2;
constexpr size_t WS_WED = WS_WEGU + (size_t)NEXP * 7168 * 1024 * 2;
constexpr size_t WS_ARENA = WS_WED + (size_t)NEXP * 1024 * 3584 * 2;
constexpr size_t A_H = WS_ARENA;
constexpr size_t A_G = A_H + (size_t)T * 1024 * 2;
constexpr size_t A_ZR = A_G + (size_t)T * 3072 * 2;
constexpr size_t A_ZQ = A_ZR + (size_t)T * 1024 * 2;
constexpr size_t A_Q = A_ZQ + (size_t)T * 768 * 2;
constexpr size_t A_ZKV = A_Q + (size_t)T * 768 * 2;
constexpr size_t A_KR = A_ZKV + (size_t)T * 256 * 2;
constexpr size_t A_KVR = A_KR + (size_t)T * 32 * 2;
constexpr size_t A_U = A_KVR + (size_t)T * 1024 * 2;
constexpr size_t A_CAT = A_U + (size_t)T * 512 * 2;
constexpr size_t A_SUM = A_CAT + (size_t)T * 1536 * 2;
constexpr size_t A_CAR = A_SUM + (size_t)NB * 8 * 2 * 72 * 2 * 64 * 4;
constexpr size_t A_MIX_END = A_CAR + (size_t)NB * 8 * 2 * 72 * 64 * 4;
constexpr size_t A_HID = A_G;
constexpr size_t A_HP = A_G;
constexpr size_t A_HIDM = A_HP + (size_t)MOE_ROWS_MAX * 1024 * 2;
constexpr size_t A_MOE_END = A_HIDM + (size_t)MOE_ROWS_MAX * 3584 * 2;
constexpr size_t WS_END = A_MIX_END > A_MOE_END ? A_MIX_END : A_MOE_END;
static_assert(WS_END < 1203000000ull, "workspace map must fit under sum(inputs)");
constexpr int CW_BAR = 4096, CW_CNT = 16384;

constexpr int RING_BYTES = 131072, LDS_BYTES = 147456, LDSCTL_OFF = LDS_BYTES - 1024;

__device__ __forceinline__ unsigned cvt_pk_bf16(float lo, float hi) { unsigned r; asm volatile("v_cvt_pk_bf16_f32 %0, %1, %2" : "=v"(r) : "v"(lo), "v"(hi)); return r; }
__device__ __forceinline__ float bf2f(unsigned short b) { return __uint_as_float(((unsigned)b) << 16); }
__device__ __forceinline__ float bflo(unsigned w) { return __uint_as_float(w << 16); }
__device__ __forceinline__ float bfhi(unsigned w) { return __uint_as_float(w & 0xffff0000u); }
__device__ __forceinline__ float fast_exp2(float x) { return __builtin_amdgcn_exp2f(x); }
__device__ __forceinline__ float fast_rcp(float x) { return __builtin_amdgcn_rcpf(x); }
__device__ __forceinline__ float sigmoidf_(float x) { return fast_rcp(1.0f + fast_exp2(-1.4426950408889634f * x)); }
__device__ __forceinline__ float siluf_(float x) { return x * sigmoidf_(x); }
__device__ __forceinline__ float gelu_tanh_(float x) { const float u = 0.7978845608028654f * (x + 0.044715f * x * x * x); return x * fast_rcp(1.0f + fast_exp2(-2.885390081777927f * u)); }
__device__ __forceinline__ float wave_sum(float v) {
    int x = __float_as_int(v);
    v += __int_as_float(__builtin_amdgcn_update_dpp(0, x, 0xB1, 0xF, 0xF, false)); x = __float_as_int(v);
    v += __int_as_float(__builtin_amdgcn_update_dpp(0, x, 0x4E, 0xF, 0xF, false)); x = __float_as_int(v);
    v += __int_as_float(__builtin_amdgcn_update_dpp(0, x, 0x141, 0xF, 0xF, false)); x = __float_as_int(v);
    v += __int_as_float(__builtin_amdgcn_update_dpp(0, x, 0x140, 0xF, 0xF, false)); x = __float_as_int(v);
    return (__int_as_float(__builtin_amdgcn_readlane(x, 0)) + __int_as_float(__builtin_amdgcn_readlane(x, 16))) + (__int_as_float(__builtin_amdgcn_readlane(x, 32)) + __int_as_float(__builtin_amdgcn_readlane(x, 48)));
}
__device__ __forceinline__ float sum_x16(float v) { auto r = __builtin_amdgcn_permlane16_swap(__float_as_uint(v), __float_as_uint(v), false, false); return __uint_as_float(r[0]) + __uint_as_float(r[1]); }
__device__ __forceinline__ float sum_x32(float v) { auto r = __builtin_amdgcn_permlane32_swap(__float_as_uint(v), __float_as_uint(v), false, false); return __uint_as_float(r[0]) + __uint_as_float(r[1]); }
__device__ __forceinline__ float row16_sum(float v) {
    int x = __float_as_int(v);
    v += __int_as_float(__builtin_amdgcn_update_dpp(0, x, 0xB1, 0xF, 0xF, false)); x = __float_as_int(v);
    v += __int_as_float(__builtin_amdgcn_update_dpp(0, x, 0x4E, 0xF, 0xF, false)); x = __float_as_int(v);
    v += __int_as_float(__builtin_amdgcn_update_dpp(0, x, 0x141, 0xF, 0xF, false)); x = __float_as_int(v);
    v += __int_as_float(__builtin_amdgcn_update_dpp(0, x, 0x140, 0xF, 0xF, false));
    return v;
}
#define LDS_WAIT() asm volatile("s_waitcnt lgkmcnt(0)" ::: "memory")
#define VM_WAIT() asm volatile("s_waitcnt vmcnt(0)" ::: "memory")

#define XB_TMO      128
#define XB_XCNT(j)  (256  + 64 * (j))
#define XB_XSUB(j)  (1280 + 64 * (j))
#define XB_XGEN(j)  (2304 + 64 * (j))
#define XB_TOP      3328
#define XB_TOPGEN   3392
#define XCD_BAR_WORDS 3456
#define XB_SPIN_CAP (1u << 20)
__device__ __forceinline__ unsigned xb_ld(unsigned* p)              { return __hip_atomic_load(p, __ATOMIC_RELAXED, __HIP_MEMORY_SCOPE_AGENT); }
__device__ __forceinline__ unsigned xb_add(unsigned* p, unsigned v) { return __hip_atomic_fetch_add(p, v, __ATOMIC_RELAXED, __HIP_MEMORY_SCOPE_AGENT); }
__device__ __forceinline__ unsigned xb_xcc_id() { return (unsigned)__builtin_amdgcn_s_getreg((3 << 11) | 20) & 0xFu; }
#define XB_SPIN(cond, bar) do { unsigned _sp = 0; while (cond) { __builtin_amdgcn_s_sleep(1); \
    if ((++_sp & 255u) == 0u) { if (xb_ld(&(bar)[XB_TMO])) break; if (_sp > XB_SPIN_CAP) { atomicAdd(&(bar)[XB_TMO], 1u); break; } } } } while (0)
struct XcdBarrier { unsigned* bar; unsigned x; volatile LAS unsigned* st; };
__device__ __forceinline__ XcdBarrier xcd_barrier_post(unsigned* bar, volatile LAS unsigned* st) {
    XcdBarrier b; b.bar = bar; b.x = xb_xcc_id(); b.st = st;
    if (threadIdx.x == 0) (void)xb_add(&bar[XB_XCNT(b.x)], 1u);
    return b;
}
__device__ __forceinline__ void xcd_barrier_complete(unsigned* bar, unsigned x, unsigned& nloc, unsigned& nx) {
    const unsigned G = gridDim.x * gridDim.y * gridDim.z;
    unsigned sum, cnt, mine, sp = 0u;
    for (;;) {
        sum = 0u; cnt = 0u; mine = 0u;
#pragma unroll
        for (unsigned j = 0; j < 16; ++j) { const unsigned c = xb_ld(&bar[XB_XCNT(j)]); sum += c; cnt += (c > 0u) ? 1u : 0u; mine = (j == x) ? c : mine; }
        if (sum == G) break;
        __builtin_amdgcn_s_sleep(1);
        if ((++sp & 255u) == 0u) { if (xb_ld(&bar[XB_TMO])) break; if (sp > XB_SPIN_CAP) { atomicAdd(&bar[XB_TMO], 1u); break; } }
    }
    nloc = mine > 0u ? mine : 1u; nx = cnt > 0u ? cnt : 1u;
}
__device__ __forceinline__ void xcd_barrier(const XcdBarrier& b) {
    asm volatile("s_waitcnt vmcnt(0)" ::: "memory");
    __syncthreads();
    if (threadIdx.x == 0) {
        unsigned* bar = b.bar;
        __builtin_amdgcn_s_waitcnt(0);
        unsigned nloc = b.st[0], nx = b.st[1];
        if (nloc == 0u) { xcd_barrier_complete(bar, b.x, nloc, nx); b.st[0] = nloc; b.st[1] = nx; }
        const unsigned old = xb_add(&bar[XB_XSUB(b.x)], 1u);
        const unsigned gen = old / nloc;
        if (old + 1u == (gen + 1u) * nloc) {
            __builtin_amdgcn_fence(__ATOMIC_RELEASE, "agent");
            asm volatile("s_waitcnt vmcnt(0)" ::: "memory");
            const unsigned og = xb_add(&bar[XB_TOP], 1u);
            const unsigned tg = og / nx;
            if (og + 1u == (tg + 1u) * nx) xb_add(&bar[XB_TOPGEN], 1u);
            else XB_SPIN(xb_ld(&bar[XB_TOPGEN]) == tg, bar);
            __builtin_amdgcn_fence(__ATOMIC_ACQUIRE, "agent");
            xb_add(&bar[XB_XGEN(b.x)], 1u);
            asm volatile("s_waitcnt vmcnt(0)" ::: "memory");
        } else {
            XB_SPIN(xb_ld(&bar[XB_XGEN(b.x)]) == gen, bar);
            __builtin_amdgcn_fence(__ATOMIC_ACQUIRE, "agent");
            asm volatile("s_waitcnt vmcnt(0)" ::: "memory");
        }
    }
    __syncthreads();
}

namespace pg8 {
constexpr int BM = 256, BK = 64, HALF = 128, HTB = HALF * BK * 2, STAGE_BYTES = 8 * HTB, NXCD = 8, WGM = 8;
__host__ __device__ __forceinline__ int lds_byte(int r, int c) { const int st = (r >> 4) * 2 + (c >> 5), rr = r & 15, cc = c & 31, ob = rr * 64 + cc * 2; return st * 1024 + (ob ^ (((ob >> 9) & 1) << 5)); }
__host__ __device__ __forceinline__ void stage_rc(int b, int& R, int& C) { const int st = b / 1024, sb = b % 1024, swz = sb ^ (((sb >> 9) & 1) << 5); R = (st >> 1) * 16 + swz / 64; C = (st & 1) * 32 + (swz % 64) / 2; }
__host__ __device__ __forceinline__ int perm32(int rho) { const int n = rho >> 4, i = rho & 15; return 8 * (i >> 2) + 4 * n + (i & 3); }

struct Unit { int pm, pn, tag, gidx; size_t a_off, b_off; };
struct Gemm { const bf16_t* A; const bf16_t* Bt; int lda, ldb, K; int tiledA; const int* gather = nullptr; };

struct Order {
    int nM, nN, nwg, G, c;
    int mode;
    int nseg;
    int lda_rows;
    int ldb_rows;
    int seg_k;
    int n_per_group;
    int tstart[9];
    bool gathered;
    __device__ __forceinline__ void init(int nM_, int nN_, int G_, int c_, int mode_, int nseg_, int lda_, int ldb_, int segk_) {
        nM = nM_; nN = nN_; nwg = nM * nN; G = G_; c = c_; mode = mode_; nseg = nseg_; lda_rows = lda_; ldb_rows = ldb_; seg_k = segk_; n_per_group = 0; gathered = false;
    }
    __device__ __forceinline__ bool next(int i, Unit& u) const {
        const int ti = i / nseg, seg = i - ti * nseg;
        const long L = (long)ti * G + c;
        if (mode == 3) {
            if (L >= nwg + 80) return false;
            if (L >= nwg) { const int idx = (int)L - nwg, cb = idx / 5, j = idx - cb * 5; u.pm = cb * 9; u.pn = 7 + j; u.tag = 0; u.gidx = 0;
                u.a_off = (size_t)u.pm * BM * lda_rows; u.b_off = (size_t)u.pn * BM * ldb_rows; return true; }
        }
        if (L >= nwg) return false;
        int wgid = (int)L; { const int q = nwg / NXCD, r = nwg % NXCD, xcd = wgid % NXCD, off = wgid / NXCD; wgid = (xcd < r ? xcd * (q + 1) : r * (q + 1) + (xcd - r) * q) + off; }
        const int nig = WGM * nN, gid = wgid / nig, fm = gid * WGM, gsz = (nM - fm) < WGM ? (nM - fm) : WGM;
        int pm = fm + ((wgid % nig) % gsz); const int pn = (wgid % nig) / gsz;
        int grp = 0, gts = 0;
        if (mode == 1 || mode == 3) pm = (pm >> 3) * 9 + 1 + (pm & 7);
        if (mode == 2) {
#pragma unroll
            for (int e = 1; e < 8; ++e) { const bool ge = pm >= tstart[e]; grp += ge ? 1 : 0; gts = ge ? tstart[e] : gts; }
        }
        u.pm = pm; u.pn = pn; u.tag = (mode == 2) ? grp : seg; u.gidx = (mode == 2) ? grp * T + (pm - gts) * BM : 0;
        u.a_off = (gathered ? (size_t)0 : (size_t)pm * BM * lda_rows) + (size_t)seg * seg_k;
        u.b_off = ((size_t)grp * n_per_group + (size_t)pn * BM) * ldb_rows + (size_t)seg * seg_k * BM;
        return true;
    }
};

typedef f32x4 Acc[2][2][4][2];

template <class Epi, bool ALIGN_EPI, bool GATHER = false>
__device__ __forceinline__ void gemm_phase(LAS unsigned char* lds, const Gemm g, const Order& S, const Epi& E, const int tid) {
    const int wid = __builtin_amdgcn_readfirstlane(tid >> 6), lane = tid & 63, wr = wid >> 2, wc = wid & 3, fr = lane & 15, fq = lane >> 4;
    const int nt = g.K / BK;
    unsigned voffA[2], voffB[2];
#pragma unroll
    for (int i = 0; i < 2; ++i) { int R, C; stage_rc(tid * 16 + i * 8192, R, C); const int Rb = Epi::PERM ? ((R & ~31) + perm32(R & 31)) : R;
        voffA[i] = g.tiledA ? (unsigned)(tid * 16 + i * 8192) : (unsigned)(R * g.lda + C) * 2u; voffB[i] = (unsigned)(tid * 16 + i * 8192); (void)Rb; }
    int gR[2], gC[2]; unsigned cvo0[2] = {0u, 0u}, cvo1[2] = {0u, 0u}, nvo0[2] = {0u, 0u}, nvo1[2] = {0u, 0u};
#pragma unroll
    for (int i = 0; i < 2; ++i) stage_rc(tid * 16 + i * 8192, gR[i], gC[i]);
#define PG8_GLOAD(u_, o0, o1) do { _Pragma("unroll") for (int _i = 0; _i < 2; ++_i) { \
        o0[_i] = (unsigned)(g.gather[(u_).gidx + gR[_i]] * g.lda + gC[_i]) * 2u; o1[_i] = (unsigned)(g.gather[(u_).gidx + HALF + gR[_i]] * g.lda + gC[_i]) * 2u; } } while (0)
    const size_t kstep = (size_t)(BK * 2), kstepA = g.tiledA ? (size_t)32768 : kstep;
    const size_t hstepA = g.tiledA ? (size_t)16384 : (size_t)HALF * g.lda * 2, hstepB = 16384, kstepB = 32768;
    static_assert(Epi::PERM, "the tiled weight copies carry the PERM row order");
    const unsigned ldsw = (unsigned)wid * 1024u;
    const int aoff = lds_byte(wr * 64 + fr, fq * 8), boff = lds_byte(wc * 32 + fr, fq * 8);
#define PG8_SA(b, h) (((b) * 2 + (h)) * HTB)
#define PG8_SB(b, h) ((4 + (b) * 2 + (h)) * HTB)
#define PG8_STAGE(bufoff, gbase, voff) do { _Pragma("unroll") for (int _i = 0; _i < 2; ++_i) \
        __builtin_amdgcn_global_load_lds((const unsigned*)((const char*)(gbase) + (voff)[_i]), (LAS unsigned*)(lds + (bufoff) + ldsw + _i * 8192), 16, 0, 0); } while (0)
#define PG8_STA(bufoff, gbase, h, v0, v1) do { if constexpr (GATHER) { if (h) PG8_STAGE(bufoff, gbase, v1); else PG8_STAGE(bufoff, gbase, v0); } else PG8_STAGE(bufoff, (gbase) + (h) * hstepA, voffA); } while (0)
#define PG8_LDA(dst, b, h) do { _Pragma("unroll") for (int m = 0; m < 4; ++m) _Pragma("unroll") for (int k = 0; k < 2; ++k) dst[m][k] = *(const LAS bf16x8*)(lds + PG8_SA(b, h) + aoff + m * 2048 + k * 1024); } while (0)
#define PG8_LDB(dst, b, h) do { _Pragma("unroll") for (int n = 0; n < 2; ++n) _Pragma("unroll") for (int k = 0; k < 2; ++k) dst[n][k] = *(const LAS bf16x8*)(lds + PG8_SB(b, h) + boff + n * 2048 + k * 1024); } while (0)
#define PG8_MMA(ai, bj, At, Bt) do { __builtin_amdgcn_s_setprio(1); _Pragma("unroll") for (int m = 0; m < 4; ++m) _Pragma("unroll") for (int n = 0; n < 2; ++n) _Pragma("unroll") for (int k = 0; k < 2; ++k) \
        acc[ai][bj][m][n] = __builtin_amdgcn_mfma_f32_16x16x32_bf16(Bt[n][k], At[m][k], acc[ai][bj][m][n], 0, 0, 0); __builtin_amdgcn_s_setprio(0); } while (0)
#define PG8_WAIT_V(n) asm volatile("s_waitcnt vmcnt(" #n ")" ::: "memory")
#define PG8_WAIT_L(n) asm volatile("s_waitcnt lgkmcnt(" #n ")" ::: "memory")
#define PG8_BAR __builtin_amdgcn_s_barrier()
#define PG8_SCHED __builtin_amdgcn_sched_barrier(0)
    Unit cur, nxt; int ui = 0;
    if (!S.next(0, cur)) return;
    Acc acc;
#pragma unroll
    for (int a = 0; a < 2; ++a)
#pragma unroll
        for (int b = 0; b < 2; ++b)
#pragma unroll
            for (int m = 0; m < 4; ++m)
#pragma unroll
                for (int n = 0; n < 2; ++n) acc[a][b][m][n] = (f32x4){0.f, 0.f, 0.f, 0.f};
    bf16x8 At[4][2], B0[2][2], B1[2][2];
    const char* cA = (const char*)g.A + cur.a_off * 2; const char* cB = (const char*)g.Bt + cur.b_off * 2;
    if constexpr (GATHER) PG8_GLOAD(cur, cvo0, cvo1);
    PG8_STAGE(PG8_SB(0, 0), cB, voffB); PG8_STAGE(PG8_SB(0, 1), cB + hstepB, voffB); PG8_STA(PG8_SA(0, 0), cA, 0, cvo0, cvo1); PG8_STA(PG8_SA(0, 1), cA, 1, cvo0, cvo1);
    if (wr == 1) PG8_BAR;
    PG8_WAIT_V(2); PG8_BAR;
    PG8_STAGE(PG8_SB(1, 0), cB + kstepB, voffB); PG8_STA(PG8_SA(1, 0), cA + kstepA, 0, cvo0, cvo1); PG8_STAGE(PG8_SB(1, 1), cB + hstepB + kstepB, voffB);
    PG8_WAIT_V(6); PG8_BAR;
    for (;;) {
        const bool has_next = S.next(ui + 1, nxt);
        const char* nA = has_next ? (const char*)g.A + nxt.a_off * 2 : cA; const char* nB = has_next ? (const char*)g.Bt + nxt.b_off * 2 : cB;
        if constexpr (GATHER) { if (has_next) {
#pragma unroll
            for (int k = 0; k < 4; ++k) __builtin_amdgcn_global_load_lds((const unsigned*)(g.gather + nxt.gidx + (k >> 1) * HALF + gR[k & 1]), (LAS unsigned*)(lds + RING_BYTES + (wid * 4 + k) * 256), 4, 0, 0); } }
        for (int t = 0; t < nt; t += 2) {
            const bool last = (t == nt - 2);
            const char* a1 = cA + (size_t)(t + 1) * kstepA;
            const char* a2 = last ? nA : cA + (size_t)(t + 2) * kstepA; const char* b2 = last ? nB : cB + (size_t)(t + 2) * kstepB;
            const char* a3 = a2 + kstepA; const char* b3 = b2 + kstepB;
            unsigned s0[2] = {0u, 0u}, s1[2] = {0u, 0u};
            if constexpr (GATHER) {
                if (last && has_next) {
#pragma unroll
                    for (int i = 0; i < 2; ++i) { const int t0 = *(const LAS int*)(lds + RING_BYTES + (wid * 4 + i) * 256 + lane * 4), t1 = *(const LAS int*)(lds + RING_BYTES + (wid * 4 + 2 + i) * 256 + lane * 4);
                        nvo0[i] = (unsigned)(t0 * g.lda + gC[i]) * 2u; nvo1[i] = (unsigned)(t1 * g.lda + gC[i]) * 2u; } }
                else if (last) { nvo0[0] = cvo0[0]; nvo0[1] = cvo0[1]; nvo1[0] = cvo1[0]; nvo1[1] = cvo1[1]; }
                s0[0] = last ? nvo0[0] : cvo0[0]; s0[1] = last ? nvo0[1] : cvo0[1]; s1[0] = last ? nvo1[0] : cvo1[0]; s1[1] = last ? nvo1[1] : cvo1[1]; }
            PG8_LDB(B0, 0, 0); PG8_LDB(B1, 0, 1); PG8_SCHED; PG8_LDA(At, 0, 0); PG8_STA(PG8_SA(1, 1), a1, 1, cvo0, cvo1);
            PG8_WAIT_V(8); PG8_WAIT_L(0); PG8_BAR; PG8_MMA(0, 0, At, B0); PG8_MMA(0, 1, At, B1); PG8_BAR; PG8_SCHED;
            PG8_LDA(At, 0, 1); PG8_STAGE(PG8_SB(0, 0), b2, voffB); PG8_STAGE(PG8_SB(0, 1), b2 + hstepB, voffB); PG8_STA(PG8_SA(0, 0), a2, 0, s0, s1);
            PG8_WAIT_V(8); PG8_WAIT_L(0); PG8_BAR; PG8_MMA(1, 0, At, B0); PG8_MMA(1, 1, At, B1); PG8_BAR; PG8_SCHED;
            PG8_LDB(B0, 1, 0); PG8_LDB(B1, 1, 1); PG8_SCHED; PG8_LDA(At, 1, 0); PG8_STA(PG8_SA(0, 1), a2, 1, s0, s1);
            PG8_WAIT_V(8); PG8_WAIT_L(0); PG8_BAR; PG8_MMA(0, 0, At, B0); PG8_MMA(0, 1, At, B1); PG8_BAR; PG8_SCHED;
            PG8_LDA(At, 1, 1); PG8_STAGE(PG8_SB(1, 0), b3, voffB); PG8_STAGE(PG8_SB(1, 1), b3 + hstepB, voffB); PG8_STA(PG8_SA(1, 0), a3, 0, s0, s1);
            PG8_WAIT_V(8); PG8_WAIT_L(0); PG8_BAR; PG8_MMA(1, 0, At, B0); PG8_MMA(1, 1, At, B1); PG8_BAR; PG8_SCHED;
        }
        if constexpr (ALIGN_EPI) { if (wr == 0) PG8_BAR; }
        E(acc, cur, wr, wc, fr, fq);
        if (!has_next) break;
        if constexpr (!Epi::KEEP_ACC) {
#pragma unroll
            for (int a = 0; a < 2; ++a)
#pragma unroll
                for (int b = 0; b < 2; ++b)
#pragma unroll
                    for (int m = 0; m < 4; ++m)
#pragma unroll
                        for (int n = 0; n < 2; ++n) acc[a][b][m][n] = (f32x4){0.f, 0.f, 0.f, 0.f};
        }
        cur = nxt; cA = nA; cB = nB; ++ui;
        if constexpr (GATHER) { cvo0[0] = nvo0[0]; cvo0[1] = nvo0[1]; cvo1[0] = nvo1[0]; cvo1[1] = nvo1[1]; }
        if constexpr (ALIGN_EPI) { if (wr == 1) PG8_BAR; }
    }
    PG8_WAIT_V(0);
    if constexpr (!ALIGN_EPI) { if (wr == 0) PG8_BAR; }
    PG8_BAR;
#undef PG8_SA
#undef PG8_SB
#undef PG8_STAGE
#undef PG8_LDA
#undef PG8_STA
#undef PG8_GLOAD
#undef PG8_LDB
#undef PG8_MMA
#undef PG8_WAIT_V
#undef PG8_WAIT_L
#undef PG8_BAR
#undef PG8_SCHED
}

__device__ __forceinline__ u32x4 pack8(const f32x4 v0, const f32x4 v1) { u32x4 w; w.x = cvt_pk_bf16(v0[0], v0[1]); w.y = cvt_pk_bf16(v0[2], v0[3]); w.z = cvt_pk_bf16(v1[0], v1[1]); w.w = cvt_pk_bf16(v1[2], v1[3]); return w; }
__device__ __forceinline__ void unpack8(const u32x4 w, f32x4& v0, f32x4& v1) { v0 = (f32x4){bflo(w.x), bfhi(w.x), bflo(w.y), bfhi(w.y)}; v1 = (f32x4){bflo(w.z), bfhi(w.z), bflo(w.w), bfhi(w.w)}; }

__device__ __forceinline__ size_t tiled_a_off(int pm, int Ktot, int ai, int wr, int m, int fr, int fq, int c) {
    const int kt = c >> 6, st = ((4 * wr + m) << 1) + ((c >> 5) & 1), ob = (64 * fr + 16 * fq) ^ ((fr >> 3) << 5);
    return (size_t)pm * BM * Ktot + (size_t)kt * 16384 + ai * 8192 + st * 512 + (ob >> 1);
}
struct EpiPlain {
    static constexpr bool PERM = true, KEEP_ACC = false;
    bf16_t* O; int ldc;
    __device__ __forceinline__ void operator()(Acc& acc, const Unit& u, int wr, int wc, int fr, int fq) const {
        const int row0 = u.pm * BM + wr * 64 + fr, col0 = u.pn * BM + wc * 32 + 8 * fq;
#pragma unroll
        for (int ai = 0; ai < 2; ++ai)
#pragma unroll
            for (int m = 0; m < 4; ++m) { bf16_t* rowp = O + (size_t)(row0 + ai * HALF + m * 16) * ldc + col0;
#pragma unroll
                for (int bj = 0; bj < 2; ++bj) *(u32x4*)(rowp + bj * HALF) = pack8(acc[ai][bj][m][0], acc[ai][bj][m][1]); }
    }
};
struct EpiQ {
    static constexpr bool PERM = true, KEEP_ACC = false;
    bf16_t* Q; const float* gqn; const unsigned long long* stats; LAS float* red;
    __device__ __forceinline__ void operator()(Acc& acc, const Unit& u, int wr, int wc, int fr, int fq) const {
        asm volatile("" : "+v"(fr), "+v"(fq));
        const int b = u.pm / 9, tq = u.pm - b * 9, row0 = u.pm * BM + wr * 64 + fr;
        LAS f32x4* info = (LAS f32x4*)(red + 1536);
        const int rl = wc * 64 + fq * 16 + fr;
        unsigned long long s0 = 0;
        if (wr == 0) s0 = stats[(size_t)(u.pm * BM + rl) * 4];
        float g[8];
#pragma unroll
        for (int j = 0; j < 8; ++j) g[j] = gqn[32 * (wc < 3 ? wc : 0) + 8 * fq + j];
        if (wc < 3) {
#pragma unroll
            for (int ai = 0; ai < 2; ++ai)
#pragma unroll
                for (int bj = 0; bj < 2; ++bj)
#pragma unroll
                    for (int m = 0; m < 4; ++m) { const f32x4 p = acc[ai][bj][m][0] * acc[ai][bj][m][0] + acc[ai][bj][m][1] * acc[ai][bj][m][1];
                        float sq = (p[0] + p[1]) + (p[2] + p[3]); sq = sum_x32(sum_x16(sq));
                        if (fq == 0) red[((wr * 4 + ai * 2 + bj) * 3 + wc) * 64 + m * 16 + fr] = sq; }
        }
        asm volatile("s_waitcnt lgkmcnt(0)" ::: "memory"); __builtin_amdgcn_s_barrier(); asm volatile("" ::: "memory");
        if (wr == 0) {
            const float r = 1.0f / sqrtf((float)s0 * (1.0f / (1048576.0f * 768.0f)) + NORM_EPS);
            const int ri = ((((rl >> 6) & 1) * 4 + (rl >> 7) * 2) * 3) * 64 + (rl & 63);
            const float ss0 = red[ri] + red[ri + 64] + red[ri + 128], ss1 = red[ri + 192] + red[ri + 256] + red[ri + 320];
            info[rl] = (f32x4){r * QSCALE / sqrtf(ss0 * r * r * (1.0f / 96.0f) + NORM_EPS), r * QSCALE / sqrtf(ss1 * r * r * (1.0f / 96.0f) + NORM_EPS), 0.f, 0.f};
        }
        asm volatile("s_waitcnt lgkmcnt(0)" ::: "memory"); __builtin_amdgcn_s_barrier(); asm volatile("" ::: "memory");
        if (wc < 3) {
            const float sgn = (fq & 1) ? 1.0f : -1.0f;
#pragma unroll
            for (int ai = 0; ai < 2; ++ai)
#pragma unroll
                for (int m = 0; m < 4; ++m) { const f32x4 inf = info[ai * HALF + wr * 64 + m * 16 + fr]; const int tk = tq * 4 + 2 * ai + wr;
                    bf16_t* qp = Q + (size_t)(row0 + ai * HALF + m * 16) * 768 + 96 * (2 * u.pn) + 32 * wc + 8 * fq;
#pragma unroll
                    for (int bj = 0; bj < 2; ++bj) { const float sc = inf[bj];
                        f32x4 v0, v1;
#pragma unroll
                        for (int i = 0; i < 4; ++i) { v0[i] = acc[ai][bj][m][0][i] * sc * g[i]; v1[i] = acc[ai][bj][m][1][i] * sc * g[4 + i]; }
                        if (wc == 2 && tq > 0) { const LAS f32x4* tp = (const LAS f32x4*)(red + 2560) + ((fq >> 1) == 0 ? (tk - 4) : (16 * m + fr)) * 4;
                            const f32x4 c0 = tp[0], c1 = tp[1], c2 = tp[2], c3 = tp[3];
                            f32x4 p0, p1;
#pragma unroll
                            for (int i = 0; i < 4; ++i) { p0[i] = __shfl_xor(v0[i], 16); p1[i] = __shfl_xor(v1[i], 16); }
                            v0[0] = v0[0] * c0[0] + sgn * p0[0] * c0[1]; v0[1] = v0[1] * c0[2] + sgn * p0[1] * c0[3]; v0[2] = v0[2] * c1[0] + sgn * p0[2] * c1[1]; v0[3] = v0[3] * c1[2] + sgn * p0[3] * c1[3];
                            v1[0] = v1[0] * c2[0] + sgn * p1[0] * c2[1]; v1[1] = v1[1] * c2[2] + sgn * p1[1] * c2[3]; v1[2] = v1[2] * c3[0] + sgn * p1[2] * c3[1]; v1[3] = v1[3] * c3[2] + sgn * p1[3] * c3[3]; }
                        *(u32x4*)(qp + 96 * bj) = pack8(v0, v1); } }
        }
        asm volatile("" :: "v"(g[0]), "v"(g[1]), "v"(g[2]), "v"(g[3]), "v"(g[4]), "v"(g[5]), "v"(g[6]), "v"(g[7]));
    }
};
struct EpiKV {
    static constexpr bool PERM = true, KEEP_ACC = false;
    bf16_t* Kt; bf16_t* Vt; const bf16_t* KR; const float* gkn; const unsigned long long* stats; LAS float* red;
    __device__ __forceinline__ void operator()(Acc& acc, const Unit& u, int wr, int wc, int fr, int fq) const {
        asm volatile("" : "+v"(fr), "+v"(fq));
        const int b = u.pm / 9, tq = u.pm - b * 9, row0 = u.pm * BM + wr * 64 + fr;
        const bool kw = wc < 2;
        LAS f32x4* info = (LAS f32x4*)(red + 1536);
        const int rl = wc * 64 + fq * 16 + fr;
        unsigned long long s1 = 0, s2 = 0;
        if (wr == 0) { s1 = stats[(size_t)(u.pm * BM + rl) * 4 + 1]; s2 = stats[(size_t)(u.pm * BM + rl) * 4 + 2]; }
        u32x4 krw[2][4];
#pragma unroll
        for (int ai = 0; ai < 2; ++ai)
#pragma unroll
            for (int m = 0; m < 4; ++m) { krw[ai][m] = (u32x4){0u, 0u, 0u, 0u}; if (!kw) krw[ai][m] = *(const u32x4*)(KR + (size_t)(row0 + ai * HALF + m * 16) * 32 + 8 * fq); }
        float gk[8], gp[8];
#pragma unroll
        for (int j = 0; j < 8; ++j) { gk[j] = gkn[(kw ? 32 * wc : 64) + 8 * fq + j]; gp[j] = gkn[64 + 8 * (fq ^ 1) + j]; }
        if (kw) {
#pragma unroll
            for (int ai = 0; ai < 2; ++ai)
#pragma unroll
                for (int bj = 0; bj < 2; ++bj)
#pragma unroll
                    for (int m = 0; m < 4; ++m) { const f32x4 p = acc[ai][bj][m][0] * acc[ai][bj][m][0] + acc[ai][bj][m][1] * acc[ai][bj][m][1];
                        float sq = (p[0] + p[1]) + (p[2] + p[3]); sq = sum_x32(sum_x16(sq));
                        if (fq == 0) red[((wr * 4 + ai * 2 + bj) * 2 + wc) * 64 + m * 16 + fr] = sq; }
        }
        asm volatile("s_waitcnt lgkmcnt(0)" ::: "memory"); __builtin_amdgcn_s_barrier(); asm volatile("" ::: "memory");
        if (wr == 0) {
            const float r = 1.0f / sqrtf((float)s1 * (1.0f / (1048576.0f * 256.0f)) + NORM_EPS), krss = (float)s2 * (1.0f / 1048576.0f);
            const int ri = ((((rl >> 6) & 1) * 4 + (rl >> 7) * 2) * 2) * 64 + (rl & 63);
            const float ss0 = red[ri] + red[ri + 64], ss1 = red[ri + 128] + red[ri + 192];
            info[rl] = (f32x4){r, 1.0f / sqrtf((ss0 * r * r + krss) * (1.0f / 96.0f) + NORM_EPS), 1.0f / sqrtf((ss1 * r * r + krss) * (1.0f / 96.0f) + NORM_EPS), 0.f};
        }
        asm volatile("s_waitcnt lgkmcnt(0)" ::: "memory"); __builtin_amdgcn_s_barrier(); asm volatile("" ::: "memory");
        if (kw) {
#pragma unroll
            for (int ai = 0; ai < 2; ++ai)
#pragma unroll
                for (int m = 0; m < 4; ++m) { const f32x4 inf = info[ai * HALF + wr * 64 + m * 16 + fr];
#pragma unroll
                    for (int bj = 0; bj < 2; ++bj) { const float sc = inf[0] * inf[1 + bj];
                        f32x4 v0, v1;
#pragma unroll
                        for (int i = 0; i < 4; ++i) { v0[i] = acc[ai][bj][m][0][i] * sc * gk[i]; v1[i] = acc[ai][bj][m][1][i] * sc * gk[4 + i]; }
                        *(u32x4*)(Kt + ((size_t)((b * 8 + 2 * u.pn + bj) * 36 + tq * 4 + 2 * ai + wr) * 12 + 4 * wc + fq) * 512 + (16 * m + fr) * 8) = pack8(v0, v1); } }
        } else {
            const int dh = wc - 2;
            const float sgn = (fq & 1) ? 1.0f : -1.0f;
#pragma unroll
            for (int ai = 0; ai < 2; ++ai)
#pragma unroll
                for (int m = 0; m < 4; ++m) { const int tk = tq * 4 + 2 * ai + wr; const float r = info[ai * HALF + wr * 64 + m * 16 + fr][0];
#pragma unroll
                    for (int bj = 0; bj < 2; ++bj)
                        *(u32x4*)(Vt + ((size_t)(((((b * 8 + 2 * u.pn + bj) * 36 + tk) * 2 + dh) * 4 + m) * 16 + fr)) * 32 + fq * 8) = pack8(acc[ai][bj][m][0] * r, acc[ai][bj][m][1] * r); }
            __builtin_amdgcn_sched_barrier(0);
#pragma unroll
            for (int ai = 0; ai < 2; ++ai)
#pragma unroll
                for (int m = 0; m < 4; ++m) { const int tk = tq * 4 + 2 * ai + wr; const f32x4 inf = info[ai * HALF + wr * 64 + m * 16 + fr]; const float n = dh ? inf[2] : inf[1];
                    const u32x4 wo = krw[ai][m]; u32x4 wp;
                    wp.x = (unsigned)__shfl_xor((int)wo.x, 16); wp.y = (unsigned)__shfl_xor((int)wo.y, 16); wp.z = (unsigned)__shfl_xor((int)wo.z, 16); wp.w = (unsigned)__shfl_xor((int)wo.w, 16);
                    f32x4 x0, x1, p0, p1; unpack8(wo, x0, x1); unpack8(wp, p0, p1);
                    f32x4 o0, o1;
                    if (tq > 0) { const LAS f32x4* tp = (const LAS f32x4*)(red + 2560) + ((fq >> 1) == 0 ? (tk - 4) : (16 * m + fr)) * 4;
                        const f32x4 c0 = tp[0], c1 = tp[1], c2 = tp[2], c3 = tp[3];
#define EKV_ROT(o, i, xo, xp, j, cc, sv) o[i] = (xo) * n * gk[j] * (cc) + sgn * ((xp) * n * gp[j]) * (sv);
                        EKV_ROT(o0, 0, x0[0], p0[0], 0, c0[0], c0[1]) EKV_ROT(o0, 1, x0[1], p0[1], 1, c0[2], c0[3]) EKV_ROT(o0, 2, x0[2], p0[2], 2, c1[0], c1[1]) EKV_ROT(o0, 3, x0[3], p0[3], 3, c1[2], c1[3])
                        EKV_ROT(o1, 0, x1[0], p1[0], 4, c2[0], c2[1]) EKV_ROT(o1, 1, x1[1], p1[1], 5, c2[2], c2[3]) EKV_ROT(o1, 2, x1[2], p1[2], 6, c3[0], c3[1]) EKV_ROT(o1, 3, x1[3], p1[3], 7, c3[2], c3[3])
#undef EKV_ROT
                    } else {
#pragma unroll
                        for (int i = 0; i < 4; ++i) { o0[i] = x0[i] * n * gk[i]; o1[i] = x1[i] * n * gk[4 + i]; }
                    }
                    *(u32x4*)(Kt + ((size_t)((b * 8 + 2 * u.pn + dh) * 36 + tk) * 12 + 8 + fq) * 512 + (16 * m + fr) * 8) = pack8(o0, o1);
                    __builtin_amdgcn_sched_barrier(0); }
        }
        asm volatile("" :: "v"(gk[0]), "v"(gk[1]), "v"(gk[2]), "v"(gk[3]), "v"(gk[4]), "v"(gk[5]), "v"(gk[6]), "v"(gk[7]));
        asm volatile("" :: "v"(gp[0]), "v"(gp[1]), "v"(gp[2]), "v"(gp[3]), "v"(gp[4]), "v"(gp[5]), "v"(gp[6]), "v"(gp[7]));
    }
};
struct EpiSwiGLU {
    static constexpr bool PERM = true, KEEP_ACC = false;
    bf16_t* O; int ldc;
    __device__ __forceinline__ void operator()(Acc& acc, const Unit& u, int wr, int wc, int fr, int fq) const {
        const int cbase = u.pn * HALF + wc * 32;
#pragma unroll
        for (int ai = 0; ai < 2; ++ai)
#pragma unroll
            for (int m = 0; m < 4; ++m) { bf16_t* rowp = O + tiled_a_off(u.pm, ldc, ai, wr, m, fr, fq, cbase);
                f32x4 v0, v1;
#pragma unroll
                for (int i = 0; i < 4; ++i) { v0[i] = siluf_(acc[ai][0][m][0][i]) * acc[ai][1][m][0][i]; v1[i] = siluf_(acc[ai][0][m][1][i]) * acc[ai][1][m][1][i]; }
                *(u32x4*)rowp = pack8(v0, v1); }
    }
};
struct EpiWin {
    static constexpr bool PERM = true, KEEP_ACC = false;
    bf16_t *U, *ZQ, *ZKV, *ZR, *G, *KR; const float* bgate; unsigned long long* stats;
    __device__ __forceinline__ void operator()(Acc& acc, const Unit& u, int wr, int wc, int fr, int fq) const {
        const int row0 = u.pm * BM + wr * 64 + fr, cl = wc * 32 + 8 * fq, pn = u.pn;
        if (pn < 4) {
#pragma unroll
            for (int ai = 0; ai < 2; ++ai)
#pragma unroll
                for (int m = 0; m < 4; ++m) { bf16_t* rowp = U + (size_t)(row0 + ai * HALF + m * 16) * 512 + pn * HALF + cl;
                    f32x4 v0, v1;
#pragma unroll
                    for (int i = 0; i < 4; ++i) { v0[i] = acc[ai][0][m][0][i] * sigmoidf_(acc[ai][1][m][0][i]); v1[i] = acc[ai][0][m][1][i] * sigmoidf_(acc[ai][1][m][1][i]); }
                    *(u32x4*)rowp = pack8(v0, v1); }
        } else if (pn == 24) {
            if (wc == 0) {
#pragma unroll
                for (int ai = 0; ai < 2; ++ai)
#pragma unroll
                    for (int m = 0; m < 4; ++m) { const int row = row0 + ai * HALF + m * 16;
                        *(u32x4*)(KR + (size_t)row * 32 + 8 * fq) = pack8(acc[ai][0][m][0], acc[ai][0][m][1]);
                        const f32x4 s4 = acc[ai][0][m][0] * acc[ai][0][m][0] + acc[ai][0][m][1] * acc[ai][0][m][1];
                        float sq = (s4[0] + s4[1]) + (s4[2] + s4[3]); sq = sum_x32(sum_x16(sq));
                        if (fq == 0) (void)__hip_atomic_fetch_add(stats + (size_t)row * 4 + 2, (unsigned long long)(sq * 1048576.0f), __ATOMIC_RELAXED, __HIP_MEMORY_SCOPE_AGENT); }
            }
        } else if (pn >= 12) {
            const int cb = (pn - 12) * BM;
            unsigned char* gq = (unsigned char*)G + ((((size_t)(u.pm * 12 + (pn - 12)) * 8 + (wr * 4 + wc)) * 8) * 64 + (fq * 16 + fr)) * 16;
            f32x4 bv[2][2];
#pragma unroll
            for (int bj = 0; bj < 2; ++bj)
#pragma unroll
                for (int n = 0; n < 2; ++n) bv[bj][n] = *(const f32x4*)(bgate + cb + bj * HALF + cl + 4 * n) * -1.4426950408889634f;
#pragma unroll
            for (int ai = 0; ai < 2; ++ai)
#pragma unroll
                for (int m = 0; m < 4; ++m) { unsigned w[4] = {0u, 0u, 0u, 0u};
#pragma unroll
                    for (int bj = 0; bj < 2; ++bj)
#pragma unroll
                        for (int n = 0; n < 2; ++n)
#pragma unroll
                            for (int i = 0; i < 4; i += 2) {
                                const f32x2 a2 = (f32x2){acc[ai][bj][m][n][i], acc[ai][bj][m][n][i + 1]}, b2 = (f32x2){bv[bj][n][i], bv[bj][n][i + 1]};
                                const f32x2 t = __builtin_elementwise_fma(a2, (f32x2){-1.4426950408889634f, -1.4426950408889634f}, b2);
                                f32x2 e; e.x = fast_exp2(t.x); e.y = fast_exp2(t.y); e = e + 1.0f;
                                f32x2 r; r.x = fast_rcp(e.x); r.y = fast_rcp(e.y);
                                const f32x2 q = __builtin_elementwise_fma(r, (f32x2){254.0f, 254.0f}, (f32x2){1.0f, 1.0f});
                                w[bj * 2 + n] = __builtin_amdgcn_cvt_pk_u8_f32(q.x, i, w[bj * 2 + n]); w[bj * 2 + n] = __builtin_amdgcn_cvt_pk_u8_f32(q.y, i + 1, w[bj * 2 + n]); }
                    *(u32x4*)(gq + (size_t)((ai * 4 + m) * 64) * 16) = (u32x4){w[0], w[1], w[2], w[3]}; }
        } else {
            bf16_t* base; int ldc, cb, act = 0;
            if (pn < 7) { base = ZQ; ldc = 768; cb = (pn - 4) * BM; }
            else if (pn == 7) { base = ZKV; ldc = 256; cb = 0; }
            else { base = ZR; ldc = 1024; cb = (pn - 8) * BM; act = (pn >= 10) ? 1 : 0; }
#pragma unroll
            for (int ai = 0; ai < 2; ++ai)
#pragma unroll
                for (int m = 0; m < 4; ++m) { bf16_t* rowp = base + (size_t)(row0 + ai * HALF + m * 16) * ldc + cb + cl;
#pragma unroll
                    for (int bj = 0; bj < 2; ++bj) { f32x4 v0 = acc[ai][bj][m][0], v1 = acc[ai][bj][m][1];
                        if (act == 1) {
#pragma unroll
                            for (int i = 0; i < 4; ++i) { v0[i] = gelu_tanh_(v0[i]); v1[i] = gelu_tanh_(v1[i]); } }
                        *(u32x4*)(rowp + bj * HALF) = pack8(v0, v1); }
                    if (pn < 8) {
                        const f32x4 s4 = (acc[ai][0][m][0] * acc[ai][0][m][0] + acc[ai][0][m][1] * acc[ai][0][m][1]) + (acc[ai][1][m][0] * acc[ai][1][m][0] + acc[ai][1][m][1] * acc[ai][1][m][1]);
                        float sq = (s4[0] + s4[1]) + (s4[2] + s4[3]); sq = sum_x32(sum_x16(sq));
                        if (fq == 0) (void)__hip_atomic_fetch_add(stats + (size_t)(row0 + ai * HALF + m * 16) * 4 + (pn == 7 ? 1 : 0), (unsigned long long)(sq * 1048576.0f), __ATOMIC_RELAXED, __HIP_MEMORY_SCOPE_AGENT); } }
        }
    }
};
struct EpiMerge {
    static constexpr bool PERM = true, KEEP_ACC = true;
    const bf16_t* G; bf16_t* M;
    __device__ __forceinline__ static void codes(unsigned w, f32x4& v) { v[0] = (float)(w & 0xffu); v[1] = (float)((w >> 8) & 0xffu); v[2] = (float)((w >> 16) & 0xffu); v[3] = (float)(w >> 24); }
    __device__ __forceinline__ void operator()(Acc& acc, const Unit& u, int wr, int wc, int fr, int fq) const {
        const int seg = u.tag;
        const unsigned char* gbase = (const unsigned char*)G + ((((size_t)(u.pm * 12 + seg * 4 + u.pn) * 8 + (wr * 4 + wc)) * 8) * 64 + (fq * 16 + fr)) * 16;
        const size_t nxt = (seg < 2) ? (size_t)4 * 8 * 8 * 64 * 16 : 0;
#pragma unroll
        for (int ai = 0; ai < 2; ++ai)
#pragma unroll
            for (int mh = 0; mh < 2; ++mh) {
                u32x4 ga[2], gb[2];
#pragma unroll
                for (int mm = 0; mm < 2; ++mm) { const unsigned char* gp = gbase + (size_t)((ai * 4 + 2 * mh + mm) * 64) * 16; ga[mm] = *(const u32x4*)gp; gb[mm] = *(const u32x4*)(gp + nxt); }
                asm volatile("" ::: "memory");
#pragma unroll
                for (int mm = 0; mm < 2; ++mm) { const int m = 2 * mh + mm;
#pragma unroll
                    for (int bj = 0; bj < 2; ++bj) { f32x4 a0, a1; codes(ga[mm][2 * bj], a0); codes(ga[mm][2 * bj + 1], a1);
                        if (seg < 2) { f32x4 b0, b1; codes(gb[mm][2 * bj], b0); codes(gb[mm][2 * bj + 1], b1);
#pragma unroll
                            for (int i = 0; i < 4; ++i) { acc[ai][bj][m][0][i] *= a0[i] * fast_rcp(b0[i]); acc[ai][bj][m][1][i] *= a1[i] * fast_rcp(b1[i]); }
                        } else {
                            *(u32x4*)(M + tiled_a_off(u.pm, 1024, ai, wr, m, fr, fq, u.pn * BM + bj * HALF + wc * 32)) = pack8(acc[ai][bj][m][0] * (a0 * (1.0f / 255.0f)), acc[ai][bj][m][1] * (a1 * (1.0f / 255.0f)));
                            acc[ai][bj][m][0] = (f32x4){0.f, 0.f, 0.f, 0.f}; acc[ai][bj][m][1] = (f32x4){0.f, 0.f, 0.f, 0.f};
                        } } }
                asm volatile("" ::: "memory"); }
    }
};
struct EpiResid {
    static constexpr bool PERM = true, KEEP_ACC = false;
    bf16_t* X; const float* mod; int gsel;
    __device__ __forceinline__ void operator()(Acc& acc, const Unit& u, int wr, int wc, int fr, int fq) const {
        const int b = u.pm / 9, j = u.pm - b * 9, mi = (j == 0) ? 16 : b;
        const float* ga = mod + (size_t)mi * 6144 + gsel * 1024;
        const int col0 = u.pn * BM + wc * 32 + 8 * fq;
        bf16_t* xb = X + (size_t)(u.pm * BM + wr * 64 + fr) * DM + col0;
        f32x4 gv[2][2];
#pragma unroll
        for (int bj = 0; bj < 2; ++bj)
#pragma unroll
            for (int n = 0; n < 2; ++n) gv[bj][n] = *(const f32x4*)(ga + col0 + bj * HALF + 4 * n);
#pragma unroll
        for (int ai = 0; ai < 2; ++ai)
#pragma unroll
            for (int mh = 0; mh < 2; ++mh) {
                u32x4 xw[2][2];
#pragma unroll
                for (int mm = 0; mm < 2; ++mm)
#pragma unroll
                    for (int bj = 0; bj < 2; ++bj) xw[mm][bj] = *(const u32x4*)(xb + (size_t)(ai * HALF + (2 * mh + mm) * 16) * DM + bj * HALF);
                asm volatile("" ::: "memory");
#pragma unroll
                for (int mm = 0; mm < 2; ++mm) { const int m = 2 * mh + mm;
#pragma unroll
                    for (int bj = 0; bj < 2; ++bj) { f32x4 x0, x1; unpack8(xw[mm][bj], x0, x1);
                        *(u32x4*)(xb + (size_t)(ai * HALF + m * 16) * DM + bj * HALF) = pack8(x0 + gv[bj][0] * acc[ai][bj][m][0], x1 + gv[bj][1] * acc[ai][bj][m][1]); } }
                asm volatile("" ::: "memory"); }
    }
};
}

struct Args {
    const float* in[38];
    float* out; unsigned char* ws;
    int ph_lo, ph_hi;
};
enum InIdx { I_X = 0, I_C, I_CTX, I_CCTX, I_WADA, I_BADA, I_GN1, I_GN2, I_WIN, I_BGATE, I_CONVW, I_CONVB, I_CLNG, I_CLNB, I_WOCONV, I_GQA, I_WQB, I_GKVA, I_WKVB, I_GQN, I_GKN, I_WOMLA,
             I_RCW, I_RCB, I_WRA, I_BRA, I_WRI, I_BRI, I_LAM, I_WOREC, I_WOUT, I_WFG, I_WFU, I_WFD, I_WROUTER, I_WEG, I_WEU, I_WED };

struct Frame {
    LAS unsigned char* lds;
    int tid, lane, wave, G, bid;
    unsigned char* ws;
};

__device__ __forceinline__ void tr_tile(const float* src, int ld_src, int col0, int nvalid, int k0, const float* kscale, bf16_t* dst, int Ktot, int n0, int kd0, LAS float* scr, int lane) {
    const int c4 = (lane & 15) * 4, rsub = lane >> 4;
#pragma unroll 4
    for (int i = 0; i < 16; ++i) { const int kk = 4 * i + rsub;
        f32x4 v = (f32x4){0.f, 0.f, 0.f, 0.f};
        if (c4 < nvalid) v = *(const f32x4*)(src + (size_t)(k0 + kk) * ld_src + col0 + c4);
        if (kscale) v = v * kscale[k0 + kk];
        scr[kk * 65 + c4] = v[0]; scr[kk * 65 + c4 + 1] = v[1]; scr[kk * 65 + c4 + 2] = v[2]; scr[kk * 65 + c4 + 3] = v[3]; }
    LDS_WAIT(); asm volatile("" ::: "memory");
    const int c = lane & 7;
    bf16_t* tbase = dst + ((size_t)((n0 >> 8) * (Ktot >> 6) + (kd0 >> 6)) * 2 + ((n0 >> 7) & 1)) * 8192;
    float tv[8][8];
#pragma unroll
    for (int j = 0; j < 8; ++j) { const LAS float* s = scr + (8 * c) * 65 + (lane >> 3) + 8 * j;
#pragma unroll
        for (int q = 0; q < 8; ++q) tv[j][q] = s[q * 65]; }
    __builtin_amdgcn_sched_barrier(0);
#pragma unroll
    for (int j = 0; j < 8; ++j) { const int n = (lane >> 3) + 8 * j;
        u32x4 o; o.x = cvt_pk_bf16(tv[j][0], tv[j][1]); o.y = cvt_pk_bf16(tv[j][2], tv[j][3]); o.z = cvt_pk_bf16(tv[j][4], tv[j][5]); o.w = cvt_pk_bf16(tv[j][6], tv[j][7]);
        const int nh = (n0 & 64) + n, v32 = nh & 31, rho = (nh & ~31) + (((v32 >> 2) & 1) << 4) + ((v32 >> 3) << 2) + (v32 & 3);
        *(u32x4*)(tbase + (pg8::lds_byte(rho, 8 * c) >> 1)) = o; }
    LDS_WAIT(); asm volatile("" ::: "memory");
}
__device__ __forceinline__ void tr_plain(int item, const float* src, int K, int N, const float* kscale, bf16_t* dst, int ld_dst, int dk0, LAS float* scr, int lane) {
    const int nnb = N / 64, kb = item / nnb, nb = item - kb * nnb;
    tr_tile(src, N, nb * 64, 64, kb * 64, kscale, dst, ld_dst, nb * 64, dk0 + kb * 64, scr, lane);
}
__device__ __forceinline__ void tr_gu(int item, const float* wg, const float* wu, bf16_t* dst, LAS float* scr, int lane) {
    const int kb = item / 112, nb = item - kb * 112;
    const int tile = nb >> 2, sub = nb & 3;
    const float* src = (sub < 2) ? wg : wu; const int col = tile * 128 + (sub & 1) * 64;
    tr_tile(src, DFF, col, 64, kb * 64, nullptr, dst, 1024, nb * 64, kb * 64, scr, lane);
}
__device__ __forceinline__ void tr_win(int item, const float* w, bf16_t* dst, LAS float* scr, int lane) {
    const int kb = item / 96, nb = item - kb * 96;
    int col, nv = 64; const int row = nb * 64;
    if (nb < 16) { const int tile = nb >> 2, sub = nb & 3; col = (sub < 2 ? 0 : 512) + tile * 128 + (sub & 1) * 64; }
    else if (nb < 32) col = 1024 + (row - 1024);
    else if (nb < 48) col = 2080 + (row - 2048);
    else col = 3104 + (row - 3072);
    tr_tile(w, IN_COLS, col, nv, kb * 64, nullptr, dst, 1024, row, kb * 64, scr, lane);
}
__device__ __forceinline__ void rec_frag_item(int item, const float* wra, const float* wri, bf16_t* dst, int lane) {
    const int s = item & 3, cb = (item >> 2) & 1, g = (item >> 3) & 7, gate = (item >> 6) & 1, d = (item >> 7) & 1;
    const float* w = (gate ? wri : wra) + ((size_t)(d * 8 + g)) * 4096;
    const int r = lane & 31, h = lane >> 5;
    float v[8];
#pragma unroll
    for (int jj = 0; jj < 8; ++jj) v[jj] = w[(16 * s + 8 * h + jj) * 64 + 32 * cb + r];
    u32x4 o; o.x = cvt_pk_bf16(v[0], v[1]); o.y = cvt_pk_bf16(v[2], v[3]); o.z = cvt_pk_bf16(v[4], v[5]); o.w = cvt_pk_bf16(v[6], v[7]);
    *(u32x4*)(dst + ((size_t)item * 64 + lane) * 8) = o;
}

__device__ __forceinline__ void krope_frag_item(int s, const float* w, bf16_t* dst, int lane) {
    const int r = lane & 31, h = lane >> 5;
    float v[8];
#pragma unroll
    for (int jj = 0; jj < 8; ++jj) v[jj] = w[(size_t)(16 * s + 8 * h + jj) * IN_COLS + 2048 + r];
    u32x4 o; o.x = cvt_pk_bf16(v[0], v[1]); o.y = cvt_pk_bf16(v[2], v[3]); o.z = cvt_pk_bf16(v[4], v[5]); o.w = cvt_pk_bf16(v[6], v[7]);
    *(u32x4*)(dst + ((size_t)s * 64 + lane) * 8) = o;
}
constexpr int CC_PER_LAYER = 96 * 16 + 3 * 16 * 8 + 12 * 16 + 16 * 4 + 16 * 16 + 256 + 64, CC_PER_FF = 112 * 16 + 16 * 56, CC_NITEMS = DEPTH * CC_PER_LAYER + 2 * CC_PER_FF;
__device__ __forceinline__ void convert_common(const Args& a, const Frame& F, int it_lo, int it_hi, int wg_i, int n_wg) {
    if (wg_i < 0) return;
    LAS float* scr = (LAS float*)(F.lds + F.wave * 16640);
    const int gw = wg_i * NWAVES + F.wave, NGW = n_wg * NWAVES;
    constexpr int I_WIN_N = 96 * 16, I_CAT = 16 * 8, I_QB = 12 * 16, I_KVB = 16 * 4, I_OUT = 16 * 16, I_REC = 256, I_KR = 64;
    constexpr int PER_LAYER = I_WIN_N + 3 * I_CAT + I_QB + I_KVB + I_OUT + I_REC + I_KR;
    constexpr int I_GU = 112 * 16, I_D = 16 * 56, PER_FF = I_GU + I_D;
    static_assert(PER_LAYER == CC_PER_LAYER && PER_FF == CC_PER_FF, "conversion item counts");
    for (int it = it_lo + gw; it < it_hi; it += NGW) {
        if (it < DEPTH * PER_LAYER) {
            const int l = it / PER_LAYER; int r = it - l * PER_LAYER;
            if (r < I_WIN_N) { tr_win(r, a.in[I_WIN] + (size_t)l * DM * IN_COLS, (bf16_t*)(a.ws + WS_WIN) + (size_t)l * NWIN * DM, scr, F.lane); continue; } r -= I_WIN_N;
            if (r < 3 * I_CAT) { const int which = r / I_CAT; r -= which * I_CAT;
                const float* src = a.in[which == 0 ? I_WOCONV : (which == 1 ? I_WOMLA : I_WOREC)] + (size_t)l * 512 * 1024;
                tr_plain(r, src, 512, 1024, nullptr, (bf16_t*)(a.ws + WS_WCAT) + (size_t)l * 1024 * 1536, 1536, which * 512, scr, F.lane); continue; } r -= 3 * I_CAT;
            if (r < I_QB) { const int kb = r >> 4, nb = r & 15, hh = nb >> 1, sub = nb & 1;
                tr_tile(a.in[I_WQB] + (size_t)l * 768 * 768, 768, 96 * hh + 64 * sub, sub ? 32 : 64, kb * 64, a.in[I_GQA] + l * 768, (bf16_t*)(a.ws + WS_WQB) + (size_t)l * 1024 * 768, 768, nb * 64, kb * 64, scr, F.lane); continue; } r -= I_QB;
            if (r < I_KVB) { tr_plain(r, a.in[I_WKVB] + (size_t)l * 256 * 1024, 256, 1024, a.in[I_GKVA] + l * 256, (bf16_t*)(a.ws + WS_WKVB) + (size_t)l * 1024 * 256, 256, 0, scr, F.lane); continue; } r -= I_KVB;
            if (r < I_OUT) { tr_plain(r, a.in[I_WOUT] + (size_t)l * 1024 * 1024, 1024, 1024, nullptr, (bf16_t*)(a.ws + WS_WOUT) + (size_t)l * 1024 * 1024, 1024, 0, scr, F.lane); continue; } r -= I_OUT;
            if (r < I_REC) { rec_frag_item(r, a.in[I_WRA] + (size_t)l * 2 * 8 * 4096, a.in[I_WRI] + (size_t)l * 2 * 8 * 4096, (bf16_t*)(a.ws + WS_WREC) + (size_t)l * 256 * 512, F.lane); continue; } r -= I_REC;
            krope_frag_item(r, a.in[I_WIN] + (size_t)l * DM * IN_COLS, (bf16_t*)(a.ws + WS_WKR) + (size_t)l * 64 * 512, F.lane);
        } else {
            int r = it - DEPTH * PER_LAYER; const int j = r / PER_FF; r -= j * PER_FF;
            if (r < I_GU) tr_gu(r, a.in[I_WFG] + (size_t)j * DM * DFF, a.in[I_WFU] + (size_t)j * DM * DFF, (bf16_t*)(a.ws + WS_WFFGU) + (size_t)j * 7168 * 1024, scr, F.lane);
            else tr_plain(r - I_GU, a.in[I_WFD] + (size_t)j * DFF * DM, DFF, DM, nullptr, (bf16_t*)(a.ws + WS_WFFD) + (size_t)j * 1024 * DFF, DFF, 0, scr, F.lane);
        }
    }
}
constexpr int MOE_CVT_ITEMS = NEXP * (112 * 16 + 16 * 56), CVT_SPLIT1 = 6200, CVT_SPLIT2 = 10700;
__device__ __forceinline__ void convert_moe(const Args& a, const Frame& F, int j, int it_lo, int it_hi, int wg_i, int n_wg) {
    if (wg_i < 0) return;
    LAS float* scr = (LAS float*)(F.lds + F.wave * 16640);
    const int gw = wg_i * NWAVES + F.wave, NGW = n_wg * NWAVES;
    constexpr int I_GU = 112 * 16, I_D = 16 * 56, PER_E = I_GU + I_D;
    for (int it = it_lo + gw; it < it_hi; it += NGW) {
        const int e = it / PER_E; const int r = it - e * PER_E;
        const size_t eo = ((size_t)j * NEXP + e) * DM * DFF;
        if (r < I_GU) tr_gu(r, a.in[I_WEG] + eo, a.in[I_WEU] + eo, (bf16_t*)(a.ws + WS_WEGU) + (size_t)e * 7168 * 1024, scr, F.lane);
        else tr_plain(r - I_GU, a.in[I_WED] + eo, DFF, DM, nullptr, (bf16_t*)(a.ws + WS_WED) + (size_t)e * 1024 * DFF, DFF, 0, scr, F.lane);
    }
}
__device__ __forceinline__ void mod_job(const Args& a, const Frame& F) {
    LAS float* sc = (LAS float*)F.lds;
    LAS float* red = (LAS float*)(F.lds + 17 * 1024 * 4);
    for (int i = F.tid; i < NMOD * 1024; i += NTHREADS) { const int v = i >> 10, k = i & 1023; const float x = (v < 16) ? a.in[I_C][v * 1024 + k] : a.in[I_CCTX][k]; sc[i] = siluf_(x); }
    __syncthreads();
    float* MOD = (float*)(a.ws + WS_MOD);
    const int cl = F.lane & 31, kh = F.lane >> 5;
    for (int item = F.bid; item < DEPTH * 192; item += F.G) {
        const int l = item / 192, nb = item - l * 192;
        const float* w = a.in[I_WADA] + (size_t)l * 1024 * 6144 + nb * 32 + cl;
        float acc[NMOD];
#pragma unroll
        for (int v = 0; v < NMOD; ++v) acc[v] = 0.f;
        const int k0 = F.wave * 128 + kh * 64;
#pragma unroll 1
        for (int kk = 0; kk < 64; kk += 16) {
            float wv[16];
#pragma unroll
            for (int j = 0; j < 16; ++j) wv[j] = w[(size_t)(k0 + kk + j) * 6144];
#pragma unroll
            for (int j = 0; j < 16; ++j)
#pragma unroll
                for (int v = 0; v < NMOD; ++v) acc[v] += sc[v * 1024 + k0 + kk + j] * wv[j];
        }
#pragma unroll
        for (int v = 0; v < NMOD; ++v) acc[v] = sum_x32(acc[v]);
        if (kh == 0) {
#pragma unroll
            for (int v = 0; v < NMOD; ++v) red[(F.wave * NMOD + v) * 32 + cl] = acc[v]; }
        __syncthreads();
        for (int o = F.tid; o < NMOD * 32; o += NTHREADS) { const int v = o >> 5, c = o & 31; float s = a.in[I_BADA][l * 6144 + nb * 32 + c];
#pragma unroll
            for (int wv = 0; wv < 8; ++wv) s += red[(wv * NMOD + v) * 32 + c];
            MOD[((size_t)l * NMOD + v) * 6144 + nb * 32 + c] = s; }
        __syncthreads();
    }
}

struct NormP {
    const float* xin; const float* cin;
    bf16_t* X; bool from_f32; float* outf;
    const float* gain;
    const float* mod; int shsel;
    bf16_t* H;
    int* inv;
    bool combine; const bf16_t* Y; const i32x2* routeP; const f32x2* routeW; const float* modprev;
    bool do_norm; bool latent_only;
    const float* wrouter; i32x4* routeA; f32x2* routeWout; unsigned* cnt;
};
template <bool ROUTER>
__device__ __forceinline__ void norm_job(const NormP& P, const Frame& F) {
    const int nact = P.latent_only ? NB * SEQ : T;
    const int rpw = nact / F.G;
    LAS int* hist = (LAS int*)(F.lds);
    LAS int* wbase = (LAS int*)(F.lds + 256);
    LAS int* stg = (LAS int*)(F.lds + 512);
    LAS f32x4* lw = (LAS f32x4*)(F.lds + 8192);
    if (ROUTER) { if (F.tid < 64) hist[F.tid] = 0;
#pragma unroll
        for (int k = 0; k < 4; ++k) { const int f4 = F.tid + NTHREADS * k, c = f4 >> 1, h = f4 & 1, j = c >> 8, i = c & 3, ln = (c & 255) >> 2;
            lw[((j * 4 + i) * 2 + h) * 64 + ln] = *(const f32x4*)(P.wrouter + (size_t)f4 * 4); }
        __syncthreads(); }
    const int a_lo = F.bid * rpw, a_hi = (F.bid == F.G - 1) ? nact : a_lo + rpw;
    int cur_mi = -1; f32x4 gs[4], s0v[4];
#pragma unroll
    for (int j = 0; j < 4; ++j) { gs[j] = (f32x4){0.f, 0.f, 0.f, 0.f}; s0v[j] = gs[j]; }
    i32x2 npp = (i32x2){0, 0}; f32x2 nww = (f32x2){0.f, 0.f};
    if (P.combine && a_lo + F.wave < a_hi) { const int ai0 = a_lo + F.wave, row0 = P.latent_only ? (ai0 / SEQ) * LROW + CTXL + (ai0 % SEQ) : ai0; npp = P.routeP[row0]; nww = P.routeW[row0]; }
    for (int ai = a_lo + F.wave; ai < a_hi; ai += NWAVES) {
        const int row = P.latent_only ? (ai / SEQ) * LROW + CTXL + (ai % SEQ) : ai;
        const int b = row / LROW, t = row - b * LROW;
        const bool isctx = t < CTXL; const int mi = isctx ? 16 : b;
        const size_t roff = isctx ? ((size_t)b * CTXL + t) * DM : ((size_t)b * SEQ + (t - CTXL)) * DM;
        bf16_t* xrow = P.X + (size_t)row * DM;
        f32x4 v[4];
        if (P.from_f32) {
            const float* xr = (isctx ? P.cin : P.xin) + roff;
#pragma unroll
            for (int j = 0; j < 4; ++j) { v[j] = *(const f32x4*)(xr + 4 * F.lane + 256 * j);
                u32x2 o; o.x = cvt_pk_bf16(v[j][0], v[j][1]); o.y = cvt_pk_bf16(v[j][2], v[j][3]); *(u32x2*)(xrow + 4 * F.lane + 256 * j) = o; }
        } else {
#pragma unroll
            for (int j = 0; j < 4; ++j) { const u32x2 w = *(const u32x2*)(xrow + 4 * F.lane + 256 * j); v[j] = (f32x4){bflo(w.x), bfhi(w.x), bflo(w.y), bfhi(w.y)}; }
        }
        if (P.combine) {
            const i32x2 pp = npp; const f32x2 ww = nww;
            if (ai + NWAVES < a_hi) { const int ai1 = ai + NWAVES, row1 = P.latent_only ? (ai1 / SEQ) * LROW + CTXL + (ai1 % SEQ) : ai1; npp = P.routeP[row1]; nww = P.routeW[row1]; }
            const float* ga = P.modprev + (size_t)mi * 6144 + 5 * 1024;
#pragma unroll
            for (int j = 0; j < 4; ++j) {
                const u32x2 y0 = *(const u32x2*)(P.Y + (size_t)pp.x * DM + 4 * F.lane + 256 * j), y1 = *(const u32x2*)(P.Y + (size_t)pp.y * DM + 4 * F.lane + 256 * j);
                const f32x4 g = *(const f32x4*)(ga + 4 * F.lane + 256 * j);
                f32x4 f; f[0] = ww.x * bflo(y0.x) + ww.y * bflo(y1.x); f[1] = ww.x * bfhi(y0.x) + ww.y * bfhi(y1.x); f[2] = ww.x * bflo(y0.y) + ww.y * bflo(y1.y); f[3] = ww.x * bfhi(y0.y) + ww.y * bfhi(y1.y);
                v[j] = v[j] + g * f;
                if (P.outf) *(f32x4*)(P.outf + roff + 4 * F.lane + 256 * j) = v[j];
                else { u32x2 o; o.x = cvt_pk_bf16(v[j][0], v[j][1]); o.y = cvt_pk_bf16(v[j][2], v[j][3]); *(u32x2*)(xrow + 4 * F.lane + 256 * j) = o; } }
        }
        if (!P.do_norm) continue;
        float ss = 0.f;
#pragma unroll
        for (int j = 0; j < 4; ++j) ss += (v[j][0] * v[j][0] + v[j][1] * v[j][1]) + (v[j][2] * v[j][2] + v[j][3] * v[j][3]);
        const float rstd = 1.0f / sqrtf(wave_sum(ss) * (1.0f / DM) + NORM_EPS);
        if (mi != cur_mi) {
            cur_mi = mi; const float* sh = P.mod + (size_t)mi * 6144 + P.shsel * 1024; const float* sc = sh + 1024;
#pragma unroll
            for (int j = 0; j < 4; ++j) { const int c = 4 * F.lane + 256 * j; gs[j] = *(const f32x4*)(P.gain + c) * (*(const f32x4*)(sc + c) + 1.0f); s0v[j] = *(const f32x4*)(sh + c); } }
#pragma unroll
        for (int j = 0; j < 4; ++j) { const int c = 4 * F.lane + 256 * j;
            v[j] = (v[j] * rstd) * gs[j] + s0v[j];
            u32x2 o; o.x = cvt_pk_bf16(v[j][0], v[j][1]); o.y = cvt_pk_bf16(v[j][2], v[j][3]);
            *(u32x2*)(P.H + (size_t)row * DM + c) = o; }
        if (ROUTER) {
            float lg[8];
#pragma unroll
            for (int e = 0; e < 8; ++e) lg[e] = 0.f;
#pragma unroll
            for (int j = 0; j < 4; ++j)
#pragma unroll
                for (int i = 0; i < 4; ++i) { const f32x4 w0 = lw[((j * 4 + i) * 2 + 0) * 64 + F.lane], w1 = lw[((j * 4 + i) * 2 + 1) * 64 + F.lane];
                    lg[0] += v[j][i] * w0[0]; lg[1] += v[j][i] * w0[1]; lg[2] += v[j][i] * w0[2]; lg[3] += v[j][i] * w0[3];
                    lg[4] += v[j][i] * w1[0]; lg[5] += v[j][i] * w1[1]; lg[6] += v[j][i] * w1[2]; lg[7] += v[j][i] * w1[3]; }
#pragma unroll
            for (int e = 0; e < 8; ++e) lg[e] = wave_sum(lg[e]);
            int e0 = 0; float v0 = lg[0];
#pragma unroll
            for (int e = 1; e < 8; ++e) if (lg[e] > v0) { v0 = lg[e]; e0 = e; }
            int e1 = -1; float v1 = -3.0e38f;
#pragma unroll
            for (int e = 0; e < 8; ++e) if (e != e0 && lg[e] > v1) { v1 = lg[e]; e1 = e; }
            const float w0 = 1.0f / (1.0f + __expf(v1 - v0)), w1 = 1.0f - w0;
            if (F.lane == 0) { const int p0 = hist[F.wave * 8 + e0]; hist[F.wave * 8 + e0] = p0 + 1; const int p1 = hist[F.wave * 8 + e1]; hist[F.wave * 8 + e1] = p1 + 1;
                LAS int* s = stg + (ai - a_lo) * 6; s[0] = e0; s[1] = p0; s[2] = e1; s[3] = p1; s[4] = __float_as_int(w0); s[5] = __float_as_int(w1); }
        }
    }
    if (ROUTER) {
        __syncthreads();
        if (F.tid < 8) { int tot = 0;
#pragma unroll
            for (int w = 0; w < 8; ++w) tot += hist[w * 8 + F.tid];
            int base = (int)__hip_atomic_fetch_add(P.cnt + F.tid * 64, (unsigned)tot, __ATOMIC_RELAXED, __HIP_MEMORY_SCOPE_AGENT);
#pragma unroll
            for (int w = 0; w < 8; ++w) { wbase[w * 8 + F.tid] = base; base += hist[w * 8 + F.tid]; } }
        __syncthreads();
        for (int i = F.tid; i < a_hi - a_lo; i += NTHREADS) {
            const int ai = a_lo + i, w = i & 7;
            const int row = P.latent_only ? (ai / SEQ) * LROW + CTXL + (ai % SEQ) : ai;
            const LAS int* s = stg + i * 6;
            const int p0_ = wbase[w * 8 + s[0]] + s[1], p1_ = wbase[w * 8 + s[2]] + s[3];
            P.routeA[row] = (i32x4){s[0], p0_, s[2], p1_}; P.inv[s[0] * T + p0_] = row; P.inv[s[2] * T + p1_] = row;
            P.routeWout[row] = (f32x2){__int_as_float(s[4]), __int_as_float(s[5])};
        }
        __syncthreads();
    }
}
__device__ __forceinline__ void moe_offsets(const unsigned* cnt, int* off  ) {
    int o = 0;
#pragma unroll
    for (int e = 0; e < 8; ++e) { off[e] = o; const int c = (int)__hip_atomic_load(cnt + e * 64, __ATOMIC_RELAXED, __HIP_MEMORY_SCOPE_AGENT); o += (c + 255) & ~255; }
    off[8] = o;
}

struct ConvP { const bf16_t* U; bf16_t* CAT; const float* cw; const float* cb; const float* lng; const float* lnb; bool latent_only; };
constexpr int CV_ROWS = 62, CV_BUF = CV_ROWS * 1024, CV_PART = 2 * CV_BUF, CV_STATS = CV_PART + 8 * 64 * 4;
static_assert(CV_STATS + 32 * 8 <= LDSCTL_OFF, "conv LDS");
__device__ __forceinline__ void conv_stage(const ConvP& P, const Frame& F, int item, int buf) {
    int b, cc;
    if (P.latent_only) { b = item >> 6; cc = 8 + (item & 63); } else { b = item / 72; cc = item - b * 72; }
    const int rb = b * LROW + cc * 32, seq_lo = b * LROW + (cc < 8 ? 0 : CTXL), seq_hi = b * LROW + (cc < 8 ? CTXL : LROW);
    for (int j = F.wave; j < CV_ROWS; j += NWAVES) {
        const int row = rb - 15 + j;
        LAS unsigned char* dst = F.lds + buf * CV_BUF + j * 1024;
        if (row >= seq_lo && row < seq_hi) __builtin_amdgcn_global_load_lds((const unsigned*)(P.U + (size_t)row * 512 + F.lane * 8), (LAS unsigned*)dst, 16, 0, 0);
        else *(LAS u32x4*)(dst + F.lane * 16) = (u32x4){0u, 0u, 0u, 0u};
    }
}
__device__ __forceinline__ void conv_job(const ConvP& P, const Frame& F) {
    LAS float* part = (LAS float*)(F.lds + CV_PART);
    LAS f32x2* stats = (LAS f32x2*)(F.lds + CV_STATS);
    const int ch = F.tid;
    float w[31];
#pragma unroll
    for (int k = 0; k < 31; ++k) w[k] = P.cw[k * 512 + ch];
    const float bias = P.cb[ch], lg = P.lng[ch], lb = P.lnb[ch];
    const int nitems = P.latent_only ? NB * 64 : NB * 72;
    int item = F.bid, buf = 0;
    if (item < nitems) conv_stage(P, F, item, 0);
    for (; item < nitems; item += F.G, buf ^= 1) {
        asm volatile("s_waitcnt vmcnt(0)" ::: "memory");
        __syncthreads();
        if (item + F.G < nitems) conv_stage(P, F, item + F.G, buf ^ 1);
        int b, cc;
        if (P.latent_only) { b = item >> 6; cc = 8 + (item & 63); } else { b = item / 72; cc = item - b * 72; }
        const int rb = b * LROW + cc * 32;
        const LAS bf16_t* xin = (const LAS bf16_t*)(F.lds + buf * CV_BUF) + ch;
        float a0[32];
#pragma unroll
        for (int o = 0; o < 32; ++o) a0[o] = bias;
#pragma unroll
        for (int jb = 0; jb < 62; jb += 16) {
            float xv[16];
#pragma unroll
            for (int jj = 0; jj < 16; ++jj) if (jb + jj < 62) xv[jj] = bf2f(xin[(jb + jj) * 512]);
            __builtin_amdgcn_sched_barrier(0);
#pragma unroll
            for (int jj = 0; jj < 16; ++jj) { const int j = jb + jj;
                if (j < 62) {
#pragma unroll
                    for (int o = (j > 30 ? j - 30 : 0); o <= (j < 31 ? j : 31); ++o) a0[o] += w[j - o] * xv[jj]; } }
            __builtin_amdgcn_sched_barrier(0);
        }
        float v[64];
#pragma unroll
        for (int o = 0; o < 32; ++o) { v[2 * o] = a0[o]; v[2 * o + 1] = a0[o] * a0[o]; }
#pragma unroll
        for (int s_ = 32; s_ >= 1; s_ >>= 1) {
            const bool up = (F.lane & s_) != 0;
#pragma unroll
            for (int ib = 0; ib < s_; ib += 16) {
                float sh[16];
#pragma unroll
                for (int ii = 0; ii < 16; ++ii) if (ib + ii < s_) sh[ii] = __shfl_xor(up ? v[ib + ii] : v[ib + ii + s_], s_);
                __builtin_amdgcn_sched_barrier(0);
#pragma unroll
                for (int ii = 0; ii < 16; ++ii) if (ib + ii < s_) v[ib + ii] = (up ? v[ib + ii + s_] : v[ib + ii]) + sh[ii];
                __builtin_amdgcn_sched_barrier(0);
            }
        }
        part[F.wave * 64 + F.lane] = v[0];
        __syncthreads();
        if (F.tid < 64) { const int L = F.tid;
            float tot = 0.f;
#pragma unroll
            for (int wv = 0; wv < 8; ++wv) tot += part[wv * 64 + L];
            const float oth = __shfl_xor(tot, 1);
            if ((L & 1) == 0) { const float mean = tot * (1.0f / 512.0f), var = oth * (1.0f / 512.0f) - mean * mean; stats[L >> 1] = (f32x2){mean, 1.0f / sqrtf(var + NORM_EPS)}; } }
        __syncthreads();
#pragma unroll
        for (int ob = 0; ob < 32; ob += 16) {
            f32x2 stv[16];
#pragma unroll
            for (int oo = 0; oo < 16; ++oo) stv[oo] = stats[ob + oo];
            __builtin_amdgcn_sched_barrier(0);
#pragma unroll
            for (int oo = 0; oo < 16; ++oo) { const int o = ob + oo; const f32x2 st = stv[oo];
                const float y0 = (a0[o] - st.x) * st.y * lg + lb;
                P.CAT[(size_t)(rb + o) * 1536 + ch] = (bf16_t)(cvt_pk_bf16(siluf_(y0), 0.f) & 0xffffu); }
            __builtin_amdgcn_sched_barrier(0);
        }
    }
    __syncthreads();
}

constexpr int NCH = 72, XT_PITCH = 68, XT_BYTES = 32 * XT_PITCH * 4, SC_STAGE = 40 * 128;
static_assert(32768 + 8 * (XT_BYTES + SC_STAGE) <= LDSCTL_OFF, "scan LDS");
__device__ __forceinline__ int crow(int r, int hi) { return (r & 3) + 8 * (r >> 2) + 4 * hi; }
struct ScanP { const bf16_t* ZR; bf16_t* CAT; const float* rcw; const float* rcb; const bf16_t* wfrag; const float* bra; const float* bri; const float* lam; float* SUM; const float* CAR; };
template <bool FINAL>
__device__ __forceinline__ void scan_job(const ScanP& P, const Frame& F) {
    const int ngw = (F.G >= 8) ? F.G / 8 : 1, g = (F.G >= 8) ? (F.bid & 7) : 0, wgi = (F.G >= 8) ? (F.bid >> 3) : F.bid;
    LAS bf16_t* wl = (LAS bf16_t*)F.lds;
    LAS float* XT = (LAS float*)(F.lds + 32768 + F.wave * (XT_BYTES + SC_STAGE));
    LAS bf16_t* STG = (LAS bf16_t*)(F.lds + 32768 + F.wave * (XT_BYTES + SC_STAGE) + XT_BYTES);
    const int lane = F.lane, r32 = lane & 31, hi = lane >> 5;
    for (int gg = g; gg < 8; gg += (F.G >= 8 ? 8 : 1)) {
    __syncthreads();
#pragma unroll
    for (int i = 0; i < 4; ++i) { const int e = (i * NTHREADS + F.tid) * 8, piece = e >> 12, within = e & 4095;
        *(LAS u32x4*)(wl + e) = *(const u32x4*)(P.wfrag + ((size_t)(piece * 8 + gg)) * 4096 + within); }
    const int ch = 64 * gg + lane;
    float cw[2][4], cbias[2], ba[2][2], bi[2][2], c1[2][2];
#pragma unroll
    for (int d = 0; d < 2; ++d) {
#pragma unroll
        for (int k = 0; k < 4; ++k) cw[d][k] = P.rcw[(d * 4 + k) * 512 + ch];
        cbias[d] = P.rcb[d * 512 + ch];
#pragma unroll
        for (int cb = 0; cb < 2; ++cb) { const int chj = 64 * gg + 32 * cb + r32;
            ba[d][cb] = -1.4426950408889634f * P.bra[d * 512 + chj]; bi[d][cb] = -1.4426950408889634f * P.bri[d * 512 + chj];
            const float sp = 0.6931471805599453f * __builtin_amdgcn_logf(1.0f + fast_exp2(-1.4426950408889634f * P.lam[d * 512 + chj]));
            c1[d][cb] = -8.0f * 1.4426950408889634f * sp; }
    }
    __syncthreads();
    const int istep = ngw * NWAVES, w_ = wgi * NWAVES + F.wave; const bool even_deal = (istep == 256);
    int item = w_, cbm = 3;
#define SCAN_STAGE(it) do { const int c_ = (it) % NCH, b_ = (it) / NCH; const int rb_ = b_ * LROW + c_ * 32, lo_ = b_ * LROW + (c_ < 8 ? 0 : CTXL), hi_ = b_ * LROW + (c_ < 8 ? CTXL : LROW); \
        _Pragma("unroll") for (int q_ = 0; q_ < 5; ++q_) { int row_ = rb_ - 3 + q_ * 8 + (lane >> 3); row_ = row_ < lo_ ? lo_ : (row_ >= hi_ ? hi_ - 1 : row_); \
            __builtin_amdgcn_global_load_lds((const unsigned*)(P.ZR + (size_t)row_ * 1024 + 64 * gg + (lane & 7) * 8), (LAS unsigned*)(STG + q_ * 512), 16, 0, 0); } } while (0)
    if (item < NB * NCH) SCAN_STAGE(item);
    for (; item < NB * NCH; ) {
        int nitem = item + istep, ncbm = 3;
        if (even_deal) { if (item >= 1024) nitem = NB * NCH; else if (nitem >= 1024) { nitem = 1024 + (w_ >> 1); ncbm = 1 << (w_ & 1); } }
        const int c = item % NCH, b = item / NCH;
        const int rb = b * LROW + c * 32;
        asm volatile("s_waitcnt vmcnt(0)" ::: "memory");
        { const int lo_ = b * LROW + (c < 8 ? 0 : CTXL), hi_ = b * LROW + (c < 8 ? CTXL : LROW);
          if (rb - 3 < lo_ || rb + 36 >= hi_) {
#pragma unroll
              for (int q_ = 0; q_ < 5; ++q_) { const int row_ = rb - 3 + q_ * 8 + (lane >> 3); if (row_ < lo_ || row_ >= hi_) *(LAS u32x4*)(STG + q_ * 512 + lane * 8) = (u32x4){0u, 0u, 0u, 0u}; }
          } }
        unsigned xwp[19];
#pragma unroll
        for (int j = 0; j < 19; ++j) xwp[j] = (unsigned)STG[(2 * j) * 64 + lane] | ((unsigned)STG[(2 * j + 1) * 64 + lane] << 16);
        asm volatile("s_waitcnt lgkmcnt(0)" ::: "memory");
        if (nitem < NB * NCH) SCAN_STAGE(nitem);
#define SCAN_X(j) (((j) & 1) ? bfhi(xwp[(j) >> 1]) : bflo(xwp[(j) >> 1]))
        float carv[2][2];
        if (FINAL) {
#pragma unroll
            for (int d = 0; d < 2; ++d)
#pragma unroll
                for (int cb = 0; cb < 2; ++cb) carv[d][cb] = P.CAR[(size_t)(((b * 8 + gg) * 2 + d) * NCH + c) * 64 + 32 * cb + r32];
        }
        float hsum[2][16];
#pragma unroll
        for (int cb = 0; cb < 2; ++cb)
#pragma unroll
            for (int r = 0; r < 16; ++r) hsum[cb][r] = 0.f;
#pragma unroll
        for (int d = 0; d < 2; ++d) {
#pragma unroll
            for (int t = 0; t < 32; ++t) { const int o = t + 3 * d; XT[t * XT_PITCH + lane] = fmaf(cw[d][3], SCAN_X(o + 3), fmaf(cw[d][2], SCAN_X(o + 2), fmaf(cw[d][1], SCAN_X(o + 1), fmaf(cw[d][0], SCAN_X(o), cbias[d])))); }
            bf16x8 af[4];
#pragma unroll
            for (int s = 0; s < 4; ++s) { const f32x4 x0 = *(const LAS f32x4*)(XT + r32 * XT_PITCH + 16 * s + 8 * hi), x1 = *(const LAS f32x4*)(XT + r32 * XT_PITCH + 16 * s + 8 * hi + 4);
                const u32x4 w = pg8::pack8(x0, x1); af[s] = __builtin_bit_cast(bf16x8, w); }
#pragma unroll
            for (int cb = 0; cb < 2; ++cb) { if (!(cbm & (1 << cb))) continue;
                f32x16 ra = {}, ri = {};
#pragma unroll
                for (int s = 0; s < 4; ++s) {
                    const bf16x8 wa = *(const LAS bf16x8*)(wl + (d * 2 + 0) * 4096 + (cb * 4 + s) * 512 + lane * 8);
                    const bf16x8 wi = *(const LAS bf16x8*)(wl + (d * 2 + 1) * 4096 + (cb * 4 + s) * 512 + lane * 8);
                    ra = __builtin_amdgcn_mfma_f32_32x32x16_bf16(af[s], wa, ra, 0, 0, 0);
                    ri = __builtin_amdgcn_mfma_f32_32x32x16_bf16(af[s], wi, ri, 0, 0, 0);
                }
                float av[16], bx[16];
#pragma unroll
                for (int r = 0; r < 16; ++r) {
                    const float xcv = XT[crow(r, hi) * XT_PITCH + 32 * cb + r32];
                    const float rg = fast_rcp(1.0f + fast_exp2(fmaf(ra[r], -1.4426950408889634f, ba[d][cb]))), ig = fast_rcp(1.0f + fast_exp2(fmaf(ri[r], -1.4426950408889634f, bi[d][cb])));
                    const float a_ = fast_exp2(c1[d][cb] * rg);
                    av[r] = a_; bx[r] = __builtin_amdgcn_sqrtf(fmaf(-a_, a_, 1.0f)) * (ig * xcv);
                }
                float Ag[4], Bg[4];
#pragma unroll
                for (int q = 0; q < 4; ++q) {
                    Ag[q] = (av[4 * q] * av[4 * q + 1]) * (av[4 * q + 2] * av[4 * q + 3]);
                    if (d == 0) Bg[q] = ((bx[4 * q] * av[4 * q + 1] + bx[4 * q + 1]) * av[4 * q + 2] + bx[4 * q + 2]) * av[4 * q + 3] + bx[4 * q + 3];
                    else        Bg[q] = ((bx[4 * q + 3] * av[4 * q + 2] + bx[4 * q + 2]) * av[4 * q + 1] + bx[4 * q + 1]) * av[4 * q] + bx[4 * q];
                }
                float A0[4], A1[4], B0[4], B1[4];
#pragma unroll
                for (int q = 0; q < 4; ++q) {
                    auto ra_ = __builtin_amdgcn_permlane32_swap(__float_as_uint(Ag[q]), __float_as_uint(Ag[q]), false, false); A0[q] = __uint_as_float(ra_[0]); A1[q] = __uint_as_float(ra_[1]);
                    auto rb_ = __builtin_amdgcn_permlane32_swap(__float_as_uint(Bg[q]), __float_as_uint(Bg[q]), false, false); B0[q] = __uint_as_float(rb_[0]); B1[q] = __uint_as_float(rb_[1]);
                }
                if (!FINAL) {
                    float Ac = 1.f, Bc = 0.f;
                    if (d == 0) {
#pragma unroll
                        for (int q = 0; q < 4; ++q) { Bc = A0[q] * Bc + B0[q]; Ac *= A0[q]; Bc = A1[q] * Bc + B1[q]; Ac *= A1[q]; }
                    } else {
#pragma unroll
                        for (int q = 3; q >= 0; --q) { Bc = A1[q] * Bc + B1[q]; Ac *= A1[q]; Bc = A0[q] * Bc + B0[q]; Ac *= A0[q]; }
                    }
                    if (hi == 0) { float* sp_ = P.SUM + ((size_t)(((b * 8 + gg) * 2 + d) * NCH + c) * 2) * 64 + 32 * cb + r32; sp_[0] = Ac; sp_[64] = Bc; }
                } else {
                    float s = carv[d][cb];
                    float sin_[4];
                    if (d == 0) {
#pragma unroll
                        for (int q = 0; q < 4; ++q) { const float s0 = s; s = A0[q] * s + B0[q]; const float s1 = s; s = A1[q] * s + B1[q]; sin_[q] = hi ? s1 : s0; }
#pragma unroll
                        for (int q = 0; q < 4; ++q) { float h = sin_[q];
#pragma unroll
                            for (int e = 0; e < 4; ++e) { h = av[4 * q + e] * h + bx[4 * q + e]; hsum[cb][4 * q + e] += h; } }
                    } else {
#pragma unroll
                        for (int q = 3; q >= 0; --q) { const float s1 = s; s = A1[q] * s + B1[q]; const float s0 = s; s = A0[q] * s + B0[q]; sin_[q] = hi ? s1 : s0; }
#pragma unroll
                        for (int q = 0; q < 4; ++q) { float h = sin_[q];
#pragma unroll
                            for (int e = 3; e >= 0; --e) { h = av[4 * q + e] * h + bx[4 * q + e]; hsum[cb][4 * q + e] += h; } }
                    }
                }
            }
        }
        if (FINAL) {
            u32x4 gatev[4];
            const bool mine = (cbm >> ((lane & 7) >> 2)) & 1;
#pragma unroll
            for (int p = 0; p < 4; ++p) { gatev[p] = (u32x4){0u, 0u, 0u, 0u}; if (mine) gatev[p] = *(const u32x4*)(P.ZR + (size_t)(rb + p * 8 + (lane >> 3)) * 1024 + 512 + 64 * gg + (lane & 7) * 8); }
#pragma unroll
            for (int cb = 0; cb < 2; ++cb) { if (!(cbm & (1 << cb))) continue;
#pragma unroll
                for (int r = 0; r < 16; ++r) XT[crow(r, hi) * XT_PITCH + 32 * cb + r32] = hsum[cb][r]; }
#pragma unroll
            for (int p = 0; p < 4; ++p) { const int tl = p * 8 + (lane >> 3), c8 = (lane & 7) * 8; const size_t row = (size_t)(rb + tl);
                const f32x4 y0 = *(const LAS f32x4*)(XT + tl * XT_PITCH + c8), y1 = *(const LAS f32x4*)(XT + tl * XT_PITCH + c8 + 4);
                f32x4 g0, g1; pg8::unpack8(gatev[p], g0, g1);
                if (mine) *(u32x4*)(P.CAT + row * 1536 + 1024 + 64 * gg + c8) = pg8::pack8(y0 * g0, y1 * g1); }
        }
        item = nitem; cbm = ncbm;
    }
#undef SCAN_STAGE
#undef SCAN_X
    }
}
__device__ __forceinline__ void carry_job(const float* __restrict__ SUM, float* __restrict__ CAR, const Frame& F) {
    const int gw = F.bid * NWAVES + F.wave, NGW = F.G * NWAVES;
    for (int item = gw; item < NB * 8 * 2; item += NGW) {
        const int d = item & 1;
        const float* __restrict__ sp = SUM + (size_t)item * NCH * 128 + F.lane; float* __restrict__ cp = CAR + (size_t)item * NCH * 64 + F.lane;
        float s = 0.f;
#pragma unroll 1
        for (int c0 = 0; c0 < NCH; c0 += 24) {
            float av[24], bv[24];
#pragma unroll
            for (int j = 0; j < 24; ++j) { const int k = c0 + j, c = (d == 0) ? k : (k < 8 ? 7 - k : NCH + 7 - k); av[j] = sp[c * 128]; bv[j] = sp[c * 128 + 64]; }
#pragma unroll
            for (int j = 0; j < 24; ++j) { const int k = c0 + j, c = (d == 0) ? k : (k < 8 ? 7 - k : NCH + 7 - k); cp[c * 64] = s; s = av[j] * s + bv[j]; }
        }
    }
}

__device__ __forceinline__ void krope_job(const bf16_t* __restrict__ H, const bf16_t* __restrict__ WF, bf16_t* __restrict__ KR, unsigned long long* __restrict__ stats, int first, int step, const Frame& F) {
    if (first < 0) return;
    const int lane = F.lane, r32 = lane & 31, hi = lane >> 5, lrow = lane >> 3, lpc = lane & 7;
    LAS unsigned char* xa = F.lds + F.wave * 16384;
    for (int item = first; item < T / 32; item += step) {
        const bf16_t* abase = H + (size_t)(item * 32 + lrow) * DM + lpc * 8;
        f32x16 acc = {};
#pragma unroll 1
        for (int kb = 0; kb < 4; ++kb) {
            u32x4 t[16]; bf16x8 bv[16];
#pragma unroll
            for (int j = 0; j < 16; ++j) t[j] = *(const u32x4*)(abase + (size_t)((j & 3) * 8) * DM + kb * 256 + (j >> 2) * 64);
#pragma unroll
            for (int j = 0; j < 16; ++j) bv[j] = *(const bf16x8*)(WF + ((size_t)(kb * 16 + j) * 64 + lane) * 8);
#pragma unroll
            for (int j = 0; j < 16; ++j) *(LAS u32x4*)(xa + (j >> 2) * 4096 + ((j & 3) * 8 + lrow) * 128 + ((lpc ^ lrow) * 16)) = t[j];
#pragma unroll
            for (int j = 0; j < 16; ++j) { const bf16x8 av = *(const LAS bf16x8*)(xa + (j >> 2) * 4096 + r32 * 128 + ((((j & 3) * 2 + hi) ^ (r32 & 7)) * 16));
                acc = __builtin_amdgcn_mfma_f32_32x32x16_bf16(av, bv[j], acc, 0, 0, 0); }
        }
#pragma unroll
        for (int r = 0; r < 16; ++r) { const int row = item * 32 + crow(r, hi);
            KR[(size_t)row * 32 + r32] = (bf16_t)(cvt_pk_bf16(acc[r], 0.f) & 0xffffu);
            float sq = sum_x16(row16_sum(acc[r] * acc[r]));
            if (r32 == 0) stats[(size_t)row * 4 + 2] = (unsigned long long)(sq * 1048576.0f); }
    }
}

constexpr int attn_NTB = LROW / 64;
__device__ __forceinline__ void rope_table_job(f32x2* tab, const Frame& F) {
    if (F.bid == 0) { const int p = F.tid >> 3, i = F.tid & 7; const float f = powf(10000.0f, -(float)i * 0.125f); float s_, c_; sincosf((float)p * f, &s_, &c_); tab[F.tid] = (f32x2){c_, s_}; }
}

namespace attn {
constexpr int KSLOT = 12288, VSLOT = 8192, NSLOT = 3, KTILE = 6144, VTILE = 4096, NTB = LROW / 64;
constexpr int L_K = 0, L_V = NSLOT * KSLOT, L_WS = L_V + NSLOT * VSLOT, L_OST = L_WS + 2048, L_END = L_OST + 8 * 4096;
static_assert(L_END <= RING_BYTES, "attention LDS");
struct AttnP { const bf16_t* Q; const bf16_t* Kt; const bf16_t* Vt; bf16_t* CAT; float mfix; };
#define AT_WAIT_V(n) asm volatile("s_waitcnt vmcnt(" #n ")" ::: "memory")
#define AT_SB() __builtin_amdgcn_sched_barrier(0)
__device__ __forceinline__ void unit(const AttnP& P, LAS unsigned char* lds, int bh, int qrow0, int NT, const int tid) {
    const int lane = tid & 63, r32 = lane & 31, hi = lane >> 5; const int wid = __builtin_amdgcn_readfirstlane(tid >> 6);
    const int h = bh & 7;
    const bf16_t* Qw = P.Q + (size_t)(qrow0 + wid * 32) * 768 + 96 * h;
    bf16x8 qr[6];
#pragma unroll
    for (int d0 = 0; d0 < 6; ++d0) qr[d0] = *(const bf16x8*)(Qw + (size_t)r32 * 768 + 16 * d0 + 8 * hi);
    const bf16_t* ksrcA = P.Kt + (size_t)bh * NTB * KTILE + wid * 512 + lane * 8;
    const bf16_t* ksrcB = P.Kt + (size_t)bh * NTB * KTILE + (8 + (wid & 3)) * 512 + lane * 8;
    const bf16_t* vsrc = P.Vt + (size_t)bh * NTB * VTILE + wid * 512 + lane * 8;
#define AT_DMA_K(t, slot) do { \
        __builtin_amdgcn_global_load_lds((const unsigned*)(ksrcA + (size_t)(t) * KTILE), (LAS unsigned*)(lds + L_K + (slot) * KSLOT + wid * 1024), 16, 0, 0); \
        __builtin_amdgcn_global_load_lds((const unsigned*)(ksrcB + (size_t)(t) * KTILE), (LAS unsigned*)(lds + L_K + (slot) * KSLOT + (8 + (wid & 3)) * 1024), 16, 0, 0); } while (0)
#define AT_DMA_V(t, slot) __builtin_amdgcn_global_load_lds((const unsigned*)(vsrc + (size_t)(t) * VTILE), (LAS unsigned*)(lds + L_V + (slot) * VSLOT + wid * 1024), 16, 0, 0)
    AT_DMA_K(0, 0); AT_DMA_K(1, 1); AT_DMA_V(0, 0);
    LAS float* wsf = (LAS float*)(lds + L_WS) + wid * 64;
    const unsigned vb0 = (unsigned)(uintptr_t)(lds + L_V) + ((lane >> 4) & 1) * 32 + (lane & 3) * 8 + (4 * hi + ((lane & 15) >> 2)) * 64;
    const LAS unsigned char* kb0 = lds + L_K + hi * 1024 + r32 * 16;
    f32x16 o[2]; o[0] = f32x16{}; o[1] = f32x16{};
    f32x16 negm;
#pragma unroll
    for (int r = 0; r < 16; ++r) negm[r] = -P.mfix;
    float lsum = 0.f;
    f32x16 pA0, pA1, pB0, pB1;
#define AT_KF(kb, i) (*(const LAS bf16x8*)((kb) + ((i) >> 1) * 2048 + ((i) & 1) * 512))
#define AT_PV(ks) __builtin_bit_cast(bf16x8, ((u32x4){pw[4 * (ks)], pw[4 * (ks) + 1], pw[4 * (ks) + 2], pw[4 * (ks) + 3]}))
    AT_WAIT_V(3); __builtin_amdgcn_s_barrier(); asm volatile("" ::: "memory");
    if (2 < NT) AT_DMA_K(2, 2);
    AT_DMA_V(1, 1);
    {
        const LAS unsigned char* kb = kb0;
        pA0 = negm; pA1 = negm;
#pragma unroll
        for (int i = 0; i < 12; ++i) { const bf16x8 kf = AT_KF(kb, i);
            if (i & 1) pA1 = __builtin_amdgcn_mfma_f32_32x32x16_bf16(kf, qr[i >> 1], pA1, 0, 0, 0); else pA0 = __builtin_amdgcn_mfma_f32_32x32x16_bf16(kf, qr[i >> 1], pA0, 0, 0, 0); }
#pragma unroll
        for (int r = 0; r < 16; ++r) { pA0[r] = fast_exp2(pA0[r]); pA1[r] = fast_exp2(pA1[r]); }
    }
#define AT_STEP(S0, S1, P0, P1, ksl, vsl) do { \
        const LAS unsigned char* kb = kb0 + (ksl) * KSLOT; const unsigned vb = vb0 + (vsl) * VSLOT; \
        s16x4 vlo[8], vhh[8]; unsigned pw[16]; float sacc = 0.f; \
        bf16x8 kfa = AT_KF(kb, 0), kfb = AT_KF(kb, 1), kfc = AT_KF(kb, 2), kfd = AT_KF(kb, 3); \
        AT_SB(); \
        _Pragma("unroll") for (int i = 0; i < 12; ++i) { \
            bf16x8 kfe = kfa; if (i + 4 < 12) kfe = AT_KF(kb, (i + 4 < 12 ? i + 4 : 0)); \
            if (i < 8) { asm volatile("ds_read_b64_tr_b16 %0,%1 offset:%c2" : "=&v"(vlo[i]) : "v"(vb), "i"(((i) >> 2) * 4096 + ((i) & 3) * 1024) : "memory"); \
                         asm volatile("ds_read_b64_tr_b16 %0,%1 offset:%c2" : "=&v"(vhh[i]) : "v"(vb), "i"(((i) >> 2) * 4096 + ((i) & 3) * 1024 + 512) : "memory"); } \
            if (i & 1) S1 = __builtin_amdgcn_mfma_f32_32x32x16_bf16(kfa, qr[i >> 1], (i == 1) ? negm : S1, 0, 0, 0); \
            else       S0 = __builtin_amdgcn_mfma_f32_32x32x16_bf16(kfa, qr[i >> 1], (i == 0) ? negm : S0, 0, 0, 0); \
            { const int j0 = (i < 8) ? 3 * i : 24 + 2 * (i - 8), j1 = (i < 8) ? 3 * i + 3 : 24 + 2 * (i - 8) + 2; \
              _Pragma("unroll") for (int j = j0; j < j1; ++j) sacc += (j < 16) ? P0[j & 15] : P1[j & 15]; } \
            if (i < 8) { const int e = 4 * i; pw[2 * i] = (e < 16) ? cvt_pk_bf16(P0[e & 15], P0[(e + 1) & 15]) : cvt_pk_bf16(P1[e & 15], P1[(e + 1) & 15]); \
                         pw[2 * i + 1] = (e < 16) ? cvt_pk_bf16(P0[(e + 2) & 15], P0[(e + 3) & 15]) : cvt_pk_bf16(P1[(e + 2) & 15], P1[(e + 3) & 15]); \
                         asm volatile("" : "+v"(pw[2 * i]), "+v"(pw[2 * i + 1])); } \
            asm volatile("" : "+v"(sacc)); \
            kfa = kfb; kfb = kfc; kfc = kfd; kfd = kfe; \
            AT_SB(); \
        } \
        lsum += sacc; \
        asm volatile("s_waitcnt lgkmcnt(0)" ::: "memory"); AT_SB(); \
        _Pragma("unroll") for (int j = 0; j < 8; ++j) { const int d0 = j & 1, ks = j >> 1, vi = d0 * 4 + ks; \
            const bf16x8 vf = (bf16x8){vlo[vi][0], vlo[vi][1], vlo[vi][2], vlo[vi][3], vhh[vi][0], vhh[vi][1], vhh[vi][2], vhh[vi][3]}; \
            const bf16x8 pa = AT_PV(ks); \
            o[d0] = __builtin_amdgcn_mfma_f32_32x32x16_bf16(pa, vf, o[d0], 0, 0, 0); \
            _Pragma("unroll") for (int e = 0; e < 4; ++e) { if (j < 4) S0[4 * j + e] = fast_exp2(S0[4 * j + e]); else S1[4 * (j - 4) + e] = fast_exp2(S1[4 * (j - 4) + e]); } \
            if (j < 4) asm volatile("" : "+v"(S0)); else asm volatile("" : "+v"(S1)); \
            AT_SB(); \
        } \
    } while (0)
    int ksl = 1, vsl = 0;
#define AT_TOP(t) do { if ((t) + 1 < NT) AT_WAIT_V(3); else AT_WAIT_V(1); __builtin_amdgcn_s_barrier(); asm volatile("" ::: "memory"); \
        const int nsl = (ksl == 2) ? 0 : ksl + 1; if ((t) + 2 < NT) AT_DMA_K((t) + 2, vsl); if ((t) + 1 < NT) AT_DMA_V((t) + 1, nsl); } while (0)
#define AT_ROT() do { vsl = ksl; ksl = (ksl == 2) ? 0 : ksl + 1; } while (0)
    int t = 1;
    for (; t + 1 < NT; t += 2) {
        AT_TOP(t);     AT_STEP(pB0, pB1, pA0, pA1, ksl, vsl); AT_ROT();
        AT_TOP(t + 1); AT_STEP(pA0, pA1, pB0, pB1, ksl, vsl); AT_ROT();
    }
    AT_TOP(t); AT_STEP(pB0, pB1, pA0, pA1, ksl, vsl); AT_ROT();
    AT_WAIT_V(0); __builtin_amdgcn_s_barrier(); asm volatile("" ::: "memory");
    {
        unsigned pw[16]; float sacc = 0.f;
#pragma unroll
        for (int r = 0; r < 16; ++r) sacc += pB0[r] + pB1[r];
        lsum += sacc;
#pragma unroll
        for (int i = 0; i < 4; ++i) { pw[2 * i] = cvt_pk_bf16(pB0[4 * i], pB0[4 * i + 1]); pw[2 * i + 1] = cvt_pk_bf16(pB0[4 * i + 2], pB0[4 * i + 3]);
                                      pw[8 + 2 * i] = cvt_pk_bf16(pB1[4 * i], pB1[4 * i + 1]); pw[8 + 2 * i + 1] = cvt_pk_bf16(pB1[4 * i + 2], pB1[4 * i + 3]); }
        const unsigned vb = vb0 + vsl * VSLOT;
#pragma unroll
        for (int d0 = 0; d0 < 2; ++d0) { s16x4 lo[4], hh[4];
#pragma unroll
            for (int ks = 0; ks < 4; ++ks) {
                asm volatile("ds_read_b64_tr_b16 %0,%1 offset:%c2" : "=&v"(lo[ks]) : "v"(vb), "i"(d0 * 4096 + ks * 1024) : "memory");
                asm volatile("ds_read_b64_tr_b16 %0,%1 offset:%c2" : "=&v"(hh[ks]) : "v"(vb), "i"(d0 * 4096 + ks * 1024 + 512) : "memory"); }
            asm volatile("s_waitcnt lgkmcnt(0)" ::: "memory"); AT_SB();
#pragma unroll
            for (int ks = 0; ks < 4; ++ks) { const bf16x8 vf = (bf16x8){lo[ks][0], lo[ks][1], lo[ks][2], lo[ks][3], hh[ks][0], hh[ks][1], hh[ks][2], hh[ks][3]};
                const bf16x8 pa = AT_PV(ks);
                o[d0] = __builtin_amdgcn_mfma_f32_32x32x16_bf16(pa, vf, o[d0], 0, 0, 0); }
        }
    }
    { auto rr = __builtin_amdgcn_permlane32_swap(__float_as_uint(lsum), __float_as_uint(lsum), false, false); lsum = __uint_as_float(rr[0]) + __uint_as_float(rr[1]); }
    if (hi == 0) wsf[32 + r32] = lsum;
    asm volatile("s_waitcnt lgkmcnt(0)" ::: "memory");
    float rli[16];
#pragma unroll
    for (int r = 0; r < 16; ++r) rli[r] = fast_rcp(wsf[32 + crow(r, hi)]);
    LAS bf16_t* stg = (LAS bf16_t*)(lds + L_OST) + wid * 2048;
#pragma unroll
    for (int r = 0; r < 16; ++r) { const int orow = crow(r, hi);
#pragma unroll
        for (int d0 = 0; d0 < 2; ++d0) stg[orow * 64 + d0 * 32 + r32] = (bf16_t)(cvt_pk_bf16(o[d0][r] * rli[r], 0.f) & 0xffffu); }
    asm volatile("s_waitcnt lgkmcnt(0)" ::: "memory");
    bf16_t* Ow = P.CAT + (size_t)(qrow0 + wid * 32) * 1536 + 512 + 64 * h;
#pragma unroll
    for (int i = 0; i < 4; ++i) { const int row = i * 8 + (lane >> 3), ch = lane & 7; const u32x4 v = *(const LAS u32x4*)(stg + row * 64 + ch * 8); *(u32x4*)(Ow + (size_t)row * 1536 + ch * 8) = v; }
    asm volatile("s_waitcnt lgkmcnt(0)" ::: "memory"); __builtin_amdgcn_s_barrier(); asm volatile("" ::: "memory");
#undef AT_DMA_K
#undef AT_DMA_V
#undef AT_KF
#undef AT_PV
#undef AT_STEP
#undef AT_TOP
#undef AT_ROT
}
__device__ __forceinline__ void phase(const AttnP& P, const Frame& F, bool with_ctx) {
    const int vcu = (F.G % 8 == 0) ? (F.bid % 8) * (F.G / 8) + F.bid / 8 : F.bid;
    for (int u = vcu; u < NB * 8 * 8; u += F.G) { const int bh = u >> 3, qb = u & 7, b = bh >> 3;
        unit(P, F.lds, bh, b * LROW + CTXL + qb * 256, LROW / 64, F.tid); }
    if (with_ctx) for (int u = vcu; u < NB * 8; u += F.G) { const int b = u >> 3; unit(P, F.lds, u, b * LROW, CTXL / 64, F.tid); }
}
}


constexpr int PH_PER_LAYER = 11, NPHASE = 1 + DEPTH * PH_PER_LAYER + 1;
#define IN(k) (lo <= (k) && (k) < hi)
#define PHASE_BEGIN() do { if (need_bar) xcd_barrier(bar); need_bar = true; int t_ = threadIdx.x; asm volatile("" : "+v"(t_)); F.tid = t_; F.lane = t_ & 63; F.wave = __builtin_amdgcn_readfirstlane(t_ >> 6); } while (0)
#define WSP(T_, off) ((T_*)(ws + (off)))

template <int L>
__device__ __forceinline__ void layer_phases(const Args& a, Frame& F, const XcdBarrier& bar, bool& need_bar, const int lo, const int hi) {
    constexpr int l = L, pb = 1 + l * PH_PER_LAYER;
    if (hi <= pb || lo >= pb + PH_PER_LAYER) return;
    constexpr bool last = (l == DEPTH - 1), moe = (l & 1) != 0; constexpr int jf = l >> 1;
    unsigned char* ws = a.ws;
    unsigned* ctl = (unsigned*)(ws + WS_CTL);
    float* MOD = WSP(float, WS_MOD); bf16_t* XRES = WSP(bf16_t, WS_XRES);
    const float* MODl = MOD + (size_t)l * NMOD * 6144;
    unsigned* cnt = ctl + CW_CNT + jf * 8 * 64;
    constexpr int nMrows = last ? NB * 8 : T / 256, rmode = last ? 1 : 0;
    bf16_t* H = WSP(bf16_t, A_H); bf16_t* Gt = WSP(bf16_t, A_G); bf16_t* ZR = WSP(bf16_t, A_ZR); bf16_t* ZQ = WSP(bf16_t, A_ZQ); bf16_t* Qb = WSP(bf16_t, A_Q);
    bf16_t* ZKV = WSP(bf16_t, A_ZKV); bf16_t* KR = WSP(bf16_t, A_KR); bf16_t* KVR = WSP(bf16_t, A_KVR); bf16_t* U = WSP(bf16_t, A_U); bf16_t* CAT = WSP(bf16_t, A_CAT);
    bf16_t* Kb = H; bf16_t* Vb = KVR;
    float* SUM = WSP(float, A_SUM); float* CAR = WSP(float, A_CAR);
    bf16_t* HID = WSP(bf16_t, A_HID); bf16_t* HP = WSP(bf16_t, A_HP); bf16_t* HIDM = WSP(bf16_t, A_HIDM);
    i32x4* routeA = WSP(i32x4, WS_ROUTE_A); f32x2* routeW = WSP(f32x2, WS_ROUTE_W); i32x2* routeP = WSP(i32x2, WS_ROUTE_P);

    if (IN(pb + 0)) { PHASE_BEGIN(); {
        NormP P{}; P.xin = a.in[I_X]; P.cin = a.in[I_CTX]; P.X = XRES; P.from_f32 = (l == 0); P.outf = nullptr; P.gain = a.in[I_GN1] + l * DM; P.mod = MODl; P.shsel = 0; P.H = H;
        P.combine = (l == 2); P.Y = HP; P.routeP = routeP; P.routeW = routeW; P.modprev = MOD + (size_t)(l > 0 ? l - 1 : 0) * NMOD * 6144; P.do_norm = true; P.latent_only = false;
        norm_job<false>(P, F);
        { u32x4* st = WSP(u32x4, WS_STATS); for (int i = F.bid * NTHREADS + F.tid; i < 2 * T; i += F.G * NTHREADS) st[i] = (u32x4){0u, 0u, 0u, 0u}; }
        if constexpr (moe) { u32x4* iv = WSP(u32x4, WS_INV); for (int i = F.bid * NTHREADS + F.tid; i < 2 * T; i += F.G * NTHREADS) iv[i] = (u32x4){0u, 0u, 0u, 0u}; } } }
    if (IN(pb + 1)) { PHASE_BEGIN(); {
        pg8::Gemm g{H, WSP(const bf16_t, WS_WIN) + (size_t)l * NWIN * DM, DM, DM, DM, 0};
        pg8::Order S; S.init(last ? NB * 8 : T / 256, NWIN / 256, F.G, F.bid, last ? 3 : 0, 1, DM, DM, 0);
        pg8::EpiWin E{U, ZQ, ZKV, ZR, Gt, KR, a.in[I_BGATE] + l * 3072, WSP(unsigned long long, WS_STATS)};
        pg8::gemm_phase<pg8::EpiWin, true>(F.lds, g, S, E, F.tid);
        if (F.G == 256) krope_job(H, WSP(const bf16_t, WS_WKR) + (size_t)l * 64 * 512, KR, WSP(unsigned long long, WS_STATS), F.bid >= 128 ? (F.bid - 128) * NWAVES + F.wave : -1, 128 * NWAVES, F);
        else krope_job(H, WSP(const bf16_t, WS_WKR) + (size_t)l * 64 * 512, KR, WSP(unsigned long long, WS_STATS), F.bid * NWAVES + F.wave, F.G * NWAVES, F); } }
    if (IN(pb + 2)) { PHASE_BEGIN(); {
        { ConvP P{U, CAT, a.in[I_CONVW] + l * 31 * 512, a.in[I_CONVB] + l * 512, a.in[I_CLNG] + l * 512, a.in[I_CLNB] + l * 512, last}; conv_job(P, F); }
        __syncthreads();
        { ScanP P{ZR, CAT, a.in[I_RCW] + l * 2 * 4 * 512, a.in[I_RCB] + l * 2 * 512, WSP(const bf16_t, WS_WREC) + (size_t)l * 256 * 512, a.in[I_BRA] + l * 1024, a.in[I_BRI] + l * 1024, a.in[I_LAM] + l * 1024, SUM, CAR};
          scan_job<false>(P, F); }
        __syncthreads();
        { LAS f32x2* tl = (LAS f32x2*)(F.lds + RING_BYTES + 10240); tl[F.tid] = WSP(const f32x2, WS_TAB)[F.tid]; __syncthreads(); }
        { pg8::Gemm g{ZQ, WSP(const bf16_t, WS_WQB) + (size_t)l * 1024 * 768, 768, 768, 768, 0};
          pg8::Order S; S.init(last ? NB * 8 : T / 256, 4, F.G, F.bid, last ? 1 : 0, 1, 768, 768, 0);
          pg8::EpiQ E{Qb, a.in[I_GQN] + l * 96, WSP(const unsigned long long, WS_STATS), (LAS float*)(F.lds + RING_BYTES)};
          pg8::gemm_phase<pg8::EpiQ, true>(F.lds, g, S, E, F.tid); }
        if (last || F.G != 256 || F.bid >= 64)
        { pg8::Gemm g{ZKV, WSP(const bf16_t, WS_WKVB) + (size_t)l * 1024 * 256, 256, 256, 256, 0};
          pg8::Order S; if (last || F.G != 256) S.init(T / 256, 4, F.G, F.bid, 0, 1, 256, 256, 0); else S.init(T / 256, 4, 192, F.bid - 64, 0, 1, 256, 256, 0);
          pg8::EpiKV E{Kb, Vb, KR, a.in[I_GKN] + l * 96, WSP(const unsigned long long, WS_STATS), (LAS float*)(F.lds + RING_BYTES)};
          pg8::gemm_phase<pg8::EpiKV, true>(F.lds, g, S, E, F.tid); }
        } }
    if (IN(pb + 3)) { PHASE_BEGIN(); {
        carry_job(SUM, CAR, F); } }
    if (IN(pb + 4)) { PHASE_BEGIN(); {
        { ScanP P{ZR, CAT, a.in[I_RCW] + l * 2 * 4 * 512, a.in[I_RCB] + l * 2 * 512, WSP(const bf16_t, WS_WREC) + (size_t)l * 256 * 512, a.in[I_BRA] + l * 1024, a.in[I_BRI] + l * 1024, a.in[I_LAM] + l * 1024, SUM, CAR};
          scan_job<true>(P, F); }
        __syncthreads();
        { float mq = 0.f, mk = 0.f;
          for (int d = 0; d < 96; ++d) { mq = fmaxf(mq, fabsf(a.in[I_GQN][l * 96 + d])); mk = fmaxf(mk, fabsf(a.in[I_GKN][l * 96 + d])); }
          attn::AttnP P{Qb, Kb, Vb, CAT, 96.0f * mq * mk * QSCALE};
          attn::phase(P, F, !last); } } }
    if (IN(pb + 5)) { PHASE_BEGIN(); {
        pg8::Gemm g{CAT, WSP(const bf16_t, WS_WCAT) + (size_t)l * 1024 * 1536, 1536, 1536, 512, 0};
        pg8::Order S; S.init(nMrows, 4, F.G, F.bid, rmode, 3, 1536, 1536, 512);
        pg8::EpiMerge E{Gt, H};
        pg8::gemm_phase<pg8::EpiMerge, true>(F.lds, g, S, E, F.tid);
        if constexpr (l == 0 || l == 2) { if (F.G == 256) convert_moe(a, F, jf, 0, CVT_SPLIT1, F.bid - 64, 192); }
        if constexpr (l == 1) { if (F.G == 256) convert_common(a, F, 2 * CC_PER_LAYER, 4 * CC_PER_LAYER, F.bid - 64, 192); }
        } }
    if (IN(pb + 6)) { PHASE_BEGIN(); {
        pg8::Gemm g{H, WSP(const bf16_t, WS_WOUT) + (size_t)l * 1024 * 1024, DM, DM, DM, 1};
        pg8::Order S; S.init(nMrows, 4, F.G, F.bid, rmode, 1, DM, DM, 0);
        pg8::EpiResid E{XRES, MODl, 2};
        pg8::gemm_phase<pg8::EpiResid, true>(F.lds, g, S, E, F.tid);
        if constexpr (l == 0 || l == 2) { if (F.G == 256) convert_moe(a, F, jf, CVT_SPLIT1, CVT_SPLIT2, F.bid - 64, 192); }
        if constexpr (l == 1) { if (F.G == 256) convert_common(a, F, DEPTH * CC_PER_LAYER + CC_PER_FF, CC_NITEMS, F.bid - 64, 192); } } }
    if (IN(pb + 7)) { PHASE_BEGIN(); {
        NormP P{}; P.X = XRES; P.from_f32 = false; P.outf = nullptr; P.gain = a.in[I_GN2] + l * DM; P.mod = MODl; P.shsel = 3; P.H = H;
        P.combine = false; P.do_norm = true; P.latent_only = last;
        P.wrouter = a.in[I_WROUTER] + (size_t)jf * DM * 8; P.routeA = routeA; P.routeWout = routeW; P.cnt = cnt; P.inv = WSP(int, WS_INV);
        if (moe) norm_job<true>(P, F); else norm_job<false>(P, F); } }
    if constexpr (moe) {
        if (IN(pb + 9)) { PHASE_BEGIN(); {
            int off[9]; moe_offsets(cnt, off);
            for (int ai = F.bid * NTHREADS + F.tid; ai < (last ? NB * SEQ : T); ai += F.G * NTHREADS) { const int row = last ? (ai / SEQ) * LROW + CTXL + (ai % SEQ) : ai;
                const i32x4 ra = routeA[row]; int p0 = ra.y, p1 = ra.w;
#pragma unroll
                for (int e = 0; e < 8; ++e) { p0 += (ra.x == e) ? off[e] : 0; p1 += (ra.z == e) ? off[e] : 0; }
                routeP[row] = (i32x2){p0, p1}; }
            pg8::Gemm g{H, WSP(const bf16_t, WS_WEGU), DM, DM, DM, 0, WSP(const int, WS_INV)};
            pg8::Order S; S.init(off[8] >> 8, 28, F.G, F.bid, 2, 1, DM, DM, 0); S.n_per_group = 7168; S.gathered = true;
#pragma unroll
            for (int e = 0; e < 9; ++e) S.tstart[e] = off[e] >> 8;
            pg8::EpiSwiGLU E{HIDM, DFF};
            pg8::gemm_phase<pg8::EpiSwiGLU, true, true>(F.lds, g, S, E, F.tid); } }
        if (IN(pb + 10)) { PHASE_BEGIN(); {
            int off[9]; moe_offsets(cnt, off);
            pg8::Gemm g{HIDM, WSP(const bf16_t, WS_WED), DFF, DFF, DFF, 1};
            pg8::Order S; S.init(off[8] >> 8, 4, F.G, F.bid, 2, 1, DFF, DFF, 0); S.n_per_group = 1024;
#pragma unroll
            for (int e = 0; e < 9; ++e) S.tstart[e] = off[e] >> 8;
            pg8::EpiPlain E{HP, DM};
            pg8::gemm_phase<pg8::EpiPlain, true>(F.lds, g, S, E, F.tid); } }
    } else {
        if (IN(pb + 9)) { PHASE_BEGIN(); {
            pg8::Gemm g{H, WSP(const bf16_t, WS_WFFGU) + (size_t)jf * 7168 * 1024, DM, DM, DM, 0};
            pg8::Order S; S.init(T / 256, 28, F.G, F.bid, 0, 1, DM, DM, 0);
            pg8::EpiSwiGLU E{HID, DFF};
            pg8::gemm_phase<pg8::EpiSwiGLU, true>(F.lds, g, S, E, F.tid); } }
        if (IN(pb + 10)) { PHASE_BEGIN(); {
            pg8::Gemm g{HID, WSP(const bf16_t, WS_WFFD) + (size_t)jf * 1024 * DFF, DFF, DFF, DFF, 1};
            pg8::Order S; S.init(T / 256, 4, F.G, F.bid, 0, 1, DFF, DFF, 0);
            pg8::EpiResid E{XRES, MODl, 5};
            pg8::gemm_phase<pg8::EpiResid, true>(F.lds, g, S, E, F.tid);
            if (F.G == 256) convert_moe(a, F, jf, CVT_SPLIT2, MOE_CVT_ITEMS, F.bid - 64, 192);
            else { __syncthreads(); convert_moe(a, F, jf, 0, MOE_CVT_ITEMS, F.bid, F.G); } } }
    }
}

__global__ void __launch_bounds__(NTHREADS, 2) fwd_kernel(Args a) {
    extern __shared__ __attribute__((aligned(16))) unsigned char lds_raw[];
    Frame F;
    F.lds = (LAS unsigned char*)lds_raw; F.tid = threadIdx.x; F.lane = F.tid & 63; F.wave = __builtin_amdgcn_readfirstlane(F.tid >> 6); F.G = gridDim.x; F.bid = blockIdx.x; F.ws = a.ws;
    volatile LAS unsigned* MISC = (volatile LAS unsigned*)(F.lds + LDSCTL_OFF);
    if (F.tid < 64) MISC[F.tid] = 0u;
    __syncthreads();
    XcdBarrier bar = xcd_barrier_post((unsigned*)(a.ws + WS_CTL) + CW_BAR, MISC + 8);
    const int lo = a.ph_lo, hi = a.ph_hi;
    bool need_bar = false;
    if (IN(0)) { PHASE_BEGIN(); {
        if (F.G == 256) { convert_common(a, F, 0, 2 * CC_PER_LAYER, F.bid, F.G); convert_common(a, F, DEPTH * CC_PER_LAYER, DEPTH * CC_PER_LAYER + CC_PER_FF, F.bid, F.G); }
        else convert_common(a, F, 0, CC_NITEMS, F.bid, F.G);
        rope_table_job((f32x2*)(a.ws + WS_TAB), F); __syncthreads(); mod_job(a, F); } }
    layer_phases<0>(a, F, bar, need_bar, lo, hi);
    layer_phases<1>(a, F, bar, need_bar, lo, hi);
    layer_phases<2>(a, F, bar, need_bar, lo, hi);
    layer_phases<3>(a, F, bar, need_bar, lo, hi);
    if (IN(NPHASE - 1)) { PHASE_BEGIN(); {
        unsigned char* ws = a.ws;
        NormP P{}; P.X = WSP(bf16_t, WS_XRES); P.from_f32 = false; P.outf = a.out; P.combine = true; P.Y = WSP(bf16_t, A_HP); P.routeP = WSP(i32x2, WS_ROUTE_P); P.routeW = WSP(f32x2, WS_ROUTE_W);
        P.modprev = WSP(float, WS_MOD) + (size_t)(DEPTH - 1) * NMOD * 6144; P.do_norm = false; P.latent_only = true;
        norm_job<false>(P, F); } }
}
#undef IN
#undef PHASE_BEGIN

extern "C" void kernel_launch(void* const* d_in, const int* in_sizes, int n_in, void* d_out, int out_size, void* d_ws, size_t ws_size, hipStream_t stream) {
    static int grid = 0;
    if (grid == 0) {
        if (n_in != 38 || out_size != NB * SEQ * DM || ws_size < WS_END) { fprintf(stderr, "kernel_launch: unexpected shapes (n_in %d out %d ws %zu need %zu)\n", n_in, out_size, ws_size, (size_t)WS_END); grid = -1; return; }
        int dev = 0, cus = 0;
        if (hipGetDevice(&dev) != hipSuccess || hipDeviceGetAttribute(&cus, hipDeviceAttributeMultiprocessorCount, dev) != hipSuccess) { grid = -1; return; }
        if (hipFuncSetAttribute((const void*)fwd_kernel, hipFuncAttributeMaxDynamicSharedMemorySize, LDS_BYTES) != hipSuccess) { fprintf(stderr, "kernel_launch: hipFuncSetAttribute failed\n"); grid = -1; return; }
        int per_cu = 0;
        if (hipOccupancyMaxActiveBlocksPerMultiprocessor(&per_cu, (const void*)fwd_kernel, NTHREADS, LDS_BYTES) != hipSuccess || per_cu < 1) { fprintf(stderr, "kernel_launch: occupancy query says %d\n", per_cu); }
        (void)hipGetLastError();
        grid = cus;
    }
    if (grid < 0) return;
    (void)hipMemsetAsync((char*)d_ws + WS_CTL, 0, CTL_BYTES, stream);
    Args a{};
    for (int i = 0; i < 38; ++i) a.in[i] = (const float*)d_in[i];
    a.out = (float*)d_out; a.ws = (unsigned char*)d_ws;
#if MK_ONE_LAUNCH
    a.ph_lo = 0; a.ph_hi = NPHASE;
    hipLaunchKernelGGL(fwd_kernel, dim3(grid), dim3(NTHREADS), LDS_BYTES, stream, a);
#else
    for (int k = 0; k < NPHASE; ++k) {
        if (k >= 1 && k < NPHASE - 1) { const int l = (k - 1) / PH_PER_LAYER, p = (k - 1) % PH_PER_LAYER; if (p == 8 && !(l & 1)) continue; }
        a.ph_lo = k; a.ph_hi = k + 1;
        hipLaunchKernelGGL(fwd_kernel, dim3(grid), dim3(NTHREADS), LDS_BYTES, stream, a);
    }
#endif
}
```

```cpp
#include <hip/hip_runtime.h>
#include <cstdio>
#include <cstdint>

#ifndef MK_ONE_LAUNCH
#define MK_ONE_LAUNCH 1
#endif

#define LAS __attribute__((address_space(3)))
#define GAS __attribute__((address_space(1)))
typedef unsigned short bf16_t;
typedef short bf16x8 __attribute__((ext_vector_type(8)));
typedef short s16x4 __attribute__((ext_vector_type(4)));
typedef float f32x2 __attribute__((ext_vector_type(2)));
typedef float f32x4 __attribute__((ext_vector_type(4)));
typedef float f32x16 __attribute__((ext_vector_type(16)));
typedef unsigned u32x2 __attribute__((ext_vector_type(2)));
typedef unsigned u32x4 __attribute__((ext_vector_type(4)));
typedef int i32x4 __attribute__((ext_vector_type(4)));
typedef int i32x2 __attribute__((ext_vector_type(2)));

constexpr int DM = 1024, NB = 16, SEQ = 2048, CTXL = 256, LROW = CTXL + SEQ  , T = NB * LROW  , DEPTH = 4;
constexpr int IN_COLS = 6176, NWIN = 6144, DFF = 3584, NEXP = 8, NMOD = 17;
constexpr int MOE_ROWS_MAX = 75776;
constexpr float NORM_EPS = 1e-6f;
constexpr float QSCALE = 0.10206207261596577f * 1.4426950408889634f;
constexpr int NTHREADS = 512, NWAVES = 8;

constexpr size_t al256(size_t x) { return (x + 255) & ~(size_t)255; }
constexpr size_t WS_CTL = 0, CTL_BYTES = 1u << 20;
constexpr size_t WS_MOD = WS_CTL + CTL_BYTES;
constexpr size_t WS_XRES = WS_MOD + al256((size_t)DEPTH * NMOD * 6144 * 4);
constexpr size_t WS_ROUTE_A = WS_XRES + (size_t)T * DM * 2;
constexpr size_t WS_ROUTE_W = WS_ROUTE_A + (size_t)T * 16;
constexpr size_t WS_ROUTE_P = WS_ROUTE_W + (size_t)T * 8;
constexpr size_t WS_TAB = WS_ROUTE_P + (size_t)T * 8;
constexpr size_t WS_STATS = WS_TAB + 4096;
constexpr size_t WS_INV = WS_STATS + (size_t)T * 32;
constexpr size_t WS_WIN = WS_INV + (size_t)8 * T * 4;
constexpr size_t WS_WQB = WS_WIN + (size_t)DEPTH * NWIN * DM * 2;
constexpr size_t WS_WKVB = WS_WQB + (size_t)DEPTH * 1024 * 768 * 2;
constexpr size_t WS_WCAT = WS_WKVB + (size_t)DEPTH * 1024 * 256 * 2;
constexpr size_t WS_WOUT = WS_WCAT + (size_t)DEPTH * 1024 * 1536 * 2;
constexpr size_t WS_WREC = WS_WOUT + (size_t)DEPTH * 1024 * 1024 * 2;
constexpr size_t WS_WKR = WS_WREC + (size_t)DEPTH * 2 * 2 * 8 * 4096 * 2;
constexpr size_t WS_WFFGU = WS_WKR + (size_t)DEPTH * 64 * 512 * 2;
constexpr size_t WS_WFFD = WS_WFFGU + (size_t)2 * 7168 * 1024 * 2;
constexpr size_t WS_WEGU = WS_WFFD + (size_t)2 * 1024 * 3584 * 2;
constexpr size_t WS_WED = WS_WEGU + (size_t)NEXP * 7168 * 1024 * 2;
constexpr size_t WS_ARENA = WS_WED + (size_t)NEXP * 1024 * 3584 * 2;
constexpr size_t A_H = WS_ARENA;
constexpr size_t A_G = A_H + (size_t)T * 1024 * 2;
constexpr size_t A_ZR = A_G + (size_t)T * 3072 * 2;
constexpr size_t A_ZQ = A_ZR + (size_t)T * 1024 * 2;
constexpr size_t A_Q = A_ZQ + (size_t)T * 768 * 2;
constexpr size_t A_ZKV = A_Q + (size_t)T * 768 * 2;
constexpr size_t A_KR = A_ZKV + (size_t)T * 256 * 2;
constexpr size_t A_KVR = A_KR + (size_t)T * 32 * 2;
constexpr size_t A_U = A_KVR + (size_t)T * 1024 * 2;
constexpr size_t A_CAT = A_U + (size_t)T * 512 * 2;
constexpr size_t A_SUM = A_CAT + (size_t)T * 1536 * 2;
constexpr size_t A_CAR = A_SUM + (size_t)NB * 8 * 2 * 72 * 2 * 64 * 4;
constexpr size_t A_MIX_END = A_CAR + (size_t)NB * 8 * 2 * 72 * 64 * 4;
constexpr size_t A_HID = A_G;
constexpr size_t A_HP = A_G;
constexpr size_t A_HIDM = A_HP + (size_t)MOE_ROWS_MAX * 1024 * 2;
constexpr size_t A_MOE_END = A_HIDM + (size_t)MOE_ROWS_MAX * 3584 * 2;
constexpr size_t WS_END = A_MIX_END > A_MOE_END ? A_MIX_END : A_MOE_END;
static_assert(WS_END < 1203000000ull, "workspace map must fit under sum(inputs)");
constexpr int CW_BAR = 4096, CW_CNT = 16384;

constexpr int RING_BYTES = 131072, LDS_BYTES = 147456, LDSCTL_OFF = LDS_BYTES - 1024;

__device__ __forceinline__ unsigned cvt_pk_bf16(float lo, float hi) { unsigned r; asm volatile("v_cvt_pk_bf16_f32 %0, %1, %2" : "=v"(r) : "v"(lo), "v"(hi)); return r; }
__device__ __forceinline__ float bf2f(unsigned short b) { return __uint_as_float(((unsigned)b) << 16); }
__device__ __forceinline__ float bflo(unsigned w) { return __uint_as_float(w << 16); }
__device__ __forceinline__ float bfhi(unsigned w) { return __uint_as_float(w & 0xffff0000u); }
__device__ __forceinline__ float fast_exp2(float x) { return __builtin_amdgcn_exp2f(x); }
__device__ __forceinline__ float fast_rcp(float x) { return __builtin_amdgcn_rcpf(x); }
__device__ __forceinline__ float sigmoidf_(float x) { return fast_rcp(1.0f + fast_exp2(-1.4426950408889634f * x)); }
__device__ __forceinline__ float siluf_(float x) { return x * sigmoidf_(x); }
__device__ __forceinline__ float gelu_tanh_(float x) { const float u = 0.7978845608028654f * (x + 0.044715f * x * x * x); return x * fast_rcp(1.0f + fast_exp2(-2.885390081777927f * u)); }
__device__ __forceinline__ float wave_sum(float v) {
    int x = __float_as_int(v);
    v += __int_as_float(__builtin_amdgcn_update_dpp(0, x, 0xB1, 0xF, 0xF, false)); x = __float_as_int(v);
    v += __int_as_float(__builtin_amdgcn_update_dpp(0, x, 0x4E, 0xF, 0xF, false)); x = __float_as_int(v);
    v += __int_as_float(__builtin_amdgcn_update_dpp(0, x, 0x141, 0xF, 0xF, false)); x = __float_as_int(v);
    v += __int_as_float(__builtin_amdgcn_update_dpp(0, x, 0x140, 0xF, 0xF, false)); x = __float_as_int(v);
    return (__int_as_float(__builtin_amdgcn_readlane(x, 0)) + __int_as_float(__builtin_amdgcn_readlane(x, 16))) + (__int_as_float(__builtin_amdgcn_readlane(x, 32)) + __int_as_float(__builtin_amdgcn_readlane(x, 48)));
}
__device__ __forceinline__ float sum_x16(float v) { auto r = __builtin_amdgcn_permlane16_swap(__float_as_uint(v), __float_as_uint(v), false, false); return __uint_as_float(r[0]) + __uint_as_float(r[1]); }
__device__ __forceinline__ float sum_x32(float v) { auto r = __builtin_amdgcn_permlane32_swap(__float_as_uint(v), __float_as_uint(v), false, false); return __uint_as_float(r[0]) + __uint_as_float(r[1]); }
__device__ __forceinline__ float row16_sum(float v) {
    int x = __float_as_int(v);
    v += __int_as_float(__builtin_amdgcn_update_dpp(0, x, 0xB1, 0xF, 0xF, false)); x = __float_as_int(v);
    v += __int_as_float(__builtin_amdgcn_update_dpp(0, x, 0x4E, 0xF, 0xF, false)); x = __float_as_int(v);
    v += __int_as_float(__builtin_amdgcn_update_dpp(0, x, 0x141, 0xF, 0xF, false)); x = __float_as_int(v);
    v += __int_as_float(__builtin_amdgcn_update_dpp(0, x, 0x140, 0xF, 0xF, false));
    return v;
}
#define LDS_WAIT() asm volatile("s_waitcnt lgkmcnt(0)" ::: "memory")
#define VM_WAIT() asm volatile("s_waitcnt vmcnt(0)" ::: "memory")

#define XB_TMO      128
#define XB_XCNT(j)  (256  + 64 * (j))
#define XB_XSUB(j)  (1280 + 64 * (j))
#define XB_XGEN(j)  (2304 + 64 * (j))
#define XB_TOP      3328
#define XB_TOPGEN   3392
#define XCD_BAR_WORDS 3456
#define XB_SPIN_CAP (1u << 20)
__device__ __forceinline__ unsigned xb_ld(unsigned* p)              { return __hip_atomic_load(p, __ATOMIC_RELAXED, __HIP_MEMORY_SCOPE_AGENT); }
__device__ __forceinline__ unsigned xb_add(unsigned* p, unsigned v) { return __hip_atomic_fetch_add(p, v, __ATOMIC_RELAXED, __HIP_MEMORY_SCOPE_AGENT); }
__device__ __forceinline__ unsigned xb_xcc_id() { return (unsigned)__builtin_amdgcn_s_getreg((3 << 11) | 20) & 0xFu; }
#define XB_SPIN(cond, bar) do { unsigned _sp = 0; while (cond) { __builtin_amdgcn_s_sleep(1); \
    if ((++_sp & 255u) == 0u) { if (xb_ld(&(bar)[XB_TMO])) break; if (_sp > XB_SPIN_CAP) { atomicAdd(&(bar)[XB_TMO], 1u); break; } } } } while (0)
struct XcdBarrier { unsigned* bar; unsigned x; volatile LAS unsigned* st; };
__device__ __forceinline__ XcdBarrier xcd_barrier_post(unsigned* bar, volatile LAS unsigned* st) {
    XcdBarrier b; b.bar = bar; b.x = xb_xcc_id(); b.st = st;
    if (threadIdx.x == 0) (void)xb_add(&bar[XB_XCNT(b.x)], 1u);
    return b;
}
__device__ __forceinline__ void xcd_barrier_complete(unsigned* bar, unsigned x, unsigned& nloc, unsigned& nx) {
    const unsigned G = gridDim.x * gridDim.y * gridDim.z;
    unsigned sum, cnt, mine, sp = 0u;
    for (;;) {
        sum = 0u; cnt = 0u; mine = 0u;
#pragma unroll
        for (unsigned j = 0; j < 16; ++j) { const unsigned c = xb_ld(&bar[XB_XCNT(j)]); sum += c; cnt += (c > 0u) ? 1u : 0u; mine = (j == x) ? c : mine; }
        if (sum == G) break;
        __builtin_amdgcn_s_sleep(1);
        if ((++sp & 255u) == 0u) { if (xb_ld(&bar[XB_TMO])) break; if (sp > XB_SPIN_CAP) { atomicAdd(&bar[XB_TMO], 1u); break; } }
    }
    nloc = mine > 0u ? mine : 1u; nx = cnt > 0u ? cnt : 1u;
}
__device__ __forceinline__ void xcd_barrier(const XcdBarrier& b) {
    asm volatile("s_waitcnt vmcnt(0)" ::: "memory");
    __syncthreads();
    if (threadIdx.x == 0) {
        unsigned* bar = b.bar;
        __builtin_amdgcn_s_waitcnt(0);
        unsigned nloc = b.st[0], nx = b.st[1];
        if (nloc == 0u) { xcd_barrier_complete(bar, b.x, nloc, nx); b.st[0] = nloc; b.st[1] = nx; }
        const unsigned old = xb_add(&bar[XB_XSUB(b.x)], 1u);
        const unsigned gen = old / nloc;
        if (old + 1u == (gen + 1u) * nloc) {
            __builtin_amdgcn_fence(__ATOMIC_RELEASE, "agent");
            asm volatile("s_waitcnt vmcnt(0)" ::: "memory");
            const unsigned og = xb_add(&bar[XB_TOP], 1u);
            const unsigned tg = og / nx;
            if (og + 1u == (tg + 1u) * nx) xb_add(&bar[XB_TOPGEN], 1u);
            else XB_SPIN(xb_ld(&bar[XB_TOPGEN]) == tg, bar);
            __builtin_amdgcn_fence(__ATOMIC_ACQUIRE, "agent");
            xb_add(&bar[XB_XGEN(b.x)], 1u);
            asm volatile("s_waitcnt vmcnt(0)" ::: "memory");
        } else {
            XB_SPIN(xb_ld(&bar[XB_XGEN(b.x)]) == gen, bar);
            __builtin_amdgcn_fence(__ATOMIC_ACQUIRE, "agent");
            asm volatile("s_waitcnt vmcnt(0)" ::: "memory");
        }
    }
    __syncthreads();
}

namespace pg8 {
constexpr int BM = 256, BK = 64, HALF = 128, HTB = HALF * BK * 2, STAGE_BYTES = 8 * HTB, NXCD = 8, WGM = 8;
__host__ __device__ __forceinline__ int lds_byte(int r, int c) { const int st = (r >> 4) * 2 + (c >> 5), rr = r & 15, cc = c & 31, ob = rr * 64 + cc * 2; return st * 1024 + (ob ^ (((ob >> 9) & 1) << 5)); }
__host__ __device__ __forceinline__ void stage_rc(int b, int& R, int& C) { const int st = b / 1024, sb = b % 1024, swz = sb ^ (((sb >> 9) & 1) << 5); R = (st >> 1) * 16 + swz / 64; C = (st & 1) * 32 + (swz % 64) / 2; }
__host__ __device__ __forceinline__ int perm32(int rho) { const int n = rho >> 4, i = rho & 15; return 8 * (i >> 2) + 4 * n + (i & 3); }

struct Unit { int pm, pn, tag, gidx; size_t a_off, b_off; };
struct Gemm { const bf16_t* A; const bf16_t* Bt; int lda, ldb, K; int tiledA; const int* gather = nullptr; };

struct Order {
    int nM, nN, nwg, G, c;
    int mode;
    int nseg;
    int lda_rows;
    int ldb_rows;
    int seg_k;
    int n_per_group;
    int tstart[9];
    bool gathered;
    __device__ __forceinline__ void init(int nM_, int nN_, int G_, int c_, int mode_, int nseg_, int lda_, int ldb_, int segk_) {
        nM = nM_; nN = nN_; nwg = nM * nN; G = G_; c = c_; mode = mode_; nseg = nseg_; lda_rows = lda_; ldb_rows = ldb_; seg_k = segk_; n_per_group = 0; gathered = false;
    }
    __device__ __forceinline__ bool next(int i, Unit& u) const {
        const int ti = i / nseg, seg = i - ti * nseg;
        const long L = (long)ti * G + c;
        if (mode == 3) {
            if (L >= nwg + 80) return false;
            if (L >= nwg) { const int idx = (int)L - nwg, cb = idx / 5, j = idx - cb * 5; u.pm = cb * 9; u.pn = 7 + j; u.tag = 0; u.gidx = 0;
                u.a_off = (size_t)u.pm * BM * lda_rows; u.b_off = (size_t)u.pn * BM * ldb_rows; return true; }
        }
        if (L >= nwg) return false;
        int wgid = (int)L; { const int q = nwg / NXCD, r = nwg % NXCD, xcd = wgid % NXCD, off = wgid / NXCD; wgid = (xcd < r ? xcd * (q + 1) : r * (q + 1) + (xcd - r) * q) + off; }
        const int nig = WGM * nN, gid = wgid / nig, fm = gid * WGM, gsz = (nM - fm) < WGM ? (nM - fm) : WGM;
        int pm = fm + ((wgid % nig) % gsz); const int pn = (wgid % nig) / gsz;
        int grp = 0, gts = 0;
        if (mode == 1 || mode == 3) pm = (pm >> 3) * 9 + 1 + (pm & 7);
        if (mode == 2) {
#pragma unroll
            for (int e = 1; e < 8; ++e) { const bool ge = pm >= tstart[e]; grp += ge ? 1 : 0; gts = ge ? tstart[e] : gts; }
        }
        u.pm = pm; u.pn = pn; u.tag = (mode == 2) ? grp : seg; u.gidx = (mode == 2) ? grp * T + (pm - gts) * BM : 0;
        u.a_off = (gathered ? (size_t)0 : (size_t)pm * BM * lda_rows) + (size_t)seg * seg_k;
        u.b_off = ((size_t)grp * n_per_group + (size_t)pn * BM) * ldb_rows + (size_t)seg * seg_k * BM;
        return true;
    }
};

typedef f32x4 Acc[2][2][4][2];

template <class Epi, bool ALIGN_EPI, bool GATHER = false>
__device__ __forceinline__ void gemm_phase(LAS unsigned char* lds, const Gemm g, const Order& S, const Epi& E, const int tid) {
    const int wid = __builtin_amdgcn_readfirstlane(tid >> 6), lane = tid & 63, wr = wid >> 2, wc = wid & 3, fr = lane & 15, fq = lane >> 4;
    const int nt = g.K / BK;
    unsigned voffA[2], voffB[2];
#pragma unroll
    for (int i = 0; i < 2; ++i) { int R, C; stage_rc(tid * 16 + i * 8192, R, C); const int Rb = Epi::PERM ? ((R & ~31) + perm32(R & 31)) : R;
        voffA[i] = g.tiledA ? (unsigned)(tid * 16 + i * 8192) : (unsigned)(R * g.lda + C) * 2u; voffB[i] = (unsigned)(tid * 16 + i * 8192); (void)Rb; }
    int gR[2], gC[2]; unsigned cvo0[2] = {0u, 0u}, cvo1[2] = {0u, 0u}, nvo0[2] = {0u, 0u}, nvo1[2] = {0u, 0u};
#pragma unroll
    for (int i = 0; i < 2; ++i) stage_rc(tid * 16 + i * 8192, gR[i], gC[i]);
#define PG8_GLOAD(u_, o0, o1) do { _Pragma("unroll") for (int _i = 0; _i < 2; ++_i) { \
        o0[_i] = (unsigned)(g.gather[(u_).gidx + gR[_i]] * g.lda + gC[_i]) * 2u; o1[_i] = (unsigned)(g.gather[(u_).gidx + HALF + gR[_i]] * g.lda + gC[_i]) * 2u; } } while (0)
    const size_t kstep = (size_t)(BK * 2), kstepA = g.tiledA ? (size_t)32768 : kstep;
    const size_t hstepA = g.tiledA ? (size_t)16384 : (size_t)HALF * g.lda * 2, hstepB = 16384, kstepB = 32768;
    static_assert(Epi::PERM, "the tiled weight copies carry the PERM row order");
    const unsigned ldsw = (unsigned)wid * 1024u;
    const int aoff = lds_byte(wr * 64 + fr, fq * 8), boff = lds_byte(wc * 32 + fr, fq * 8);
#define PG8_SA(b, h) (((b) * 2 + (h)) * HTB)
#define PG8_SB(b, h) ((4 + (b) * 2 + (h)) * HTB)
#define PG8_STAGE(bufoff, gbase, voff) do { _Pragma("unroll") for (int _i = 0; _i < 2; ++_i) \
        __builtin_amdgcn_global_load_lds((const unsigned*)((const char*)(gbase) + (voff)[_i]), (LAS unsigned*)(lds + (bufoff) + ldsw + _i * 8192), 16, 0, 0); } while (0)
#define PG8_STA(bufoff, gbase, h, v0, v1) do { if constexpr (GATHER) { if (h) PG8_STAGE(bufoff, gbase, v1); else PG8_STAGE(bufoff, gbase, v0); } else PG8_STAGE(bufoff, (gbase) + (h) * hstepA, voffA); } while (0)
#define PG8_LDA(dst, b, h) do { _Pragma("unroll") for (int m = 0; m < 4; ++m) _Pragma("unroll") for (int k = 0; k < 2; ++k) dst[m][k] = *(const LAS bf16x8*)(lds + PG8_SA(b, h) + aoff + m * 2048 + k * 1024); } while (0)
#define PG8_LDB(dst, b, h) do { _Pragma("unroll") for (int n = 0; n < 2; ++n) _Pragma("unroll") for (int k = 0; k < 2; ++k) dst[n][k] = *(const LAS bf16x8*)(lds + PG8_SB(b, h) + boff + n * 2048 + k * 1024); } while (0)
#define PG8_MMA(ai, bj, At, Bt) do { __builtin_amdgcn_s_setprio(1); _Pragma("unroll") for (int m = 0; m < 4; ++m) _Pragma("unroll") for (int n = 0; n < 2; ++n) _Pragma("unroll") for (int k = 0; k < 2; ++k) \
        acc[ai][bj][m][n] = __builtin_amdgcn_mfma_f32_16x16x32_bf16(Bt[n][k], At[m][k], acc[ai][bj][m][n], 0, 0, 0); __builtin_amdgcn_s_setprio(0); } while (0)
#define PG8_WAIT_V(n) asm volatile("s_waitcnt vmcnt(" #n ")" ::: "memory")
#define PG8_WAIT_L(n) asm volatile("s_waitcnt lgkmcnt(" #n ")" ::: "memory")
#define PG8_BAR __builtin_amdgcn_s_barrier()
#define PG8_SCHED __builtin_amdgcn_sched_barrier(0)
    Unit cur, nxt; int ui = 0;
    if (!S.next(0, cur)) return;
    Acc acc;
#pragma unroll
    for (int a = 0; a < 2; ++a)
#pragma unroll
        for (int b = 0; b < 2; ++b)
#pragma unroll
            for (int m = 0; m < 4; ++m)
#pragma unroll
                for (int n = 0; n < 2; ++n) acc[a][b][m][n] = (f32x4){0.f, 0.f, 0.f, 0.f};
    bf16x8 At[4][2], B0[2][2], B1[2][2];
    const char* cA = (const char*)g.A + cur.a_off * 2; const char* cB = (const char*)g.Bt + cur.b_off * 2;
    if constexpr (GATHER) PG8_GLOAD(cur, cvo0, cvo1);
    PG8_STAGE(PG8_SB(0, 0), cB, voffB); PG8_STAGE(PG8_SB(0, 1), cB + hstepB, voffB); PG8_STA(PG8_SA(0, 0), cA, 0, cvo0, cvo1); PG8_STA(PG8_SA(0, 1), cA, 1, cvo0, cvo1);
    if (wr == 1) PG8_BAR;
    PG8_WAIT_V(2); PG8_BAR;
    PG8_STAGE(PG8_SB(1, 0), cB + kstepB, voffB); PG8_STA(PG8_SA(1, 0), cA + kstepA, 0, cvo0, cvo1); PG8_STAGE(PG8_SB(1, 1), cB + hstepB + kstepB, voffB);
    PG8_WAIT_V(6); PG8_BAR;
    for (;;) {
        const bool has_next = S.next(ui + 1, nxt);
        const char* nA = has_next ? (const char*)g.A + nxt.a_off * 2 : cA; const char* nB = has_next ? (const char*)g.Bt + nxt.b_off * 2 : cB;
        if constexpr (GATHER) { if (has_next) {
#pragma unroll
            for (int k = 0; k < 4; ++k) __builtin_amdgcn_global_load_lds((const unsigned*)(g.gather + nxt.gidx + (k >> 1) * HALF + gR[k & 1]), (LAS unsigned*)(lds + RING_BYTES + (wid * 4 + k) * 256), 4, 0, 0); } }
        for (int t = 0; t < nt; t += 2) {
            const bool last = (t == nt - 2);
            const char* a1 = cA + (size_t)(t + 1) * kstepA;
            const char* a2 = last ? nA : cA + (size_t)(t + 2) * kstepA; const char* b2 = last ? nB : cB + (size_t)(t + 2) * kstepB;
            const char* a3 = a2 + kstepA; const char* b3 = b2 + kstepB;
            unsigned s0[2] = {0u, 0u}, s1[2] = {0u, 0u};
            if constexpr (GATHER) {
                if (last && has_next) {
#pragma unroll
                    for (int i = 0; i < 2; ++i) { const int t0 = *(const LAS int*)(lds + RING_BYTES + (wid * 4 + i) * 256 + lane * 4), t1 = *(const LAS int*)(lds + RING_BYTES + (wid * 4 + 2 + i) * 256 + lane * 4);
                        nvo0[i] = (unsigned)(t0 * g.lda + gC[i]) * 2u; nvo1[i] = (unsigned)(t1 * g.lda + gC[i]) * 2u; } }
                else if (last) { nvo0[0] = cvo0[0]; nvo0[1] = cvo0[1]; nvo1[0] = cvo1[0]; nvo1[1] = cvo1[1]; }
                s0[0] = last ? nvo0[0] : cvo0[0]; s0[1] = last ? nvo0[1] : cvo0[1]; s1[0] = last ? nvo1[0] : cvo1[0]; s1[1] = last ? nvo1[1] : cvo1[1]; }
            PG8_LDB(B0, 0, 0); PG8_LDB(B1, 0, 1); PG8_SCHED; PG8_LDA(At, 0, 0); PG8_STA(PG8_SA(1, 1), a1, 1, cvo0, cvo1);
            PG8_WAIT_V(8); PG8_WAIT_L(0); PG8_BAR; PG8_MMA(0, 0, At, B0); PG8_MMA(0, 1, At, B1); PG8_BAR; PG8_SCHED;
            PG8_LDA(At, 0, 1); PG8_STAGE(PG8_SB(0, 0), b2, voffB); PG8_STAGE(PG8_SB(0, 1), b2 + hstepB, voffB); PG8_STA(PG8_SA(0, 0), a2, 0, s0, s1);
            PG8_WAIT_V(8); PG8_WAIT_L(0); PG8_BAR; PG8_MMA(1, 0, At, B0); PG8_MMA(1, 1, At, B1); PG8_BAR; PG8_SCHED;
            PG8_LDB(B0, 1, 0); PG8_LDB(B1, 1, 1); PG8_SCHED; PG8_LDA(At, 1, 0); PG8_STA(PG8_SA(0, 1), a2, 1, s0, s1);
            PG8_WAIT_V(8); PG8_WAIT_L(0); PG8_BAR; PG8_MMA(0, 0, At, B0); PG8_MMA(0, 1, At, B1); PG8_BAR; PG8_SCHED;
            PG8_LDA(At, 1, 1); PG8_STAGE(PG8_SB(1, 0), b3, voffB); PG8_STAGE(PG8_SB(1, 1), b3 + hstepB, voffB); PG8_STA(PG8_SA(1, 0), a3, 0, s0, s1);
            PG8_WAIT_V(8); PG8_WAIT_L(0); PG8_BAR; PG8_MMA(1, 0, At, B0); PG8_MMA(1, 1, At, B1); PG8_BAR; PG8_SCHED;
        }
        if constexpr (ALIGN_EPI) { if (wr == 0) PG8_BAR; }
        E(acc, cur, wr, wc, fr, fq);
        if (!has_next) break;
        if constexpr (!Epi::KEEP_ACC) {
#pragma unroll
            for (int a = 0; a < 2; ++a)
#pragma unroll
                for (int b = 0; b < 2; ++b)
#pragma unroll
                    for (int m = 0; m < 4; ++m)
#pragma unroll
                        for (int n = 0; n < 2; ++n) acc[a][b][m][n] = (f32x4){0.f, 0.f, 0.f, 0.f};
        }
        cur = nxt; cA = nA; cB = nB; ++ui;
        if constexpr (GATHER) { cvo0[0] = nvo0[0]; cvo0[1] = nvo0[1]; cvo1[0] = nvo1[0]; cvo1[1] = nvo1[1]; }
        if constexpr (ALIGN_EPI) { if (wr == 1) PG8_BAR; }
    }
    PG8_WAIT_V(0);
    if constexpr (!ALIGN_EPI) { if (wr == 0) PG8_BAR; }
    PG8_BAR;
#undef PG8_SA
#undef PG8_SB
#undef PG8_STAGE
#undef PG8_LDA
#undef PG8_STA
#undef PG8_GLOAD
#undef PG8_LDB
#undef PG8_MMA
#undef PG8_WAIT_V
#undef PG8_WAIT_L
#undef PG8_BAR
#undef PG8_SCHED
}

__device__ __forceinline__ u32x4 pack8(const f32x4 v0, const f32x4 v1) { u32x4 w; w.x = cvt_pk_bf16(v0[0], v0[1]); w.y = cvt_pk_bf16(v0[2], v0[3]); w.z = cvt_pk_bf16(v1[0], v1[1]); w.w = cvt_pk_bf16(v1[2], v1[3]); return w; }
__device__ __forceinline__ void unpack8(const u32x4 w, f32x4& v0, f32x4& v1) { v0 = (f32x4){bflo(w.x), bfhi(w.x), bflo(w.y), bfhi(w.y)}; v1 = (f32x4){bflo(w.z), bfhi(w.z), bflo(w.w), bfhi(w.w)}; }

__device__ __forceinline__ size_t tiled_a_off(int pm, int Ktot, int ai, int wr, int m, int fr, int fq, int c) {
    const int kt = c >> 6, st = ((4 * wr + m) << 1) + ((c >> 5) & 1), ob = (64 * fr + 16 * fq) ^ ((fr >> 3) << 5);
    return (size_t)pm * BM * Ktot + (size_t)kt * 16384 + ai * 8192 + st * 512 + (ob >> 1);
}
struct EpiPlain {
    static constexpr bool PERM = true, KEEP_ACC = false;
    bf16_t* O; int ldc;
    __device__ __forceinline__ void operator()(Acc& acc, const Unit& u, int wr, int wc, int fr, int fq) const {
        const int row0 = u.pm * BM + wr * 64 + fr, col0 = u.pn * BM + wc * 32 + 8 * fq;
#pragma unroll
        for (int ai = 0; ai < 2; ++ai)
#pragma unroll
            for (int m = 0; m < 4; ++m) { bf16_t* rowp = O + (size_t)(row0 + ai * HALF + m * 16) * ldc + col0;
#pragma unroll
                for (int bj = 0; bj < 2; ++bj) *(u32x4*)(rowp + bj * HALF) = pack8(acc[ai][bj][m][0], acc[ai][bj][m][1]); }
    }
};
struct EpiQ {
    static constexpr bool PERM = true, KEEP_ACC = false;
    bf16_t* Q; const float* gqn; const unsigned long long* stats; LAS float* red;
    __device__ __forceinline__ void operator()(Acc& acc, const Unit& u, int wr, int wc, int fr, int fq) const {
        asm volatile("" : "+v"(fr), "+v"(fq));
        const int b = u.pm / 9, tq = u.pm - b * 9, row0 = u.pm * BM + wr * 64 + fr;
        LAS f32x4* info = (LAS f32x4*)(red + 1536);
        const int rl = wc * 64 + fq * 16 + fr;
        unsigned long long s0 = 0;
        if (wr == 0) s0 = stats[(size_t)(u.pm * BM + rl) * 4];
        float g[8];
#pragma unroll
        for (int j = 0; j < 8; ++j) g[j] = gqn[32 * (wc < 3 ? wc : 0) + 8 * fq + j];
        if (wc < 3) {
#pragma unroll
            for (int ai = 0; ai < 2; ++ai)
#pragma unroll
                for (int bj = 0; bj < 2; ++bj)
#pragma unroll
                    for (int m = 0; m < 4; ++m) { const f32x4 p = acc[ai][bj][m][0] * acc[ai][bj][m][0] + acc[ai][bj][m][1] * acc[ai][bj][m][1];
                        float sq = (p[0] + p[1]) + (p[2] + p[3]); sq = sum_x32(sum_x16(sq));
                        if (fq == 0) red[((wr * 4 + ai * 2 + bj) * 3 + wc) * 64 + m * 16 + fr] = sq; }
        }
        asm volatile("s_waitcnt lgkmcnt(0)" ::: "memory"); __builtin_amdgcn_s_barrier(); asm volatile("" ::: "memory");
        if (wr == 0) {
            const float r = 1.0f / sqrtf((float)s0 * (1.0f / (1048576.0f * 768.0f)) + NORM_EPS);
            const int ri = ((((rl >> 6) & 1) * 4 + (rl >> 7) * 2) * 3) * 64 + (rl & 63);
            const float ss0 = red[ri] + red[ri + 64] + red[ri + 128], ss1 = red[ri + 192] + red[ri + 256] + red[ri + 320];
            info[rl] = (f32x4){r * QSCALE / sqrtf(ss0 * r * r * (1.0f / 96.0f) + NORM_EPS), r * QSCALE / sqrtf(ss1 * r * r * (1.0f / 96.0f) + NORM_EPS), 0.f, 0.f};
        }
        asm volatile("s_waitcnt lgkmcnt(0)" ::: "memory"); __builtin_amdgcn_s_barrier(); asm volatile("" ::: "memory");
        if (wc < 3) {
            const float sgn = (fq & 1) ? 1.0f : -1.0f;
#pragma unroll
            for (int ai = 0; ai < 2; ++ai)
#pragma unroll
                for (int m = 0; m < 4; ++m) { const f32x4 inf = info[ai * HALF + wr * 64 + m * 16 + fr]; const int tk = tq * 4 + 2 * ai + wr;
                    bf16_t* qp = Q + (size_t)(row0 + ai * HALF + m * 16) * 768 + 96 * (2 * u.pn) + 32 * wc + 8 * fq;
#pragma unroll
                    for (int bj = 0; bj < 2; ++bj) { const float sc = inf[bj];
                        f32x4 v0, v1;
#pragma unroll
                        for (int i = 0; i < 4; ++i) { v0[i] = acc[ai][bj][m][0][i] * sc * g[i]; v1[i] = acc[ai][bj][m][1][i] * sc * g[4 + i]; }
                        if (wc == 2 && tq > 0) { const LAS f32x4* tp = (const LAS f32x4*)(red + 2560) + ((fq >> 1) == 0 ? (tk - 4) : (16 * m + fr)) * 4;
                            const f32x4 c0 = tp[0], c1 = tp[1], c2 = tp[2], c3 = tp[3];
                            f32x4 p0, p1;
#pragma unroll
                            for (int i = 0; i < 4; ++i) { p0[i] = __shfl_xor(v0[i], 16); p1[i] = __shfl_xor(v1[i], 16); }
                            v0[0] = v0[0] * c0[0] + sgn * p0[0] * c0[1]; v0[1] = v0[1] * c0[2] + sgn * p0[1] * c0[3]; v0[2] = v0[2] * c1[0] + sgn * p0[2] * c1[1]; v0[3] = v0[3] * c1[2] + sgn * p0[3] * c1[3];
                            v1[0] = v1[0] * c2[0] + sgn * p1[0] * c2[1]; v1[1] = v1[1] * c2[2] + sgn * p1[1] * c2[3]; v1[2] = v1[2] * c3[0] + sgn * p1[2] * c3[1]; v1[3] = v1[3] * c3[2] + sgn * p1[3] * c3[3]; }
                        *(u32x4*)(qp + 96 * bj) = pack8(v0, v1); } }
        }
        asm volatile("" :: "v"(g[0]), "v"(g[1]), "v"(g[2]), "v"(g[3]), "v"(g[4]), "v"(g[5]), "v"(g[6]), "v"(g[7]));
    }
};
struct EpiKV {
    static constexpr bool PERM = true, KEEP_ACC = false;
    bf16_t* Kt; bf16_t* Vt; const bf16_t* KR; const float* gkn; const unsigned long long* stats; LAS float* red;
    __device__ __forceinline__ void operator()(Acc& acc, const Unit& u, int wr, int wc, int fr, int fq) const {
        asm volatile("" : "+v"(fr), "+v"(fq));
        const int b = u.pm / 9, tq = u.pm - b * 9, row0 = u.pm * BM + wr * 64 + fr;
        const bool kw = wc < 2;
        LAS f32x4* info = (LAS f32x4*)(red + 1536);
        const int rl = wc * 64 + fq * 16 + fr;
        unsigned long long s1 = 0, s2 = 0;
        if (wr == 0) { s1 = stats[(size_t)(u.pm * BM + rl) * 4 + 1]; s2 = stats[(size_t)(u.pm * BM + rl) * 4 + 2]; }
        u32x4 krw[2][4];
#pragma unroll
        for (int ai = 0; ai < 2; ++ai)
#pragma unroll
            for (int m = 0; m < 4; ++m) { krw[ai][m] = (u32x4){0u, 0u, 0u, 0u}; if (!kw) krw[ai][m] = *(const u32x4*)(KR + (size_t)(row0 + ai * HALF + m * 16) * 32 + 8 * fq); }
        float gk[8], gp[8];
#pragma unroll
        for (int j = 0; j < 8; ++j) { gk[j] = gkn[(kw ? 32 * wc : 64) + 8 * fq + j]; gp[j] = gkn[64 + 8 * (fq ^ 1) + j]; }
        if (kw) {
#pragma unroll
            for (int ai = 0; ai < 2; ++ai)
#pragma unroll
                for (int bj = 0; bj < 2; ++bj)
#pragma unroll
                    for (int m = 0; m < 4; ++m) { const f32x4 p = acc[ai][bj][m][0] * acc[ai][bj][m][0] + acc[ai][bj][m][1] * acc[ai][bj][m][1];
                        float sq = (p[0] + p[1]) + (p[2] + p[3]); sq = sum_x32(sum_x16(sq));
                        if (fq == 0) red[((wr * 4 + ai * 2 + bj) * 2 + wc) * 64 + m * 16 + fr] = sq; }
        }
        asm volatile("s_waitcnt lgkmcnt(0)" ::: "memory"); __builtin_amdgcn_s_barrier(); asm volatile("" ::: "memory");
        if (wr == 0) {
            const float r = 1.0f / sqrtf((float)s1 * (1.0f / (1048576.0f * 256.0f)) + NORM_EPS), krss = (float)s2 * (1.0f / 1048576.0f);
            const int ri = ((((rl >> 6) & 1) * 4 + (rl >> 7) * 2) * 2) * 64 + (rl & 63);
            const float ss0 = red[ri] + red[ri + 64], ss1 = red[ri + 128] + red[ri + 192];
            info[rl] = (f32x4){r, 1.0f / sqrtf((ss0 * r * r + krss) * (1.0f / 96.0f) + NORM_EPS), 1.0f / sqrtf((ss1 * r * r + krss) * (1.0f / 96.0f) + NORM_EPS), 0.f};
        }
        asm volatile("s_waitcnt lgkmcnt(0)" ::: "memory"); __builtin_amdgcn_s_barrier(); asm volatile("" ::: "memory");
        if (kw) {
#pragma unroll
            for (int ai = 0; ai < 2; ++ai)
#pragma unroll
                for (int m = 0; m < 4; ++m) { const f32x4 inf = info[ai * HALF + wr * 64 + m * 16 + fr];
#pragma unroll
                    for (int bj = 0; bj < 2; ++bj) { const float sc = inf[0] * inf[1 + bj];
                        f32x4 v0, v1;
#pragma unroll
                        for (int i = 0; i < 4; ++i) { v0[i] = acc[ai][bj][m][0][i] * sc * gk[i]; v1[i] = acc[ai][bj][m][1][i] * sc * gk[4 + i]; }
                        *(u32x4*)(Kt + ((size_t)((b * 8 + 2 * u.pn + bj) * 36 + tq * 4 + 2 * ai + wr) * 12 + 4 * wc + fq) * 512 + (16 * m + fr) * 8) = pack8(v0, v1); } }
        } else {
            const int dh = wc - 2;
            const float sgn = (fq & 1) ? 1.0f : -1.0f;
#pragma unroll
            for (int ai = 0; ai < 2; ++ai)
#pragma unroll
                for (int m = 0; m < 4; ++m) { const int tk = tq * 4 + 2 * ai + wr; const float r = info[ai * HALF + wr * 64 + m * 16 + fr][0];
#pragma unroll
                    for (int bj = 0; bj < 2; ++bj)
                        *(u32x4*)(Vt + ((size_t)(((((b * 8 + 2 * u.pn + bj) * 36 + tk) * 2 + dh) * 4 + m) * 16 + fr)) * 32 + fq * 8) = pack8(acc[ai][bj][m][0] * r, acc[ai][bj][m][1] * r); }
            __builtin_amdgcn_sched_barrier(0);
#pragma unroll
            for (int ai = 0; ai < 2; ++ai)
#pragma unroll
                for (int m = 0; m < 4; ++m) { const int tk = tq * 4 + 2 * ai + wr; const f32x4 inf = info[ai * HALF + wr * 64 + m * 16 + fr]; const float n = dh ? inf[2] : inf[1];
                    const u32x4 wo = krw[ai][m]; u32x4 wp;
                    wp.x = (unsigned)__shfl_xor((int)wo.x, 16); wp.y = (unsigned)__shfl_xor((int)wo.y, 16); wp.z = (unsigned)__shfl_xor((int)wo.z, 16); wp.w = (unsigned)__shfl_xor((int)wo.w, 16);
                    f32x4 x0, x1, p0, p1; unpack8(wo, x0, x1); unpack8(wp, p0, p1);
                    f32x4 o0, o1;
                    if (tq > 0) { const LAS f32x4* tp = (const LAS f32x4*)(red + 2560) + ((fq >> 1) == 0 ? (tk - 4) : (16 * m + fr)) * 4;
                        const f32x4 c0 = tp[0], c1 = tp[1], c2 = tp[2], c3 = tp[3];
#define EKV_ROT(o, i, xo, xp, j, cc, sv) o[i] = (xo) * n * gk[j] * (cc) + sgn * ((xp) * n * gp[j]) * (sv);
                        EKV_ROT(o0, 0, x0[0], p0[0], 0, c0[0], c0[1]) EKV_ROT(o0, 1, x0[1], p0[1], 1, c0[2], c0[3]) EKV_ROT(o0, 2, x0[2], p0[2], 2, c1[0], c1[1]) EKV_ROT(o0, 3, x0[3], p0[3], 3, c1[2], c1[3])
                        EKV_ROT(o1, 0, x1[0], p1[0], 4, c2[0], c2[1]) EKV_ROT(o1, 1, x1[1], p1[1], 5, c2[2], c2[3]) EKV_ROT(o1, 2, x1[2], p1[2], 6, c3[0], c3[1]) EKV_ROT(o1, 3, x1[3], p1[3], 7, c3[2], c3[3])
#undef EKV_ROT
                    } else {
#pragma unroll
                        for (int i = 0; i < 4; ++i) { o0[i] = x0[i] * n * gk[i]; o1[i] = x1[i] * n * gk[4 + i]; }
                    }
                    *(u32x4*)(Kt + ((size_t)((b * 8 + 2 * u.pn + dh) * 36 + tk) * 12 + 8 + fq) * 512 + (16 * m + fr) * 8) = pack8(o0, o1);
                    __builtin_amdgcn_sched_barrier(0); }
        }
        asm volatile("" :: "v"(gk[0]), "v"(gk[1]), "v"(gk[2]), "v"(gk[3]), "v"(gk[4]), "v"(gk[5]), "v"(gk[6]), "v"(gk[7]));
        asm volatile("" :: "v"(gp[0]), "v"(gp[1]), "v"(gp[2]), "v"(gp[3]), "v"(gp[4]), "v"(gp[5]), "v"(gp[6]), "v"(gp[7]));
    }
};
struct EpiSwiGLU {
    static constexpr bool PERM = true, KEEP_ACC = false;
    bf16_t* O; int ldc;
    __device__ __forceinline__ void operator()(Acc& acc, const Unit& u, int wr, int wc, int fr, int fq) const {
        const int cbase = u.pn * HALF + wc * 32;
#pragma unroll
        for (int ai = 0; ai < 2; ++ai)
#pragma unroll
            for (int m = 0; m < 4; ++m) { bf16_t* rowp = O + tiled_a_off(u.pm, ldc, ai, wr, m, fr, fq, cbase);
                f32x4 v0, v1;
#pragma unroll
                for (int i = 0; i < 4; ++i) { v0[i] = siluf_(acc[ai][0][m][0][i]) * acc[ai][1][m][0][i]; v1[i] = siluf_(acc[ai][0][m][1][i]) * acc[ai][1][m][1][i]; }
                *(u32x4*)rowp = pack8(v0, v1); }
    }
};
struct EpiWin {
    static constexpr bool PERM = true, KEEP_ACC = false;
    bf16_t *U, *ZQ, *ZKV, *ZR, *G, *KR; const float* bgate; unsigned long long* stats;
    __device__ __forceinline__ void operator()(Acc& acc, const Unit& u, int wr, int wc, int fr, int fq) const {
        const int row0 = u.pm * BM + wr * 64 + fr, cl = wc * 32 + 8 * fq, pn = u.pn;
        if (pn < 4) {
#pragma unroll
            for (int ai = 0; ai < 2; ++ai)
#pragma unroll
                for (int m = 0; m < 4; ++m) { bf16_t* rowp = U + (size_t)(row0 + ai * HALF + m * 16) * 512 + pn * HALF + cl;
                    f32x4 v0, v1;
#pragma unroll
                    for (int n = 0; n < 2; ++n)
#pragma unroll
                        for (int i = 0; i < 4; i += 2) {
                            const f32x2 a2 = (f32x2){acc[ai][0][m][n][i], acc[ai][0][m][n][i + 1]}, b2 = (f32x2){acc[ai][1][m][n][i], acc[ai][1][m][n][i + 1]};
                            const f32x2 t = b2 * -1.4426950408889634f;
                            f32x2 e; e.x = fast_exp2(t.x); e.y = fast_exp2(t.y); e = e + 1.0f;
                            f32x2 r; r.x = fast_rcp(e.x); r.y = fast_rcp(e.y);
                            const f32x2 o2 = a2 * r;
                            if (n == 0) { v0[i] = o2.x; v0[i + 1] = o2.y; } else { v1[i] = o2.x; v1[i + 1] = o2.y; } }
                    *(u32x4*)rowp = pack8(v0, v1); }
        } else if (pn == 24) {
            if (wc == 0) {
#pragma unroll
                for (int ai = 0; ai < 2; ++ai)
#pragma unroll
                    for (int m = 0; m < 4; ++m) { const int row = row0 + ai * HALF + m * 16;
                        *(u32x4*)(KR + (size_t)row * 32 + 8 * fq) = pack8(acc[ai][0][m][0], acc[ai][0][m][1]);
                        const f32x4 s4 = acc[ai][0][m][0] * acc[ai][0][m][0] + acc[ai][0][m][1] * acc[ai][0][m][1];
                        float sq = (s4[0] + s4[1]) + (s4[2] + s4[3]); sq = sum_x32(sum_x16(sq));
                        if (fq == 0) (void)__hip_atomic_fetch_add(stats + (size_t)row * 4 + 2, (unsigned long long)(sq * 1048576.0f), __ATOMIC_RELAXED, __HIP_MEMORY_SCOPE_AGENT); }
            }
        } else if (pn >= 12) {
            const int cb = (pn - 12) * BM;
            unsigned char* gq = (unsigned char*)G + ((((size_t)(u.pm * 12 + (pn - 12)) * 8 + (wr * 4 + wc)) * 8) * 64 + (fq * 16 + fr)) * 16;
            f32x4 bv[2][2];
#pragma unroll
            for (int bj = 0; bj < 2; ++bj)
#pragma unroll
                for (int n = 0; n < 2; ++n) bv[bj][n] = *(const f32x4*)(bgate + cb + bj * HALF + cl + 4 * n) * -1.4426950408889634f;
#pragma unroll
            for (int ai = 0; ai < 2; ++ai)
#pragma unroll
                for (int m = 0; m < 4; ++m) { unsigned w[4] = {0u, 0u, 0u, 0u};
#pragma unroll
                    for (int bj = 0; bj < 2; ++bj)
#pragma unroll
                        for (int n = 0; n < 2; ++n)
#pragma unroll
                            for (int i = 0; i < 4; i += 2) {
                                const f32x2 a2 = (f32x2){acc[ai][bj][m][n][i], acc[ai][bj][m][n][i + 1]}, b2 = (f32x2){bv[bj][n][i], bv[bj][n][i + 1]};
                                const f32x2 t = __builtin_elementwise_fma(a2, (f32x2){-1.4426950408889634f, -1.4426950408889634f}, b2);
                                f32x2 e; e.x = fast_exp2(t.x); e.y = fast_exp2(t.y); e = e + 1.0f;
                                f32x2 r; r.x = fast_rcp(e.x); r.y = fast_rcp(e.y);
                                const f32x2 q = __builtin_elementwise_fma(r, (f32x2){254.0f, 254.0f}, (f32x2){1.0f, 1.0f});
                                w[bj * 2 + n] = __builtin_amdgcn_cvt_pk_u8_f32(q.x, i, w[bj * 2 + n]); w[bj * 2 + n] = __builtin_amdgcn_cvt_pk_u8_f32(q.y, i + 1, w[bj * 2 + n]); }
                    *(u32x4*)(gq + (size_t)((ai * 4 + m) * 64) * 16) = (u32x4){w[0], w[1], w[2], w[3]}; }
        } else {
            bf16_t* base; int ldc, cb, act = 0;
            if (pn < 7) { base = ZQ; ldc = 768; cb = (pn - 4) * BM; }
            else if (pn == 7) { base = ZKV; ldc = 256; cb = 0; }
            else { base = ZR; ldc = 1024; cb = (pn - 8) * BM; act = (pn >= 10) ? 1 : 0; }
#pragma unroll
            for (int ai = 0; ai < 2; ++ai)
#pragma unroll
                for (int m = 0; m < 4; ++m) { bf16_t* rowp = base + (size_t)(row0 + ai * HALF + m * 16) * ldc + cb + cl;
#pragma unroll
                    for (int bj = 0; bj < 2; ++bj) { f32x4 v0 = acc[ai][bj][m][0], v1 = acc[ai][bj][m][1];
                        if (act == 1) {
#pragma unroll
                            for (int i = 0; i < 4; ++i) { v0[i] = gelu_tanh_(v0[i]); v1[i] = gelu_tanh_(v1[i]); } }
                        *(u32x4*)(rowp + bj * HALF) = pack8(v0, v1); }
                    if (pn < 8) {
                        const f32x4 s4 = (acc[ai][0][m][0] * acc[ai][0][m][0] + acc[ai][0][m][1] * acc[ai][0][m][1]) + (acc[ai][1][m][0] * acc[ai][1][m][0] + acc[ai][1][m][1] * acc[ai][1][m][1]);
                        float sq = (s4[0] + s4[1]) + (s4[2] + s4[3]); sq = sum_x32(sum_x16(sq));
                        if (fq == 0) (void)__hip_atomic_fetch_add(stats + (size_t)(row0 + ai * HALF + m * 16) * 4 + (pn == 7 ? 1 : 0), (unsigned long long)(sq * 1048576.0f), __ATOMIC_RELAXED, __HIP_MEMORY_SCOPE_AGENT); } }
        }
    }
};
struct EpiMerge {
    static constexpr bool PERM = true, KEEP_ACC = true;
    const bf16_t* G; bf16_t* M;
    __device__ __forceinline__ static void codes(unsigned w, f32x4& v) { v[0] = (float)(w & 0xffu); v[1] = (float)((w >> 8) & 0xffu); v[2] = (float)((w >> 16) & 0xffu); v[3] = (float)(w >> 24); }
    __device__ __forceinline__ void operator()(Acc& acc, const Unit& u, int wr, int wc, int fr, int fq) const {
        const int seg = u.tag;
        const unsigned char* gbase = (const unsigned char*)G + ((((size_t)(u.pm * 12 + seg * 4 + u.pn) * 8 + (wr * 4 + wc)) * 8) * 64 + (fq * 16 + fr)) * 16;
        const size_t nxt = (seg < 2) ? (size_t)4 * 8 * 8 * 64 * 16 : 0;
#pragma unroll
        for (int ai = 0; ai < 2; ++ai)
#pragma unroll
            for (int mh = 0; mh < 2; ++mh) {
                u32x4 ga[2], gb[2];
#pragma unroll
                for (int mm = 0; mm < 2; ++mm) { const unsigned char* gp = gbase + (size_t)((ai * 4 + 2 * mh + mm) * 64) * 16; ga[mm] = *(const u32x4*)gp; gb[mm] = *(const u32x4*)(gp + nxt); }
                asm volatile("" ::: "memory");
#pragma unroll
                for (int mm = 0; mm < 2; ++mm) { const int m = 2 * mh + mm;
#pragma unroll
                    for (int bj = 0; bj < 2; ++bj) { f32x4 a0, a1; codes(ga[mm][2 * bj], a0); codes(ga[mm][2 * bj + 1], a1);
                        if (seg < 2) { f32x4 b0, b1; codes(gb[mm][2 * bj], b0); codes(gb[mm][2 * bj + 1], b1);
#pragma unroll
                            for (int i = 0; i < 4; ++i) { acc[ai][bj][m][0][i] *= a0[i] * fast_rcp(b0[i]); acc[ai][bj][m][1][i] *= a1[i] * fast_rcp(b1[i]); }
                        } else {
                            *(u32x4*)(M + tiled_a_off(u.pm, 1024, ai, wr, m, fr, fq, u.pn * BM + bj * HALF + wc * 32)) = pack8(acc[ai][bj][m][0] * (a0 * (1.0f / 255.0f)), acc[ai][bj][m][1] * (a1 * (1.0f / 255.0f)));
                            acc[ai][bj][m][0] = (f32x4){0.f, 0.f, 0.f, 0.f}; acc[ai][bj][m][1] = (f32x4){0.f, 0.f, 0.f, 0.f};
                        } } }
                asm volatile("" ::: "memory"); }
    }
};
struct EpiResid {
    static constexpr bool PERM = true, KEEP_ACC = false;
    bf16_t* X; const float* mod; int gsel;
    __device__ __forceinline__ void operator()(Acc& acc, const Unit& u, int wr, int wc, int fr, int fq) const {
        const int b = u.pm / 9, j = u.pm - b * 9, mi = (j == 0) ? 16 : b;
        const float* ga = mod + (size_t)mi * 6144 + gsel * 1024;
        const int col0 = u.pn * BM + wc * 32 + 8 * fq;
        bf16_t* xb = X + (size_t)(u.pm * BM + wr * 64 + fr) * DM + col0;
        f32x4 gv[2][2];
#pragma unroll
        for (int bj = 0; bj < 2; ++bj)
#pragma unroll
            for (int n = 0; n < 2; ++n) gv[bj][n] = *(const f32x4*)(ga + col0 + bj * HALF + 4 * n);
#pragma unroll
        for (int ai = 0; ai < 2; ++ai)
#pragma unroll
            for (int mh = 0; mh < 2; ++mh) {
                u32x4 xw[2][2];
#pragma unroll
                for (int mm = 0; mm < 2; ++mm)
#pragma unroll
                    for (int bj = 0; bj < 2; ++bj) xw[mm][bj] = *(const u32x4*)(xb + (size_t)(ai * HALF + (2 * mh + mm) * 16) * DM + bj * HALF);
                asm volatile("" ::: "memory");
#pragma unroll
                for (int mm = 0; mm < 2; ++mm) { const int m = 2 * mh + mm;
#pragma unroll
                    for (int bj = 0; bj < 2; ++bj) { f32x4 x0, x1; unpack8(xw[mm][bj], x0, x1);
                        *(u32x4*)(xb + (size_t)(ai * HALF + m * 16) * DM + bj * HALF) = pack8(x0 + gv[bj][0] * acc[ai][bj][m][0], x1 + gv[bj][1] * acc[ai][bj][m][1]); } }
                asm volatile("" ::: "memory"); }
    }
};
}

struct Args {
    const float* in[38];
    float* out; unsigned char* ws;
    int ph_lo, ph_hi;
};
enum InIdx { I_X = 0, I_C, I_CTX, I_CCTX, I_WADA, I_BADA, I_GN1, I_GN2, I_WIN, I_BGATE, I_CONVW, I_CONVB, I_CLNG, I_CLNB, I_WOCONV, I_GQA, I_WQB, I_GKVA, I_WKVB, I_GQN, I_GKN, I_WOMLA,
             I_RCW, I_RCB, I_WRA, I_BRA, I_WRI, I_BRI, I_LAM, I_WOREC, I_WOUT, I_WFG, I_WFU, I_WFD, I_WROUTER, I_WEG, I_WEU, I_WED };

struct Frame {
    LAS unsigned char* lds;
    int tid, lane, wave, G, bid;
    unsigned char* ws;
};

__device__ __forceinline__ void tr_tile(const float* src, int ld_src, int col0, int nvalid, int k0, const float* kscale, bf16_t* dst, int Ktot, int n0, int kd0, LAS float* scr, int lane) {
    const int c4 = (lane & 15) * 4, rsub = lane >> 4;
#pragma unroll 4
    for (int i = 0; i < 16; ++i) { const int kk = 4 * i + rsub;
        f32x4 v = (f32x4){0.f, 0.f, 0.f, 0.f};
        if (c4 < nvalid) v = *(const f32x4*)(src + (size_t)(k0 + kk) * ld_src + col0 + c4);
        if (kscale) v = v * kscale[k0 + kk];
        scr[kk * 65 + c4] = v[0]; scr[kk * 65 + c4 + 1] = v[1]; scr[kk * 65 + c4 + 2] = v[2]; scr[kk * 65 + c4 + 3] = v[3]; }
    LDS_WAIT(); asm volatile("" ::: "memory");
    const int c = lane & 7;
    bf16_t* tbase = dst + ((size_t)((n0 >> 8) * (Ktot >> 6) + (kd0 >> 6)) * 2 + ((n0 >> 7) & 1)) * 8192;
    float tv[8][8];
#pragma unroll
    for (int j = 0; j < 8; ++j) { const LAS float* s = scr + (8 * c) * 65 + (lane >> 3) + 8 * j;
#pragma unroll
        for (int q = 0; q < 8; ++q) tv[j][q] = s[q * 65]; }
    __builtin_amdgcn_sched_barrier(0);
#pragma unroll
    for (int j = 0; j < 8; ++j) { const int n = (lane >> 3) + 8 * j;
        u32x4 o; o.x = cvt_pk_bf16(tv[j][0], tv[j][1]); o.y = cvt_pk_bf16(tv[j][2], tv[j][3]); o.z = cvt_pk_bf16(tv[j][4], tv[j][5]); o.w = cvt_pk_bf16(tv[j][6], tv[j][7]);
        const int nh = (n0 & 64) + n, v32 = nh & 31, rho = (nh & ~31) + (((v32 >> 2) & 1) << 4) + ((v32 >> 3) << 2) + (v32 & 3);
        *(u32x4*)(tbase + (pg8::lds_byte(rho, 8 * c) >> 1)) = o; }
    LDS_WAIT(); asm volatile("" ::: "memory");
}
__device__ __forceinline__ void tr_plain(int item, const float* src, int K, int N, const float* kscale, bf16_t* dst, int ld_dst, int dk0, LAS float* scr, int lane) {
    const int nnb = N / 64, kb = item / nnb, nb = item - kb * nnb;
    tr_tile(src, N, nb * 64, 64, kb * 64, kscale, dst, ld_dst, nb * 64, dk0 + kb * 64, scr, lane);
}
__device__ __forceinline__ void tr_gu(int item, const float* wg, const float* wu, bf16_t* dst, LAS float* scr, int lane) {
    const int kb = item / 112, nb = item - kb * 112;
    const int tile = nb >> 2, sub = nb & 3;
    const float* src = (sub < 2) ? wg : wu; const int col = tile * 128 + (sub & 1) * 64;
    tr_tile(src, DFF, col, 64, kb * 64, nullptr, dst, 1024, nb * 64, kb * 64, scr, lane);
}
__device__ __forceinline__ void tr_win(int item, const float* w, bf16_t* dst, LAS float* scr, int lane) {
    const int kb = item / 96, nb = item - kb * 96;
    int col, nv = 64; const int row = nb * 64;
    if (nb < 16) { const int tile = nb >> 2, sub = nb & 3; col = (sub < 2 ? 0 : 512) + tile * 128 + (sub & 1) * 64; }
    else if (nb < 32) col = 1024 + (row - 1024);
    else if (nb < 48) col = 2080 + (row - 2048);
    else col = 3104 + (row - 3072);
    tr_tile(w, IN_COLS, col, nv, kb * 64, nullptr, dst, 1024, row, kb * 64, scr, lane);
}
__device__ __forceinline__ void rec_frag_item(int item, const float* wra, const float* wri, bf16_t* dst, int lane) {
    const int s = item & 3, cb = (item >> 2) & 1, g = (item >> 3) & 7, gate = (item >> 6) & 1, d = (item >> 7) & 1;
    const float* w = (gate ? wri : wra) + ((size_t)(d * 8 + g)) * 4096;
    const int r = lane & 31, h = lane >> 5;
    float v[8];
#pragma unroll
    for (int jj = 0; jj < 8; ++jj) v[jj] = w[(16 * s + 8 * h + jj) * 64 + 32 * cb + r];
    u32x4 o; o.x = cvt_pk_bf16(v[0], v[1]); o.y = cvt_pk_bf16(v[2], v[3]); o.z = cvt_pk_bf16(v[4], v[5]); o.w = cvt_pk_bf16(v[6], v[7]);
    *(u32x4*)(dst + ((size_t)item * 64 + lane) * 8) = o;
}

__device__ __forceinline__ void krope_frag_item(int s, const float* w, bf16_t* dst, int lane) {
    const int r = lane & 31, h = lane >> 5;
    float v[8];
#pragma unroll
    for (int jj = 0; jj < 8; ++jj) v[jj] = w[(size_t)(16 * s + 8 * h + jj) * IN_COLS + 2048 + r];
    u32x4 o; o.x = cvt_pk_bf16(v[0], v[1]); o.y = cvt_pk_bf16(v[2], v[3]); o.z = cvt_pk_bf16(v[4], v[5]); o.w = cvt_pk_bf16(v[6], v[7]);
    *(u32x4*)(dst + ((size_t)s * 64 + lane) * 8) = o;
}
constexpr int CC_PER_LAYER = 96 * 16 + 3 * 16 * 8 + 12 * 16 + 16 * 4 + 16 * 16 + 256 + 64, CC_PER_FF = 112 * 16 + 16 * 56, CC_NITEMS = DEPTH * CC_PER_LAYER + 2 * CC_PER_FF;
__device__ __forceinline__ void convert_common(const Args& a, const Frame& F, int it_lo, int it_hi, int wg_i, int n_wg) {
    if (wg_i < 0) return;
    LAS float* scr = (LAS float*)(F.lds + F.wave * 16640);
    const int gw = wg_i * NWAVES + F.wave, NGW = n_wg * NWAVES;
    constexpr int I_WIN_N = 96 * 16, I_CAT = 16 * 8, I_QB = 12 * 16, I_KVB = 16 * 4, I_OUT = 16 * 16, I_REC = 256, I_KR = 64;
    constexpr int PER_LAYER = I_WIN_N + 3 * I_CAT + I_QB + I_KVB + I_OUT + I_REC + I_KR;
    constexpr int I_GU = 112 * 16, I_D = 16 * 56, PER_FF = I_GU + I_D;
    static_assert(PER_LAYER == CC_PER_LAYER && PER_FF == CC_PER_FF, "conversion item counts");
    for (int it = it_lo + gw; it < it_hi; it += NGW) {
        if (it < DEPTH * PER_LAYER) {
            const int l = it / PER_LAYER; int r = it - l * PER_LAYER;
            if (r < I_WIN_N) { tr_win(r, a.in[I_WIN] + (size_t)l * DM * IN_COLS, (bf16_t*)(a.ws + WS_WIN) + (size_t)l * NWIN * DM, scr, F.lane); continue; } r -= I_WIN_N;
            if (r < 3 * I_CAT) { const int which = r / I_CAT; r -= which * I_CAT;
                const float* src = a.in[which == 0 ? I_WOCONV : (which == 1 ? I_WOMLA : I_WOREC)] + (size_t)l * 512 * 1024;
                tr_plain(r, src, 512, 1024, nullptr, (bf16_t*)(a.ws + WS_WCAT) + (size_t)l * 1024 * 1536, 1536, which * 512, scr, F.lane); continue; } r -= 3 * I_CAT;
            if (r < I_QB) { const int kb = r >> 4, nb = r & 15, hh = nb >> 1, sub = nb & 1;
                tr_tile(a.in[I_WQB] + (size_t)l * 768 * 768, 768, 96 * hh + 64 * sub, sub ? 32 : 64, kb * 64, a.in[I_GQA] + l * 768, (bf16_t*)(a.ws + WS_WQB) + (size_t)l * 1024 * 768, 768, nb * 64, kb * 64, scr, F.lane); continue; } r -= I_QB;
            if (r < I_KVB) { tr_plain(r, a.in[I_WKVB] + (size_t)l * 256 * 1024, 256, 1024, a.in[I_GKVA] + l * 256, (bf16_t*)(a.ws + WS_WKVB) + (size_t)l * 1024 * 256, 256, 0, scr, F.lane); continue; } r -= I_KVB;
            if (r < I_OUT) { tr_plain(r, a.in[I_WOUT] + (size_t)l * 1024 * 1024, 1024, 1024, nullptr, (bf16_t*)(a.ws + WS_WOUT) + (size_t)l * 1024 * 1024, 1024, 0, scr, F.lane); continue; } r -= I_OUT;
            if (r < I_REC) { rec_frag_item(r, a.in[I_WRA] + (size_t)l * 2 * 8 * 4096, a.in[I_WRI] + (size_t)l * 2 * 8 * 4096, (bf16_t*)(a.ws + WS_WREC) + (size_t)l * 256 * 512, F.lane); continue; } r -= I_REC;
            krope_frag_item(r, a.in[I_WIN] + (size_t)l * DM * IN_COLS, (bf16_t*)(a.ws + WS_WKR) + (size_t)l * 64 * 512, F.lane);
        } else {
            int r = it - DEPTH * PER_LAYER; const int j = r / PER_FF; r -= j * PER_FF;
            if (r < I_GU) tr_gu(r, a.in[I_WFG] + (size_t)j * DM * DFF, a.in[I_WFU] + (size_t)j * DM * DFF, (bf16_t*)(a.ws + WS_WFFGU) + (size_t)j * 7168 * 1024, scr, F.lane);
            else tr_plain(r - I_GU, a.in[I_WFD] + (size_t)j * DFF * DM, DFF, DM, nullptr, (bf16_t*)(a.ws + WS_WFFD) + (size_t)j * 1024 * DFF, DFF, 0, scr, F.lane);
        }
    }
}
constexpr int MOE_CVT_ITEMS = NEXP * (112 * 16 + 16 * 56), CVT_SPLIT1 = 6200, CVT_SPLIT2 = 10700;
__device__ __forceinline__ void convert_moe(const Args& a, const Frame& F, int j, int it_lo, int it_hi, int wg_i, int n_wg) {
    if (wg_i < 0) return;
    LAS float* scr = (LAS float*)(F.lds + F.wave * 16640);
    const int gw = wg_i * NWAVES + F.wave, NGW = n_wg * NWAVES;
    constexpr int I_GU = 112 * 16, I_D = 16 * 56, PER_E = I_GU + I_D;
    for (int it = it_lo + gw; it < it_hi; it += NGW) {
        const int e = it / PER_E; const int r = it - e * PER_E;
        const size_t eo = ((size_t)j * NEXP + e) * DM * DFF;
        if (r < I_GU) tr_gu(r, a.in[I_WEG] + eo, a.in[I_WEU] + eo, (bf16_t*)(a.ws + WS_WEGU) + (size_t)e * 7168 * 1024, scr, F.lane);
        else tr_plain(r - I_GU, a.in[I_WED] + eo, DFF, DM, nullptr, (bf16_t*)(a.ws + WS_WED) + (size_t)e * 1024 * DFF, DFF, 0, scr, F.lane);
    }
}
__device__ __forceinline__ void mod_job(const Args& a, const Frame& F) {
    LAS float* sc = (LAS float*)F.lds;
    LAS float* red = (LAS float*)(F.lds + 17 * 1024 * 4);
    for (int i = F.tid; i < NMOD * 1024; i += NTHREADS) { const int v = i >> 10, k = i & 1023; const float x = (v < 16) ? a.in[I_C][v * 1024 + k] : a.in[I_CCTX][k]; sc[i] = siluf_(x); }
    __syncthreads();
    float* MOD = (float*)(a.ws + WS_MOD);
    const int cl = F.lane & 31, kh = F.lane >> 5;
    for (int item = F.bid; item < DEPTH * 192; item += F.G) {
        const int l = item / 192, nb = item - l * 192;
        const float* w = a.in[I_WADA] + (size_t)l * 1024 * 6144 + nb * 32 + cl;
        float acc[NMOD];
#pragma unroll
        for (int v = 0; v < NMOD; ++v) acc[v] = 0.f;
        const int k0 = F.wave * 128 + kh * 64;
#pragma unroll 1
        for (int kk = 0; kk < 64; kk += 16) {
            float wv[16];
#pragma unroll
            for (int j = 0; j < 16; ++j) wv[j] = w[(size_t)(k0 + kk + j) * 6144];
#pragma unroll
            for (int j = 0; j < 16; ++j)
#pragma unroll
                for (int v = 0; v < NMOD; ++v) acc[v] += sc[v * 1024 + k0 + kk + j] * wv[j];
        }
#pragma unroll
        for (int v = 0; v < NMOD; ++v) acc[v] = sum_x32(acc[v]);
        if (kh == 0) {
#pragma unroll
            for (int v = 0; v < NMOD; ++v) red[(F.wave * NMOD + v) * 32 + cl] = acc[v]; }
        __syncthreads();
        for (int o = F.tid; o < NMOD * 32; o += NTHREADS) { const int v = o >> 5, c = o & 31; float s = a.in[I_BADA][l * 6144 + nb * 32 + c];
#pragma unroll
            for (int wv = 0; wv < 8; ++wv) s += red[(wv * NMOD + v) * 32 + c];
            MOD[((size_t)l * NMOD + v) * 6144 + nb * 32 + c] = s; }
        __syncthreads();
    }
}

struct NormP {
    const float* xin; const float* cin;
    bf16_t* X; bool from_f32; float* outf;
    const float* gain;
    const float* mod; int shsel;
    bf16_t* H;
    int* inv;
    bool combine; const bf16_t* Y; const i32x2* routeP; const f32x2* routeW; const float* modprev;
    bool do_norm; bool latent_only;
    const float* wrouter; i32x4* routeA; f32x2* routeWout; unsigned* cnt;
};
template <bool ROUTER>
__device__ __forceinline__ void norm_job(const NormP& P, const Frame& F) {
    const int nact = P.latent_only ? NB * SEQ : T;
    const int rpw = nact / F.G;
    LAS int* hist = (LAS int*)(F.lds);
    LAS int* wbase = (LAS int*)(F.lds + 256);
    LAS int* stg = (LAS int*)(F.lds + 512);
    LAS f32x4* lw = (LAS f32x4*)(F.lds + 8192);
    if (ROUTER) { if (F.tid < 64) hist[F.tid] = 0;
#pragma unroll
        for (int k = 0; k < 4; ++k) { const int f4 = F.tid + NTHREADS * k, c = f4 >> 1, h = f4 & 1, j = c >> 8, i = c & 3, ln = (c & 255) >> 2;
            lw[((j * 4 + i) * 2 + h) * 64 + ln] = *(const f32x4*)(P.wrouter + (size_t)f4 * 4); }
        __syncthreads(); }
    const int a_lo = F.bid * rpw, a_hi = (F.bid == F.G - 1) ? nact : a_lo + rpw;
    int cur_mi = -1; f32x4 gs[4], s0v[4];
#pragma unroll
    for (int j = 0; j < 4; ++j) { gs[j] = (f32x4){0.f, 0.f, 0.f, 0.f}; s0v[j] = gs[j]; }
    i32x2 npp = (i32x2){0, 0}; f32x2 nww = (f32x2){0.f, 0.f};
    if (P.combine && a_lo + F.wave < a_hi) { const int ai0 = a_lo + F.wave, row0 = P.latent_only ? (ai0 / SEQ) * LROW + CTXL + (ai0 % SEQ) : ai0; npp = P.routeP[row0]; nww = P.routeW[row0]; }
    for (int ai = a_lo + F.wave; ai < a_hi; ai += NWAVES) {
        const int row = P.latent_only ? (ai / SEQ) * LROW + CTXL + (ai % SEQ) : ai;
        const int b = row / LROW, t = row - b * LROW;
        const bool isctx = t < CTXL; const int mi = isctx ? 16 : b;
        const size_t roff = isctx ? ((size_t)b * CTXL + t) * DM : ((size_t)b * SEQ + (t - CTXL)) * DM;
        bf16_t* xrow = P.X + (size_t)row * DM;
        f32x4 v[4];
        if (P.from_f32) {
            const float* xr = (isctx ? P.cin : P.xin) + roff;
#pragma unroll
            for (int j = 0; j < 4; ++j) { v[j] = *(const f32x4*)(xr + 4 * F.lane + 256 * j);
                u32x2 o; o.x = cvt_pk_bf16(v[j][0], v[j][1]); o.y = cvt_pk_bf16(v[j][2], v[j][3]); *(u32x2*)(xrow + 4 * F.lane + 256 * j) = o; }
        } else {
#pragma unroll
            for (int j = 0; j < 4; ++j) { const u32x2 w = *(const u32x2*)(xrow + 4 * F.lane + 256 * j); v[j] = (f32x4){bflo(w.x), bfhi(w.x), bflo(w.y), bfhi(w.y)}; }
        }
        if (P.combine) {
            const i32x2 pp = npp; const f32x2 ww = nww;
            if (ai + NWAVES < a_hi) { const int ai1 = ai + NWAVES, row1 = P.latent_only ? (ai1 / SEQ) * LROW + CTXL + (ai1 % SEQ) : ai1; npp = P.routeP[row1]; nww = P.routeW[row1]; }
            const float* ga = P.modprev + (size_t)mi * 6144 + 5 * 1024;
#pragma unroll
            for (int j = 0; j < 4; ++j) {
                const u32x2 y0 = *(const u32x2*)(P.Y + (size_t)pp.x * DM + 4 * F.lane + 256 * j), y1 = *(const u32x2*)(P.Y + (size_t)pp.y * DM + 4 * F.lane + 256 * j);
                const f32x4 g = *(const f32x4*)(ga + 4 * F.lane + 256 * j);
                f32x4 f; f[0] = ww.x * bflo(y0.x) + ww.y * bflo(y1.x); f[1] = ww.x * bfhi(y0.x) + ww.y * bfhi(y1.x); f[2] = ww.x * bflo(y0.y) + ww.y * bflo(y1.y); f[3] = ww.x * bfhi(y0.y) + ww.y * bfhi(y1.y);
                v[j] = v[j] + g * f;
                if (P.outf) *(f32x4*)(P.outf + roff + 4 * F.lane + 256 * j) = v[j];
                else { u32x2 o; o.x = cvt_pk_bf16(v[j][0], v[j][1]); o.y = cvt_pk_bf16(v[j][2], v[j][3]); *(u32x2*)(xrow + 4 * F.lane + 256 * j) = o; } }
        }
        if (!P.do_norm) continue;
        float ss = 0.f;
#pragma unroll
        for (int j = 0; j < 4; ++j) ss += (v[j][0] * v[j][0] + v[j][1] * v[j][1]) + (v[j][2] * v[j][2] + v[j][3] * v[j][3]);
        const float rstd = 1.0f / sqrtf(wave_sum(ss) * (1.0f / DM) + NORM_EPS);
        if (mi != cur_mi) {
            cur_mi = mi; const float* sh = P.mod + (size_t)mi * 6144 + P.shsel * 1024; const float* sc = sh + 1024;
#pragma unroll
            for (int j = 0; j < 4; ++j) { const int c = 4 * F.lane + 256 * j; gs[j] = *(const f32x4*)(P.gain + c) * (*(const f32x4*)(sc + c) + 1.0f); s0v[j] = *(const f32x4*)(sh + c); } }
#pragma unroll
        for (int j = 0; j < 4; ++j) { const int c = 4 * F.lane + 256 * j;
            v[j] = (v[j] * rstd) * gs[j] + s0v[j];
            u32x2 o; o.x = cvt_pk_bf16(v[j][0], v[j][1]); o.y = cvt_pk_bf16(v[j][2], v[j][3]);
            *(u32x2*)(P.H + (size_t)row * DM + c) = o; }
        if (ROUTER) {
            float lg[8];
#pragma unroll
            for (int e = 0; e < 8; ++e) lg[e] = 0.f;
#pragma unroll
            for (int j = 0; j < 4; ++j)
#pragma unroll
                for (int i = 0; i < 4; ++i) { const f32x4 w0 = lw[((j * 4 + i) * 2 + 0) * 64 + F.lane], w1 = lw[((j * 4 + i) * 2 + 1) * 64 + F.lane];
                    lg[0] += v[j][i] * w0[0]; lg[1] += v[j][i] * w0[1]; lg[2] += v[j][i] * w0[2]; lg[3] += v[j][i] * w0[3];
                    lg[4] += v[j][i] * w1[0]; lg[5] += v[j][i] * w1[1]; lg[6] += v[j][i] * w1[2]; lg[7] += v[j][i] * w1[3]; }
#pragma unroll
            for (int e = 0; e < 8; ++e) lg[e] = wave_sum(lg[e]);
            int e0 = 0; float v0 = lg[0];
#pragma unroll
            for (int e = 1; e < 8; ++e) if (lg[e] > v0) { v0 = lg[e]; e0 = e; }
            int e1 = -1; float v1 = -3.0e38f;
#pragma unroll
            for (int e = 0; e < 8; ++e) if (e != e0 && lg[e] > v1) { v1 = lg[e]; e1 = e; }
            const float w0 = 1.0f / (1.0f + __expf(v1 - v0)), w1 = 1.0f - w0;
            if (F.lane == 0) { const int p0 = hist[F.wave * 8 + e0]; hist[F.wave * 8 + e0] = p0 + 1; const int p1 = hist[F.wave * 8 + e1]; hist[F.wave * 8 + e1] = p1 + 1;
                LAS int* s = stg + (ai - a_lo) * 6; s[0] = e0; s[1] = p0; s[2] = e1; s[3] = p1; s[4] = __float_as_int(w0); s[5] = __float_as_int(w1); }
        }
    }
    if (ROUTER) {
        __syncthreads();
        if (F.tid < 8) { int tot = 0;
#pragma unroll
            for (int w = 0; w < 8; ++w) tot += hist[w * 8 + F.tid];
            int base = (int)__hip_atomic_fetch_add(P.cnt + F.tid * 64, (unsigned)tot, __ATOMIC_RELAXED, __HIP_MEMORY_SCOPE_AGENT);
#pragma unroll
            for (int w = 0; w < 8; ++w) { wbase[w * 8 + F.tid] = base; base += hist[w * 8 + F.tid]; } }
        __syncthreads();
        for (int i = F.tid; i < a_hi - a_lo; i += NTHREADS) {
            const int ai = a_lo + i, w = i & 7;
            const int row = P.latent_only ? (ai / SEQ) * LROW + CTXL + (ai % SEQ) : ai;
            const LAS int* s = stg + i * 6;
            const int p0_ = wbase[w * 8 + s[0]] + s[1], p1_ = wbase[w * 8 + s[2]] + s[3];
            P.routeA[row] = (i32x4){s[0], p0_, s[2], p1_}; P.inv[s[0] * T + p0_] = row; P.inv[s[2] * T + p1_] = row;
            P.routeWout[row] = (f32x2){__int_as_float(s[4]), __int_as_float(s[5])};
        }
        __syncthreads();
    }
}
__device__ __forceinline__ void moe_offsets(const unsigned* cnt, int* off  ) {
    int o = 0;
#pragma unroll
    for (int e = 0; e < 8; ++e) { off[e] = o; const int c = (int)__hip_atomic_load(cnt + e * 64, __ATOMIC_RELAXED, __HIP_MEMORY_SCOPE_AGENT); o += (c + 255) & ~255; }
    off[8] = o;
}

struct ConvP { const bf16_t* U; bf16_t* CAT; const float* cw; const float* cb; const float* lng; const float* lnb; bool latent_only; };
constexpr int CV_ROWS = 62, CV_BUF = CV_ROWS * 1024, CV_PART = 2 * CV_BUF, CV_STATS = CV_PART + 8 * 64 * 4;
static_assert(CV_STATS + 32 * 8 <= LDSCTL_OFF, "conv LDS");
__device__ __forceinline__ void conv_stage(const ConvP& P, const Frame& F, int item, int buf) {
    int b, cc;
    if (P.latent_only) { b = item >> 6; cc = 8 + (item & 63); } else { b = item / 72; cc = item - b * 72; }
    const int rb = b * LROW + cc * 32, seq_lo = b * LROW + (cc < 8 ? 0 : CTXL), seq_hi = b * LROW + (cc < 8 ? CTXL : LROW);
    for (int j = F.wave; j < CV_ROWS; j += NWAVES) {
        const int row = rb - 15 + j;
        LAS unsigned char* dst = F.lds + buf * CV_BUF + j * 1024;
        if (row >= seq_lo && row < seq_hi) __builtin_amdgcn_global_load_lds((const unsigned*)(P.U + (size_t)row * 512 + F.lane * 8), (LAS unsigned*)dst, 16, 0, 0);
        else *(LAS u32x4*)(dst + F.lane * 16) = (u32x4){0u, 0u, 0u, 0u};
    }
}
__device__ __forceinline__ void conv_job(const ConvP& P, const Frame& F) {
    LAS float* part = (LAS float*)(F.lds + CV_PART);
    LAS f32x2* stats = (LAS f32x2*)(F.lds + CV_STATS);
    const int ch = F.tid;
    float w[31];
#pragma unroll
    for (int k = 0; k < 31; ++k) w[k] = P.cw[k * 512 + ch];
    const float bias = P.cb[ch], lg = P.lng[ch], lb = P.lnb[ch];
    const int nitems = P.latent_only ? NB * 64 : NB * 72;
    int item = F.bid, buf = 0;
    if (item < nitems) conv_stage(P, F, item, 0);
    for (; item < nitems; item += F.G, buf ^= 1) {
        asm volatile("s_waitcnt vmcnt(0)" ::: "memory");
        __syncthreads();
        if (item + F.G < nitems) conv_stage(P, F, item + F.G, buf ^ 1);
        int b, cc;
        if (P.latent_only) { b = item >> 6; cc = 8 + (item & 63); } else { b = item / 72; cc = item - b * 72; }
        const int rb = b * LROW + cc * 32;
        const LAS bf16_t* xin = (const LAS bf16_t*)(F.lds + buf * CV_BUF) + ch;
        float a0[32];
#pragma unroll
        for (int o = 0; o < 32; ++o) a0[o] = bias;
#pragma unroll
        for (int jb = 0; jb < 62; jb += 16) {
            float xv[16];
#pragma unroll
            for (int jj = 0; jj < 16; ++jj) if (jb + jj < 62) xv[jj] = bf2f(xin[(jb + jj) * 512]);
            __builtin_amdgcn_sched_barrier(0);
#pragma unroll
            for (int jj = 0; jj < 16; ++jj) { const int j = jb + jj;
                if (j < 62) {
#pragma unroll
                    for (int o = (j > 30 ? j - 30 : 0); o <= (j < 31 ? j : 31); ++o) a0[o] += w[j - o] * xv[jj]; } }
            __builtin_amdgcn_sched_barrier(0);
        }
        float v[64];
#pragma unroll
        for (int o = 0; o < 32; ++o) { v[2 * o] = a0[o]; v[2 * o + 1] = a0[o] * a0[o]; }
#pragma unroll
        for (int s_ = 32; s_ >= 1; s_ >>= 1) {
            const bool up = (F.lane & s_) != 0;
#pragma unroll
            for (int ib = 0; ib < s_; ib += 16) {
                float sh[16];
#pragma unroll
                for (int ii = 0; ii < 16; ++ii) if (ib + ii < s_) sh[ii] = __shfl_xor(up ? v[ib + ii] : v[ib + ii + s_], s_);
                __builtin_amdgcn_sched_barrier(0);
#pragma unroll
                for (int ii = 0; ii < 16; ++ii) if (ib + ii < s_) v[ib + ii] = (up ? v[ib + ii + s_] : v[ib + ii]) + sh[ii];
                __builtin_amdgcn_sched_barrier(0);
            }
        }
        part[F.wave * 64 + F.lane] = v[0];
        __syncthreads();
        if (F.tid < 64) { const int L = F.tid;
            float tot = 0.f;
#pragma unroll
            for (int wv = 0; wv < 8; ++wv) tot += part[wv * 64 + L];
            const float oth = __shfl_xor(tot, 1);
            if ((L & 1) == 0) { const float mean = tot * (1.0f / 512.0f), var = oth * (1.0f / 512.0f) - mean * mean; stats[L >> 1] = (f32x2){mean, 1.0f / sqrtf(var + NORM_EPS)}; } }
        __syncthreads();
#pragma unroll
        for (int ob = 0; ob < 32; ob += 16) {
            f32x2 stv[16];
#pragma unroll
            for (int oo = 0; oo < 16; ++oo) stv[oo] = stats[ob + oo];
            __builtin_amdgcn_sched_barrier(0);
#pragma unroll
            for (int oo = 0; oo < 16; ++oo) { const int o = ob + oo; const f32x2 st = stv[oo];
                const float y0 = (a0[o] - st.x) * st.y * lg + lb;
                P.CAT[(size_t)(rb + o) * 1536 + ch] = (bf16_t)(cvt_pk_bf16(siluf_(y0), 0.f) & 0xffffu); }
            __builtin_amdgcn_sched_barrier(0);
        }
    }
    __syncthreads();
}

constexpr int NCH = 72, XT_PITCH = 68, XT_BYTES = 32 * XT_PITCH * 4, SC_STAGE = 40 * 128;
static_assert(32768 + 8 * (XT_BYTES + SC_STAGE) <= LDSCTL_OFF, "scan LDS");
__device__ __forceinline__ int crow(int r, int hi) { return (r & 3) + 8 * (r >> 2) + 4 * hi; }
struct ScanP { const bf16_t* ZR; bf16_t* CAT; const float* rcw; const float* rcb; const bf16_t* wfrag; const float* bra; const float* bri; const float* lam; float* SUM; const float* CAR; };
template <bool FINAL>
__device__ __forceinline__ void scan_job(const ScanP& P, const Frame& F) {
    const int ngw = (F.G >= 8) ? F.G / 8 : 1, g = (F.G >= 8) ? (F.bid & 7) : 0, wgi = (F.G >= 8) ? (F.bid >> 3) : F.bid;
    LAS bf16_t* wl = (LAS bf16_t*)F.lds;
    LAS float* XT = (LAS float*)(F.lds + 32768 + F.wave * (XT_BYTES + SC_STAGE));
    LAS bf16_t* STG = (LAS bf16_t*)(F.lds + 32768 + F.wave * (XT_BYTES + SC_STAGE) + XT_BYTES);
    const int lane = F.lane, r32 = lane & 31, hi = lane >> 5;
    for (int gg = g; gg < 8; gg += (F.G >= 8 ? 8 : 1)) {
    __syncthreads();
#pragma unroll
    for (int i = 0; i < 4; ++i) { const int e = (i * NTHREADS + F.tid) * 8, piece = e >> 12, within = e & 4095;
        *(LAS u32x4*)(wl + e) = *(const u32x4*)(P.wfrag + ((size_t)(piece * 8 + gg)) * 4096 + within); }
    const int ch = 64 * gg + lane;
    float cw[2][4], cbias[2], ba[2][2], bi[2][2], c1[2][2];
#pragma unroll
    for (int d = 0; d < 2; ++d) {
#pragma unroll
        for (int k = 0; k < 4; ++k) cw[d][k] = P.rcw[(d * 4 + k) * 512 + ch];
        cbias[d] = P.rcb[d * 512 + ch];
#pragma unroll
        for (int cb = 0; cb < 2; ++cb) { const int chj = 64 * gg + 32 * cb + r32;
            ba[d][cb] = -1.4426950408889634f * P.bra[d * 512 + chj]; bi[d][cb] = -1.4426950408889634f * P.bri[d * 512 + chj];
            const float sp = 0.6931471805599453f * __builtin_amdgcn_logf(1.0f + fast_exp2(-1.4426950408889634f * P.lam[d * 512 + chj]));
            c1[d][cb] = -8.0f * 1.4426950408889634f * sp; }
    }
    __syncthreads();
    const int istep = ngw * NWAVES, w_ = wgi * NWAVES + F.wave; const bool even_deal = (istep == 256);
    int item = w_, cbm = 3;
#define SCAN_STAGE(it) do { const int c_ = (it) % NCH, b_ = (it) / NCH; const int rb_ = b_ * LROW + c_ * 32, lo_ = b_ * LROW + (c_ < 8 ? 0 : CTXL), hi_ = b_ * LROW + (c_ < 8 ? CTXL : LROW); \
        _Pragma("unroll") for (int q_ = 0; q_ < 5; ++q_) { int row_ = rb_ - 3 + q_ * 8 + (lane >> 3); row_ = row_ < lo_ ? lo_ : (row_ >= hi_ ? hi_ - 1 : row_); \
            __builtin_amdgcn_global_load_lds((const unsigned*)(P.ZR + (size_t)row_ * 1024 + 64 * gg + (lane & 7) * 8), (LAS unsigned*)(STG + q_ * 512), 16, 0, 0); } } while (0)
    if (item < NB * NCH) SCAN_STAGE(item);
    for (; item < NB * NCH; ) {
        int nitem = item + istep, ncbm = 3;
        if (even_deal) { if (item >= 1024) nitem = NB * NCH; else if (nitem >= 1024) { nitem = 1024 + (w_ >> 1); ncbm = 1 << (w_ & 1); } }
        const int c = item % NCH, b = item / NCH;
        const int rb = b * LROW + c * 32;
        asm volatile("s_waitcnt vmcnt(0)" ::: "memory");
        { const int lo_ = b * LROW + (c < 8 ? 0 : CTXL), hi_ = b * LROW + (c < 8 ? CTXL : LROW);
          if (rb - 3 < lo_ || rb + 36 >= hi_) {
#pragma unroll
              for (int q_ = 0; q_ < 5; ++q_) { const int row_ = rb - 3 + q_ * 8 + (lane >> 3); if (row_ < lo_ || row_ >= hi_) *(LAS u32x4*)(STG + q_ * 512 + lane * 8) = (u32x4){0u, 0u, 0u, 0u}; }
          } }
        unsigned xwp[19];
#pragma unroll
        for (int j = 0; j < 19; ++j) xwp[j] = (unsigned)STG[(2 * j) * 64 + lane] | ((unsigned)STG[(2 * j + 1) * 64 + lane] << 16);
        asm volatile("s_waitcnt lgkmcnt(0)" ::: "memory");
        if (nitem < NB * NCH) SCAN_STAGE(nitem);
#define SCAN_X(j) (((j) & 1) ? bfhi(xwp[(j) >> 1]) : bflo(xwp[(j) >> 1]))
        float carv[2][2];
        if (FINAL) {
#pragma unroll
            for (int d = 0; d < 2; ++d)
#pragma unroll
                for (int cb = 0; cb < 2; ++cb) carv[d][cb] = P.CAR[(size_t)(((b * 8 + gg) * 2 + d) * NCH + c) * 64 + 32 * cb + r32];
        }
        float hsum[2][16];
#pragma unroll
        for (int cb = 0; cb < 2; ++cb)
#pragma unroll
            for (int r = 0; r < 16; ++r) hsum[cb][r] = 0.f;
#pragma unroll
        for (int d = 0; d < 2; ++d) {
#pragma unroll
            for (int t = 0; t < 32; ++t) { const int o = t + 3 * d; XT[t * XT_PITCH + lane] = fmaf(cw[d][3], SCAN_X(o + 3), fmaf(cw[d][2], SCAN_X(o + 2), fmaf(cw[d][1], SCAN_X(o + 1), fmaf(cw[d][0], SCAN_X(o), cbias[d])))); }
            bf16x8 af[4];
#pragma unroll
            for (int s = 0; s < 4; ++s) { const f32x4 x0 = *(const LAS f32x4*)(XT + r32 * XT_PITCH + 16 * s + 8 * hi), x1 = *(const LAS f32x4*)(XT + r32 * XT_PITCH + 16 * s + 8 * hi + 4);
                const u32x4 w = pg8::pack8(x0, x1); af[s] = __builtin_bit_cast(bf16x8, w); }
#pragma unroll
            for (int cb = 0; cb < 2; ++cb) { if (!(cbm & (1 << cb))) continue;
                f32x16 ra = {}, ri = {};
#pragma unroll
                for (int s = 0; s < 4; ++s) {
                    const bf16x8 wa = *(const LAS bf16x8*)(wl + (d * 2 + 0) * 4096 + (cb * 4 + s) * 512 + lane * 8);
                    const bf16x8 wi = *(const LAS bf16x8*)(wl + (d * 2 + 1) * 4096 + (cb * 4 + s) * 512 + lane * 8);
                    ra = __builtin_amdgcn_mfma_f32_32x32x16_bf16(af[s], wa, ra, 0, 0, 0);
                    ri = __builtin_amdgcn_mfma_f32_32x32x16_bf16(af[s], wi, ri, 0, 0, 0);
                }
                float av[16], bx[16];
#pragma unroll
                for (int r = 0; r < 16; ++r) {
                    const float xcv = XT[crow(r, hi) * XT_PITCH + 32 * cb + r32];
                    const float rg = fast_rcp(1.0f + fast_exp2(fmaf(ra[r], -1.4426950408889634f, ba[d][cb]))), ig = fast_rcp(1.0f + fast_exp2(fmaf(ri[r], -1.4426950408889634f, bi[d][cb])));
                    const float a_ = fast_exp2(c1[d][cb] * rg);
                    av[r] = a_; bx[r] = __builtin_amdgcn_sqrtf(fmaf(-a_, a_, 1.0f)) * (ig * xcv);
                }
                float Ag[4], Bg[4];
#pragma unroll
                for (int q = 0; q < 4; ++q) {
                    Ag[q] = (av[4 * q] * av[4 * q + 1]) * (av[4 * q + 2] * av[4 * q + 3]);
                    if (d == 0) Bg[q] = ((bx[4 * q] * av[4 * q + 1] + bx[4 * q + 1]) * av[4 * q + 2] + bx[4 * q + 2]) * av[4 * q + 3] + bx[4 * q + 3];
                    else        Bg[q] = ((bx[4 * q + 3] * av[4 * q + 2] + bx[4 * q + 2]) * av[4 * q + 1] + bx[4 * q + 1]) * av[4 * q] + bx[4 * q];
                }
                float A0[4], A1[4], B0[4], B1[4];
#pragma unroll
                for (int q = 0; q < 4; ++q) {
                    auto ra_ = __builtin_amdgcn_permlane32_swap(__float_as_uint(Ag[q]), __float_as_uint(Ag[q]), false, false); A0[q] = __uint_as_float(ra_[0]); A1[q] = __uint_as_float(ra_[1]);
                    auto rb_ = __builtin_amdgcn_permlane32_swap(__float_as_uint(Bg[q]), __float_as_uint(Bg[q]), false, false); B0[q] = __uint_as_float(rb_[0]); B1[q] = __uint_as_float(rb_[1]);
                }
                if (!FINAL) {
                    float Ac = 1.f, Bc = 0.f;
                    if (d == 0) {
#pragma unroll
                        for (int q = 0; q < 4; ++q) { Bc = A0[q] * Bc + B0[q]; Ac *= A0[q]; Bc = A1[q] * Bc + B1[q]; Ac *= A1[q]; }
                    } else {
#pragma unroll
                        for (int q = 3; q >= 0; --q) { Bc = A1[q] * Bc + B1[q]; Ac *= A1[q]; Bc = A0[q] * Bc + B0[q]; Ac *= A0[q]; }
                    }
                    if (hi == 0) { float* sp_ = P.SUM + ((size_t)(((b * 8 + gg) * 2 + d) * NCH + c) * 2) * 64 + 32 * cb + r32; sp_[0] = Ac; sp_[64] = Bc; }
                } else {
                    float s = carv[d][cb];
                    float sin_[4];
                    if (d == 0) {
#pragma unroll
                        for (int q = 0; q < 4; ++q) { const float s0 = s; s = A0[q] * s + B0[q]; const float s1 = s; s = A1[q] * s + B1[q]; sin_[q] = hi ? s1 : s0; }
#pragma unroll
                        for (int q = 0; q < 4; ++q) { float h = sin_[q];
#pragma unroll
                            for (int e = 0; e < 4; ++e) { h = av[4 * q + e] * h + bx[4 * q + e]; hsum[cb][4 * q + e] += h; } }
                    } else {
#pragma unroll
                        for (int q = 3; q >= 0; --q) { const float s1 = s; s = A1[q] * s + B1[q]; const float s0 = s; s = A0[q] * s + B0[q]; sin_[q] = hi ? s1 : s0; }
#pragma unroll
                        for (int q = 0; q < 4; ++q) { float h = sin_[q];
#pragma unroll
                            for (int e = 3; e >= 0; --e) { h = av[4 * q + e] * h + bx[4 * q + e]; hsum[cb][4 * q + e] += h; } }
                    }
                }
            }
        }
        if (FINAL) {
            u32x4 gatev[4];
            const bool mine = (cbm >> ((lane & 7) >> 2)) & 1;
#pragma unroll
            for (int p = 0; p < 4; ++p) { gatev[p] = (u32x4){0u, 0u, 0u, 0u}; if (mine) gatev[p] = *(const u32x4*)(P.ZR + (size_t)(rb + p * 8 + (lane >> 3)) * 1024 + 512 + 64 * gg + (lane & 7) * 8); }
#pragma unroll
            for (int cb = 0; cb < 2; ++cb) { if (!(cbm & (1 << cb))) continue;
#pragma unroll
                for (int r = 0; r < 16; ++r) XT[crow(r, hi) * XT_PITCH + 32 * cb + r32] = hsum[cb][r]; }
#pragma unroll
            for (int p = 0; p < 4; ++p) { const int tl = p * 8 + (lane >> 3), c8 = (lane & 7) * 8; const size_t row = (size_t)(rb + tl);
                const f32x4 y0 = *(const LAS f32x4*)(XT + tl * XT_PITCH + c8), y1 = *(const LAS f32x4*)(XT + tl * XT_PITCH + c8 + 4);
                f32x4 g0, g1; pg8::unpack8(gatev[p], g0, g1);
                if (mine) *(u32x4*)(P.CAT + row * 1536 + 1024 + 64 * gg + c8) = pg8::pack8(y0 * g0, y1 * g1); }
        }
        item = nitem; cbm = ncbm;
    }
#undef SCAN_STAGE
#undef SCAN_X
    }
}
__device__ __forceinline__ void carry_job(const float* __restrict__ SUM, float* __restrict__ CAR, const Frame& F) {
    const int gw = F.bid * NWAVES + F.wave, NGW = F.G * NWAVES;
    for (int item = gw; item < NB * 8 * 2; item += NGW) {
        const int d = item & 1;
        const float* __restrict__ sp = SUM + (size_t)item * NCH * 128 + F.lane; float* __restrict__ cp = CAR + (size_t)item * NCH * 64 + F.lane;
        float s = 0.f;
#pragma unroll 1
        for (int c0 = 0; c0 < NCH; c0 += 24) {
            float av[24], bv[24];
#pragma unroll
            for (int j = 0; j < 24; ++j) { const int k = c0 + j, c = (d == 0) ? k : (k < 8 ? 7 - k : NCH + 7 - k); av[j] = sp[c * 128]; bv[j] = sp[c * 128 + 64]; }
#pragma unroll
            for (int j = 0; j < 24; ++j) { const int k = c0 + j, c = (d == 0) ? k : (k < 8 ? 7 - k : NCH + 7 - k); cp[c * 64] = s; s = av[j] * s + bv[j]; }
        }
    }
}

__device__ __forceinline__ void krope_job(const bf16_t* __restrict__ H, const bf16_t* __restrict__ WF, bf16_t* __restrict__ KR, unsigned long long* __restrict__ stats, int first, int step, const Frame& F) {
    if (first < 0) return;
    const int lane = F.lane, r32 = lane & 31, hi = lane >> 5, lrow = lane >> 3, lpc = lane & 7;
    LAS unsigned char* xa = F.lds + F.wave * 16384;
    for (int item = first; item < T / 32; item += step) {
        const bf16_t* abase = H + (size_t)(item * 32 + lrow) * DM + lpc * 8;
        f32x16 acc = {};
#pragma unroll 1
        for (int kb = 0; kb < 4; ++kb) {
            u32x4 t[16]; bf16x8 bv[16];
#pragma unroll
            for (int j = 0; j < 16; ++j) t[j] = *(const u32x4*)(abase + (size_t)((j & 3) * 8) * DM + kb * 256 + (j >> 2) * 64);
#pragma unroll
            for (int j = 0; j < 16; ++j) bv[j] = *(const bf16x8*)(WF + ((size_t)(kb * 16 + j) * 64 + lane) * 8);
#pragma unroll
            for (int j = 0; j < 16; ++j) *(LAS u32x4*)(xa + (j >> 2) * 4096 + ((j & 3) * 8 + lrow) * 128 + ((lpc ^ lrow) * 16)) = t[j];
#pragma unroll
            for (int j = 0; j < 16; ++j) { const bf16x8 av = *(const LAS bf16x8*)(xa + (j >> 2) * 4096 + r32 * 128 + ((((j & 3) * 2 + hi) ^ (r32 & 7)) * 16));
                acc = __builtin_amdgcn_mfma_f32_32x32x16_bf16(av, bv[j], acc, 0, 0, 0); }
        }
#pragma unroll
        for (int r = 0; r < 16; ++r) { const int row = item * 32 + crow(r, hi);
            KR[(size_t)row * 32 + r32] = (bf16_t)(cvt_pk_bf16(acc[r], 0.f) & 0xffffu);
            float sq = sum_x16(row16_sum(acc[r] * acc[r]));
            if (r32 == 0) stats[(size_t)row * 4 + 2] = (unsigned long long)(sq * 1048576.0f); }
    }
}

constexpr int attn_NTB = LROW / 64;
__device__ __forceinline__ void rope_table_job(f32x2* tab, const Frame& F) {
    if (F.bid == 0) { const int p = F.tid >> 3, i = F.tid & 7; const float f = powf(10000.0f, -(float)i * 0.125f); float s_, c_; sincosf((float)p * f, &s_, &c_); tab[F.tid] = (f32x2){c_, s_}; }
}

namespace attn {
constexpr int KSLOT = 12288, VSLOT = 8192, NSLOT = 3, KTILE = 6144, VTILE = 4096, NTB = LROW / 64;
constexpr int L_K = 0, L_V = NSLOT * KSLOT, L_WS = L_V + NSLOT * VSLOT, L_OST = L_WS + 2048, L_END = L_OST + 8 * 4096;
static_assert(L_END <= RING_BYTES, "attention LDS");
struct AttnP { const bf16_t* Q; const bf16_t* Kt; const bf16_t* Vt; bf16_t* CAT; float mfix; };
#define AT_WAIT_V(n) asm volatile("s_waitcnt vmcnt(" #n ")" ::: "memory")
#define AT_SB() __builtin_amdgcn_sched_barrier(0)
__device__ __forceinline__ void unit(const AttnP& P, LAS unsigned char* lds, int bh, int qrow0, int NT, const int tid) {
    const int lane = tid & 63, r32 = lane & 31, hi = lane >> 5; const int wid = __builtin_amdgcn_readfirstlane(tid >> 6);
    const int h = bh & 7;
    const bf16_t* Qw = P.Q + (size_t)(qrow0 + wid * 32) * 768 + 96 * h;
    bf16x8 qr[6];
#pragma unroll
    for (int d0 = 0; d0 < 6; ++d0) qr[d0] = *(const bf16x8*)(Qw + (size_t)r32 * 768 + 16 * d0 + 8 * hi);
    const bf16_t* ksrcA = P.Kt + (size_t)bh * NTB * KTILE + wid * 512 + lane * 8;
    const bf16_t* ksrcB = P.Kt + (size_t)bh * NTB * KTILE + (8 + (wid & 3)) * 512 + lane * 8;
    const bf16_t* vsrc = P.Vt + (size_t)bh * NTB * VTILE + wid * 512 + lane * 8;
#define AT_DMA_K(t, slot) do { \
        __builtin_amdgcn_global_load_lds((const unsigned*)(ksrcA + (size_t)(t) * KTILE), (LAS unsigned*)(lds + L_K + (slot) * KSLOT + wid * 1024), 16, 0, 0); \
        __builtin_amdgcn_global_load_lds((const unsigned*)(ksrcB + (size_t)(t) * KTILE), (LAS unsigned*)(lds + L_K + (slot) * KSLOT + (8 + (wid & 3)) * 1024), 16, 0, 0); } while (0)
#define AT_DMA_V(t, slot) __builtin_amdgcn_global_load_lds((const unsigned*)(vsrc + (size_t)(t) * VTILE), (LAS unsigned*)(lds + L_V + (slot) * VSLOT + wid * 1024), 16, 0, 0)
    AT_DMA_K(0, 0); AT_DMA_K(1, 1); AT_DMA_V(0, 0);
    LAS float* wsf = (LAS float*)(lds + L_WS) + wid * 64;
    const unsigned vb0 = (unsigned)(uintptr_t)(lds + L_V) + ((lane >> 4) & 1) * 32 + (lane & 3) * 8 + (4 * hi + ((lane & 15) >> 2)) * 64;
    const LAS unsigned char* kb0 = lds + L_K + hi * 1024 + r32 * 16;
    f32x16 o[2]; o[0] = f32x16{}; o[1] = f32x16{};
    f32x16 negm;
#pragma unroll
    for (int r = 0; r < 16; ++r) negm[r] = -P.mfix;
    float lsum = 0.f;
    f32x16 pA0, pA1, pB0, pB1;
#define AT_KF(kb, i) (*(const LAS bf16x8*)((kb) + ((i) >> 1) * 2048 + ((i) & 1) * 512))
#define AT_PV(ks) __builtin_bit_cast(bf16x8, ((u32x4){pw[4 * (ks)], pw[4 * (ks) + 1], pw[4 * (ks) + 2], pw[4 * (ks) + 3]}))
    AT_WAIT_V(3); __builtin_amdgcn_s_barrier(); asm volatile("" ::: "memory");
    if (2 < NT) AT_DMA_K(2, 2);
    AT_DMA_V(1, 1);
    {
        const LAS unsigned char* kb = kb0;
        pA0 = negm; pA1 = negm;
#pragma unroll
        for (int i = 0; i < 12; ++i) { const bf16x8 kf = AT_KF(kb, i);
            if (i & 1) pA1 = __builtin_amdgcn_mfma_f32_32x32x16_bf16(kf, qr[i >> 1], pA1, 0, 0, 0); else pA0 = __builtin_amdgcn_mfma_f32_32x32x16_bf16(kf, qr[i >> 1], pA0, 0, 0, 0); }
#pragma unroll
        for (int r = 0; r < 16; ++r) { pA0[r] = fast_exp2(pA0[r]); pA1[r] = fast_exp2(pA1[r]); }
    }
#define AT_STEP(S0, S1, P0, P1, ksl, vsl) do { \
        const LAS unsigned char* kb = kb0 + (ksl) * KSLOT; const unsigned vb = vb0 + (vsl) * VSLOT; \
        s16x4 vlo[8], vhh[8]; unsigned pw[16]; float sacc = 0.f; \
        bf16x8 kfa = AT_KF(kb, 0), kfb = AT_KF(kb, 1), kfc = AT_KF(kb, 2), kfd = AT_KF(kb, 3); \
        AT_SB(); \
        _Pragma("unroll") for (int i = 0; i < 12; ++i) { \
            bf16x8 kfe = kfa; if (i + 4 < 12) kfe = AT_KF(kb, (i + 4 < 12 ? i + 4 : 0)); \
            if (i < 8) { asm volatile("ds_read_b64_tr_b16 %0,%1 offset:%c2" : "=&v"(vlo[i]) : "v"(vb), "i"(((i) >> 2) * 4096 + ((i) & 3) * 1024) : "memory"); \
                         asm volatile("ds_read_b64_tr_b16 %0,%1 offset:%c2" : "=&v"(vhh[i]) : "v"(vb), "i"(((i) >> 2) * 4096 + ((i) & 3) * 1024 + 512) : "memory"); } \
            if (i & 1) S1 = __builtin_amdgcn_mfma_f32_32x32x16_bf16(kfa, qr[i >> 1], (i == 1) ? negm : S1, 0, 0, 0); \
            else       S0 = __builtin_amdgcn_mfma_f32_32x32x16_bf16(kfa, qr[i >> 1], (i == 0) ? negm : S0, 0, 0, 0); \
            { const int j0 = (i < 8) ? 3 * i : 24 + 2 * (i - 8), j1 = (i < 8) ? 3 * i + 3 : 24 + 2 * (i - 8) + 2; \
              _Pragma("unroll") for (int j = j0; j < j1; ++j) sacc += (j < 16) ? P0[j & 15] : P1[j & 15]; } \
            if (i < 8) { const int e = 4 * i; pw[2 * i] = (e < 16) ? cvt_pk_bf16(P0[e & 15], P0[(e + 1) & 15]) : cvt_pk_bf16(P1[e & 15], P1[(e + 1) & 15]); \
                         pw[2 * i + 1] = (e < 16) ? cvt_pk_bf16(P0[(e + 2) & 15], P0[(e + 3) & 15]) : cvt_pk_bf16(P1[(e + 2) & 15], P1[(e + 3) & 15]); \
                         asm volatile("" : "+v"(pw[2 * i]), "+v"(pw[2 * i + 1])); } \
            asm volatile("" : "+v"(sacc)); \
            kfa = kfb; kfb = kfc; kfc = kfd; kfd = kfe; \
            AT_SB(); \
        } \
        lsum += sacc; \
        asm volatile("s_waitcnt lgkmcnt(0)" ::: "memory"); AT_SB(); \
        _Pragma("unroll") for (int j = 0; j < 8; ++j) { const int d0 = j & 1, ks = j >> 1, vi = d0 * 4 + ks; \
            const bf16x8 vf = (bf16x8){vlo[vi][0], vlo[vi][1], vlo[vi][2], vlo[vi][3], vhh[vi][0], vhh[vi][1], vhh[vi][2], vhh[vi][3]}; \
            const bf16x8 pa = AT_PV(ks); \
            o[d0] = __builtin_amdgcn_mfma_f32_32x32x16_bf16(pa, vf, o[d0], 0, 0, 0); \
            _Pragma("unroll") for (int e = 0; e < 4; ++e) { if (j < 4) S0[4 * j + e] = fast_exp2(S0[4 * j + e]); else S1[4 * (j - 4) + e] = fast_exp2(S1[4 * (j - 4) + e]); } \
            if (j < 4) asm volatile("" : "+v"(S0)); else asm volatile("" : "+v"(S1)); \
            AT_SB(); \
        } \
    } while (0)
    int ksl = 1, vsl = 0;
#define AT_TOP(t) do { if ((t) + 1 < NT) AT_WAIT_V(3); else AT_WAIT_V(1); __builtin_amdgcn_s_barrier(); asm volatile("" ::: "memory"); \
        const int nsl = (ksl == 2) ? 0 : ksl + 1; if ((t) + 2 < NT) AT_DMA_K((t) + 2, vsl); if ((t) + 1 < NT) AT_DMA_V((t) + 1, nsl); } while (0)
#define AT_ROT() do { vsl = ksl; ksl = (ksl == 2) ? 0 : ksl + 1; } while (0)
    int t = 1;
    for (; t + 1 < NT; t += 2) {
        AT_TOP(t);     AT_STEP(pB0, pB1, pA0, pA1, ksl, vsl); AT_ROT();
        AT_TOP(t + 1); AT_STEP(pA0, pA1, pB0, pB1, ksl, vsl); AT_ROT();
    }
    AT_TOP(t); AT_STEP(pB0, pB1, pA0, pA1, ksl, vsl); AT_ROT();
    AT_WAIT_V(0); __builtin_amdgcn_s_barrier(); asm volatile("" ::: "memory");
    {
        unsigned pw[16]; float sacc = 0.f;
#pragma unroll
        for (int r = 0; r < 16; ++r) sacc += pB0[r] + pB1[r];
        lsum += sacc;
#pragma unroll
        for (int i = 0; i < 4; ++i) { pw[2 * i] = cvt_pk_bf16(pB0[4 * i], pB0[4 * i + 1]); pw[2 * i + 1] = cvt_pk_bf16(pB0[4 * i + 2], pB0[4 * i + 3]);
                                      pw[8 + 2 * i] = cvt_pk_bf16(pB1[4 * i], pB1[4 * i + 1]); pw[8 + 2 * i + 1] = cvt_pk_bf16(pB1[4 * i + 2], pB1[4 * i + 3]); }
        const unsigned vb = vb0 + vsl * VSLOT;
#pragma unroll
        for (int d0 = 0; d0 < 2; ++d0) { s16x4 lo[4], hh[4];
#pragma unroll
            for (int ks = 0; ks < 4; ++ks) {
                asm volatile("ds_read_b64_tr_b16 %0,%1 offset:%c2" : "=&v"(lo[ks]) : "v"(vb), "i"(d0 * 4096 + ks * 1024) : "memory");
                asm volatile("ds_read_b64_tr_b16 %0,%1 offset:%c2" : "=&v"(hh[ks]) : "v"(vb), "i"(d0 * 4096 + ks * 1024 + 512) : "memory"); }
            asm volatile("s_waitcnt lgkmcnt(0)" ::: "memory"); AT_SB();
#pragma unroll
            for (int ks = 0; ks < 4; ++ks) { const bf16x8 vf = (bf16x8){lo[ks][0], lo[ks][1], lo[ks][2], lo[ks][3], hh[ks][0], hh[ks][1], hh[ks][2], hh[ks][3]};
                const bf16x8 pa = AT_PV(ks);
                o[d0] = __builtin_amdgcn_mfma_f32_32x32x16_bf16(pa, vf, o[d0], 0, 0, 0); }
        }
    }
    { auto rr = __builtin_amdgcn_permlane32_swap(__float_as_uint(lsum), __float_as_uint(lsum), false, false); lsum = __uint_as_float(rr[0]) + __uint_as_float(rr[1]); }
    if (hi == 0) wsf[32 + r32] = lsum;
    asm volatile("s_waitcnt lgkmcnt(0)" ::: "memory");
    float rli[16];
#pragma unroll
    for (int r = 0; r < 16; ++r) rli[r] = fast_rcp(wsf[32 + crow(r, hi)]);
    LAS bf16_t* stg = (LAS bf16_t*)(lds + L_OST) + wid * 2048;
#pragma unroll
    for (int r = 0; r < 16; ++r) { const int orow = crow(r, hi);
#pragma unroll
        for (int d0 = 0; d0 < 2; ++d0) stg[orow * 64 + d0 * 32 + r32] = (bf16_t)(cvt_pk_bf16(o[d0][r] * rli[r], 0.f) & 0xffffu); }
    asm volatile("s_waitcnt lgkmcnt(0)" ::: "memory");
    bf16_t* Ow = P.CAT + (size_t)(qrow0 + wid * 32) * 1536 + 512 + 64 * h;
#pragma unroll
    for (int i = 0; i < 4; ++i) { const int row = i * 8 + (lane >> 3), ch = lane & 7; const u32x4 v = *(const LAS u32x4*)(stg + row * 64 + ch * 8); *(u32x4*)(Ow + (size_t)row * 1536 + ch * 8) = v; }
    asm volatile("s_waitcnt lgkmcnt(0)" ::: "memory"); __builtin_amdgcn_s_barrier(); asm volatile("" ::: "memory");
#undef AT_DMA_K
#undef AT_DMA_V
#undef AT_KF
#undef AT_PV
#undef AT_STEP
#undef AT_TOP
#undef AT_ROT
}
__device__ __forceinline__ void phase(const AttnP& P, const Frame& F, bool with_ctx) {
    const int vcu = (F.G % 8 == 0) ? (F.bid % 8) * (F.G / 8) + F.bid / 8 : F.bid;
    for (int u = vcu; u < NB * 8 * 8; u += F.G) { const int bh = u >> 3, qb = u & 7, b = bh >> 3;
        unit(P, F.lds, bh, b * LROW + CTXL + qb * 256, LROW / 64, F.tid); }
    if (with_ctx) for (int u = vcu; u < NB * 8; u += F.G) { const int b = u >> 3; unit(P, F.lds, u, b * LROW, CTXL / 64, F.tid); }
}
}


constexpr int PH_PER_LAYER = 11, NPHASE = 1 + DEPTH * PH_PER_LAYER + 1;
#define IN(k) (lo <= (k) && (k) < hi)
#define PHASE_BEGIN() do { if (need_bar) xcd_barrier(bar); need_bar = true; int t_ = threadIdx.x; asm volatile("" : "+v"(t_)); F.tid = t_; F.lane = t_ & 63; F.wave = __builtin_amdgcn_readfirstlane(t_ >> 6); } while (0)
#define WSP(T_, off) ((T_*)(ws + (off)))

template <int L>
__device__ __forceinline__ void layer_phases(const Args& a, Frame& F, const XcdBarrier& bar, bool& need_bar, const int lo, const int hi) {
    constexpr int l = L, pb = 1 + l * PH_PER_LAYER;
    if (hi <= pb || lo >= pb + PH_PER_LAYER) return;
    constexpr bool last = (l == DEPTH - 1), moe = (l & 1) != 0; constexpr int jf = l >> 1;
    unsigned char* ws = a.ws;
    unsigned* ctl = (unsigned*)(ws + WS_CTL);
    float* MOD = WSP(float, WS_MOD); bf16_t* XRES = WSP(bf16_t, WS_XRES);
    const float* MODl = MOD + (size_t)l * NMOD * 6144;
    unsigned* cnt = ctl + CW_CNT + jf * 8 * 64;
    constexpr int nMrows = last ? NB * 8 : T / 256, rmode = last ? 1 : 0;
    bf16_t* H = WSP(bf16_t, A_H); bf16_t* Gt = WSP(bf16_t, A_G); bf16_t* ZR = WSP(bf16_t, A_ZR); bf16_t* ZQ = WSP(bf16_t, A_ZQ); bf16_t* Qb = WSP(bf16_t, A_Q);
    bf16_t* ZKV = WSP(bf16_t, A_ZKV); bf16_t* KR = WSP(bf16_t, A_KR); bf16_t* KVR = WSP(bf16_t, A_KVR); bf16_t* U = WSP(bf16_t, A_U); bf16_t* CAT = WSP(bf16_t, A_CAT);
    bf16_t* Kb = H; bf16_t* Vb = KVR;
    float* SUM = WSP(float, A_SUM); float* CAR = WSP(float, A_CAR);
    bf16_t* HID = WSP(bf16_t, A_HID); bf16_t* HP = WSP(bf16_t, A_HP); bf16_t* HIDM = WSP(bf16_t, A_HIDM);
    i32x4* routeA = WSP(i32x4, WS_ROUTE_A); f32x2* routeW = WSP(f32x2, WS_ROUTE_W); i32x2* routeP = WSP(i32x2, WS_ROUTE_P);

    if (IN(pb + 0)) { PHASE_BEGIN(); {
        NormP P{}; P.xin = a.in[I_X]; P.cin = a.in[I_CTX]; P.X = XRES; P.from_f32 = (l == 0); P.outf = nullptr; P.gain = a.in[I_GN1] + l * DM; P.mod = MODl; P.shsel = 0; P.H = H;
        P.combine = (l == 2); P.Y = HP; P.routeP = routeP; P.routeW = routeW; P.modprev = MOD + (size_t)(l > 0 ? l - 1 : 0) * NMOD * 6144; P.do_norm = true; P.latent_only = false;
        norm_job<false>(P, F);
        { u32x4* st = WSP(u32x4, WS_STATS); for (int i = F.bid * NTHREADS + F.tid; i < 2 * T; i += F.G * NTHREADS) st[i] = (u32x4){0u, 0u, 0u, 0u}; }
        if constexpr (moe) { u32x4* iv = WSP(u32x4, WS_INV); for (int i = F.bid * NTHREADS + F.tid; i < 2 * T; i += F.G * NTHREADS) iv[i] = (u32x4){0u, 0u, 0u, 0u}; } } }
    if (IN(pb + 1)) { PHASE_BEGIN(); {
        pg8::Gemm g{H, WSP(const bf16_t, WS_WIN) + (size_t)l * NWIN * DM, DM, DM, DM, 0};
        pg8::Order S; S.init(last ? NB * 8 : T / 256, NWIN / 256, F.G, F.bid, last ? 3 : 0, 1, DM, DM, 0);
        pg8::EpiWin E{U, ZQ, ZKV, ZR, Gt, KR, a.in[I_BGATE] + l * 3072, WSP(unsigned long long, WS_STATS)};
        pg8::gemm_phase<pg8::EpiWin, true>(F.lds, g, S, E, F.tid);
        if (F.G == 256) krope_job(H, WSP(const bf16_t, WS_WKR) + (size_t)l * 64 * 512, KR, WSP(unsigned long long, WS_STATS), F.bid >= 128 ? (F.bid - 128) * NWAVES + F.wave : -1, 128 * NWAVES, F);
        else krope_job(H, WSP(const bf16_t, WS_WKR) + (size_t)l * 64 * 512, KR, WSP(unsigned long long, WS_STATS), F.bid * NWAVES + F.wave, F.G * NWAVES, F); } }
    if (IN(pb + 2)) { PHASE_BEGIN(); {
        { ConvP P{U, CAT, a.in[I_CONVW] + l * 31 * 512, a.in[I_CONVB] + l * 512, a.in[I_CLNG] + l * 512, a.in[I_CLNB] + l * 512, last}; conv_job(P, F); }
        __syncthreads();
        { ScanP P{ZR, CAT, a.in[I_RCW] + l * 2 * 4 * 512, a.in[I_RCB] + l * 2 * 512, WSP(const bf16_t, WS_WREC) + (size_t)l * 256 * 512, a.in[I_BRA] + l * 1024, a.in[I_BRI] + l * 1024, a.in[I_LAM] + l * 1024, SUM, CAR};
          scan_job<false>(P, F); }
        __syncthreads();
        { LAS f32x2* tl = (LAS f32x2*)(F.lds + RING_BYTES + 10240); tl[F.tid] = WSP(const f32x2, WS_TAB)[F.tid]; __syncthreads(); }
        { pg8::Gemm g{ZQ, WSP(const bf16_t, WS_WQB) + (size_t)l * 1024 * 768, 768, 768, 768, 0};
          pg8::Order S; S.init(last ? NB * 8 : T / 256, 4, F.G, F.bid, last ? 1 : 0, 1, 768, 768, 0);
          pg8::EpiQ E{Qb, a.in[I_GQN] + l * 96, WSP(const unsigned long long, WS_STATS), (LAS float*)(F.lds + RING_BYTES)};
          pg8::gemm_phase<pg8::EpiQ, true>(F.lds, g, S, E, F.tid); }
        if (last || F.G != 256 || F.bid >= 64)
        { pg8::Gemm g{ZKV, WSP(const bf16_t, WS_WKVB) + (size_t)l * 1024 * 256, 256, 256, 256, 0};
          pg8::Order S; if (last || F.G != 256) S.init(T / 256, 4, F.G, F.bid, 0, 1, 256, 256, 0); else S.init(T / 256, 4, 192, F.bid - 64, 0, 1, 256, 256, 0);
          pg8::EpiKV E{Kb, Vb, KR, a.in[I_GKN] + l * 96, WSP(const unsigned long long, WS_STATS), (LAS float*)(F.lds + RING_BYTES)};
          pg8::gemm_phase<pg8::EpiKV, true>(F.lds, g, S, E, F.tid); }
        } }
    if (IN(pb + 3)) { PHASE_BEGIN(); {
        carry_job(SUM, CAR, F); } }
    if (IN(pb + 4)) { PHASE_BEGIN(); {
        { ScanP P{ZR, CAT, a.in[I_RCW] + l * 2 * 4 * 512, a.in[I_RCB] + l * 2 * 512, WSP(const bf16_t, WS_WREC) + (size_t)l * 256 * 512, a.in[I_BRA] + l * 1024, a.in[I_BRI] + l * 1024, a.in[I_LAM] + l * 1024, SUM, CAR};
          scan_job<true>(P, F); }
        __syncthreads();
        { float mq = 0.f, mk = 0.f;
          for (int d = 0; d < 96; ++d) { mq = fmaxf(mq, fabsf(a.in[I_GQN][l * 96 + d])); mk = fmaxf(mk, fabsf(a.in[I_GKN][l * 96 + d])); }
          attn::AttnP P{Qb, Kb, Vb, CAT, 96.0f * mq * mk * QSCALE};
          attn::phase(P, F, !last); } } }
    if (IN(pb + 5)) { PHASE_BEGIN(); {
        pg8::Gemm g{CAT, WSP(const bf16_t, WS_WCAT) + (size_t)l * 1024 * 1536, 1536, 1536, 512, 0};
        pg8::Order S; S.init(nMrows, 4, F.G, F.bid, rmode, 3, 1536, 1536, 512);
        pg8::EpiMerge E{Gt, H};
        pg8::gemm_phase<pg8::EpiMerge, true>(F.lds, g, S, E, F.tid);
        if constexpr (l == 0 || l == 2) { if (F.G == 256) convert_moe(a, F, jf, 0, CVT_SPLIT1, F.bid - 64, 192); }
        if constexpr (l == 1) { if (F.G == 256) convert_common(a, F, 2 * CC_PER_LAYER, 4 * CC_PER_LAYER, F.bid - 64, 192); }
        } }
    if (IN(pb + 6)) { PHASE_BEGIN(); {
        pg8::Gemm g{H, WSP(const bf16_t, WS_WOUT) + (size_t)l * 1024 * 1024, DM, DM, DM, 1};
        pg8::Order S; S.init(nMrows, 4, F.G, F.bid, rmode, 1, DM, DM, 0);
        pg8::EpiResid E{XRES, MODl, 2};
        pg8::gemm_phase<pg8::EpiResid, true>(F.lds, g, S, E, F.tid);
        if constexpr (l == 0 || l == 2) { if (F.G == 256) convert_moe(a, F, jf, CVT_SPLIT1, CVT_SPLIT2, F.bid - 64, 192); }
        if constexpr (l == 1) { if (F.G == 256) convert_common(a, F, DEPTH * CC_PER_LAYER + CC_PER_FF, CC_NITEMS, F.bid - 64, 192); } } }
    if (IN(pb + 7)) { PHASE_BEGIN(); {
        NormP P{}; P.X = XRES; P.from_f32 = false; P.outf = nullptr; P.gain = a.in[I_GN2] + l * DM; P.mod = MODl; P.shsel = 3; P.H = H;
        P.combine = false; P.do_norm = true; P.latent_only = last;
        P.wrouter = a.in[I_WROUTER] + (size_t)jf * DM * 8; P.routeA = routeA; P.routeWout = routeW; P.cnt = cnt; P.inv = WSP(int, WS_INV);
        if (moe) norm_job<true>(P, F); else norm_job<false>(P, F); } }
    if constexpr (moe) {
        if (IN(pb + 9)) { PHASE_BEGIN(); {
            int off[9]; moe_offsets(cnt, off);
            for (int ai = F.bid * NTHREADS + F.tid; ai < (last ? NB * SEQ : T); ai += F.G * NTHREADS) { const int row = last ? (ai / SEQ) * LROW + CTXL + (ai % SEQ) : ai;
                const i32x4 ra = routeA[row]; int p0 = ra.y, p1 = ra.w;
#pragma unroll
                for (int e = 0; e < 8; ++e) { p0 += (ra.x == e) ? off[e] : 0; p1 += (ra.z == e) ? off[e] : 0; }
                routeP[row] = (i32x2){p0, p1}; }
            pg8::Gemm g{H, WSP(const bf16_t, WS_WEGU), DM, DM, DM, 0, WSP(const int, WS_INV)};
            pg8::Order S; S.init(off[8] >> 8, 28, F.G, F.bid, 2, 1, DM, DM, 0); S.n_per_group = 7168; S.gathered = true;
#pragma unroll
            for (int e = 0; e < 9; ++e) S.tstart[e] = off[e] >> 8;
            pg8::EpiSwiGLU E{HIDM, DFF};
            pg8::gemm_phase<pg8::EpiSwiGLU, true, true>(F.lds, g, S, E, F.tid); } }
        if (IN(pb + 10)) { PHASE_BEGIN(); {
            int off[9]; moe_offsets(cnt, off);
            pg8::Gemm g{HIDM, WSP(const bf16_t, WS_WED), DFF, DFF, DFF, 1};
            pg8::Order S; S.init(off[8] >> 8, 4, F.G, F.bid, 2, 1, DFF, DFF, 0); S.n_per_group = 1024;
#pragma unroll
            for (int e = 0; e < 9; ++e) S.tstart[e] = off[e] >> 8;
            pg8::EpiPlain E{HP, DM};
            pg8::gemm_phase<pg8::EpiPlain, true>(F.lds, g, S, E, F.tid); } }
    } else {
        if (IN(pb + 9)) { PHASE_BEGIN(); {
            pg8::Gemm g{H, WSP(const bf16_t, WS_WFFGU) + (size_t)jf * 7168 * 1024, DM, DM, DM, 0};
            pg8::Order S; S.init(T / 256, 28, F.G, F.bid, 0, 1, DM, DM, 0);
            pg8::EpiSwiGLU E{HID, DFF};
            pg8::gemm_phase<pg8::EpiSwiGLU, true>(F.lds, g, S, E, F.tid); } }
        if (IN(pb + 10)) { PHASE_BEGIN(); {
            pg8::Gemm g{HID, WSP(const bf16_t, WS_WFFD) + (size_t)jf * 1024 * DFF, DFF, DFF, DFF, 1};
            pg8::Order S; S.init(T / 256, 4, F.G, F.bid, 0, 1, DFF, DFF, 0);
            pg8::EpiResid E{XRES, MODl, 5};
            pg8::gemm_phase<pg8::EpiResid, true>(F.lds, g, S, E, F.tid);
            if (F.G == 256) convert_moe(a, F, jf, CVT_SPLIT2, MOE_CVT_ITEMS, F.bid - 64, 192);
            else { __syncthreads(); convert_moe(a, F, jf, 0, MOE_CVT_ITEMS, F.bid, F.G); } } }
    }
}

__global__ void __launch_bounds__(NTHREADS, 2) fwd_kernel(Args a) {
    extern __shared__ __attribute__((aligned(16))) unsigned char lds_raw[];
    Frame F;
    F.lds = (LAS unsigned char*)lds_raw; F.tid = threadIdx.x; F.lane = F.tid & 63; F.wave = __builtin_amdgcn_readfirstlane(F.tid >> 6); F.G = gridDim.x; F.bid = blockIdx.x; F.ws = a.ws;
    volatile LAS unsigned* MISC = (volatile LAS unsigned*)(F.lds + LDSCTL_OFF);
    if (F.tid < 64) MISC[F.tid] = 0u;
    __syncthreads();
    XcdBarrier bar = xcd_barrier_post((unsigned*)(a.ws + WS_CTL) + CW_BAR, MISC + 8);
    const int lo = a.ph_lo, hi = a.ph_hi;
    bool need_bar = false;
    if (IN(0)) { PHASE_BEGIN(); {
        if (F.G == 256) { convert_common(a, F, 0, 2 * CC_PER_LAYER, F.bid, F.G); convert_common(a, F, DEPTH * CC_PER_LAYER, DEPTH * CC_PER_LAYER + CC_PER_FF, F.bid, F.G); }
        else convert_common(a, F, 0, CC_NITEMS, F.bid, F.G);
        rope_table_job((f32x2*)(a.ws + WS_TAB), F); __syncthreads(); mod_job(a, F); } }
    layer_phases<0>(a, F, bar, need_bar, lo, hi);
    layer_phases<1>(a, F, bar, need_bar, lo, hi);
    layer_phases<2>(a, F, bar, need_bar, lo, hi);
    layer_phases<3>(a, F, bar, need_bar, lo, hi);
    if (IN(NPHASE - 1)) { PHASE_BEGIN(); {
        unsigned char* ws = a.ws;
        NormP P{}; P.X = WSP(bf16_t, WS_XRES); P.from_f32 = false; P.outf = a.out; P.combine = true; P.Y = WSP(bf16_t, A_HP); P.routeP = WSP(i32x2, WS_ROUTE_P); P.routeW = WSP(f32x2, WS_ROUTE_W);
        P.modprev = WSP(float, WS_MOD) + (size_t)(DEPTH - 1) * NMOD * 6144; P.do_norm = false; P.latent_only = true;
        norm_job<false>(P, F); } }
}
#undef IN
#undef PHASE_BEGIN

extern "C" void kernel_launch(void* const* d_in, const int* in_sizes, int n_in, void* d_out, int out_size, void* d_ws, size_t ws_size, hipStream_t stream) {
    static int grid = 0;
    if (grid == 0) {
        if (n_in != 38 || out_size != NB * SEQ * DM || ws_size < WS_END) { fprintf(stderr, "kernel_launch: unexpected shapes (n_in %d out %d ws %zu need %zu)\n", n_in, out_size, ws_size, (size_t)WS_END); grid = -1; return; }
        int dev = 0, cus = 0;
        if (hipGetDevice(&dev) != hipSuccess || hipDeviceGetAttribute(&cus, hipDeviceAttributeMultiprocessorCount, dev) != hipSuccess) { grid = -1; return; }
        if (hipFuncSetAttribute((const void*)fwd_kernel, hipFuncAttributeMaxDynamicSharedMemorySize, LDS_BYTES) != hipSuccess) { fprintf(stderr, "kernel_launch: hipFuncSetAttribute failed\n"); grid = -1; return; }
        int per_cu = 0;
        if (hipOccupancyMaxActiveBlocksPerMultiprocessor(&per_cu, (const void*)fwd_kernel, NTHREADS, LDS_BYTES) != hipSuccess || per_cu < 1) { fprintf(stderr, "kernel_launch: occupancy query says %d\n", per_cu); }
        (void)hipGetLastError();
        grid = cus;
    }
    if (grid < 0) return;
    (void)hipMemsetAsync((char*)d_ws + WS_CTL, 0, CTL_BYTES, stream);
    Args a{};
    for (int i = 0; i < 38; ++i) a.in[i] = (const float*)d_in[i];
    a.out = (float*)d_out; a.ws = (unsigned char*)d_ws;
#if MK_ONE_LAUNCH
    a.ph_lo = 0; a.ph_hi = NPHASE;
    hipLaunchKernelGGL(fwd_kernel, dim3(grid), dim3(NTHREADS), LDS_BYTES, stream, a);
#else
    for (int k = 0; k < NPHASE; ++k) {
        if (k >= 1 && k < NPHASE - 1) { const int l = (k - 1) / PH_PER_LAYER, p = (k - 1) % PH_PER_LAYER; if (p == 8 && !(l & 1)) continue; }
        a.ph_lo = k; a.ph_hi = k + 1;
        hipLaunchKernelGGL(fwd_kernel, dim3(grid), dim3(NTHREADS), LDS_BYTES, stream, a);
    }
#endif
}
```
